# Optimizing an MI355X kernel written in HIP

```python
import jax, jax.numpy as jnp
from jax import lax
import numpy as np

D_MODEL = 2048
BATCH = 4
SEQ = 4096
DEPTH = 2
DEC_BATCH = 8
DEC_SEQ = 64
PAST_LEN = 2048

CHUNK = 64
HEAD_DIM = 128
A_HEADS = 8
A_WIDTH = A_HEADS * HEAD_DIM
BAND_CHUNKS = 8
BAND_ROWS = BAND_CHUNKS * CHUNK
MAX_REL = 128
B_HEADS = 8
B_WIDTH = B_HEADS * HEAD_DIM
CONV_W = 4
C_HEADS = 8
C_WIDTH = C_HEADS * HEAD_DIM
ROPE_BASE = 10000.0
EPS = 1e-6
NEG_INF = -1e30
IN_SIZES = (A_WIDTH,) * 4 + (3 * B_WIDTH, B_WIDTH, B_HEADS, B_HEADS) + (C_WIDTH,) * 4 + (D_MODEL,) * 3
N_IN = sum(IN_SIZES)

kernel_name = 'hybrid_streaming_encoder_step'


def rms_norm(x, g):
    xf = x.astype(jnp.float32)
    return xf * lax.rsqrt(jnp.mean(xf * xf, axis=-1, keepdims=True) + EPS) * g.astype(jnp.float32)


def group_norm(x, g):
    xf = x.astype(jnp.float32)
    mu = jnp.mean(xf, axis=-1, keepdims=True)
    var = jnp.mean(jnp.square(xf - mu), axis=-1, keepdims=True)
    return (xf - mu) * lax.rsqrt(var + EPS) * g.astype(jnp.float32)


def l2_norm(x):
    xf = x.astype(jnp.float32)
    return xf * lax.rsqrt(jnp.sum(xf * xf, axis=-1, keepdims=True) + EPS)


def rotary(x, pos):
    half = x.shape[-1] // 2
    inv = ROPE_BASE ** (-jnp.arange(half, dtype=jnp.float32) / half)
    ang = pos.astype(jnp.float32)[:, None] * inv[None, :]
    cos = jnp.cos(ang)[None, :, None, :]
    sin = jnp.sin(ang)[None, :, None, :]
    xf = x.astype(jnp.float32)
    x1, x2 = xf[..., :half], xf[..., half:]
    return jnp.concatenate([x1 * cos - x2 * sin, x1 * sin + x2 * cos], axis=-1)


def causal_conv(x, buf, w):
    t = x.shape[1]
    xp = jnp.concatenate([buf.astype(x.dtype), x], axis=1)
    y = xp[:, 0:t] * w[0]
    for i in range(1, CONV_W):
        y = y + xp[:, i:i + t] * w[i]
    return jax.nn.silu(y), xp[:, t:]


def rel_bias_lookup(rel_bias, dist):
    return jnp.take(rel_bias, jnp.clip(dist, -MAX_REL, MAX_REL) + MAX_REL, axis=1).astype(jnp.float32)


def band_attention_prompt(q, k, v, rel_bias):
    b, s, h, d = q.shape
    nc = s // CHUNK
    nb = BAND_CHUNKS + 1
    pad = jnp.zeros((b, BAND_CHUNKS, CHUNK, h, d), k.dtype)
    kp = jnp.concatenate([pad, k.reshape(b, nc, CHUNK, h, d)], axis=1)
    vp = jnp.concatenate([pad.astype(v.dtype), v.reshape(b, nc, CHUNK, h, d)], axis=1)
    kb = jnp.stack([kp[:, o:o + nc] for o in range(nb)], axis=2).reshape(b, nc, nb * CHUNK, h, d)
    vb = jnp.stack([vp[:, o:o + nc] for o in range(nb)], axis=2).reshape(b, nc, nb * CHUNK, h, d)
    qc = q.reshape(b, nc, CHUNK, h, d)
    scores = jnp.einsum('bcihd,bcrhd->bchir', qc, kb).astype(jnp.float32) * (d ** -0.5)
    i = jnp.arange(CHUNK)[:, None]
    r = jnp.arange(nb * CHUNK)[None, :]
    bias = rel_bias_lookup(rel_bias, BAND_ROWS + i - r)
    key_chunk = jnp.arange(nc)[:, None] - (BAND_CHUNKS - jnp.arange(nb * CHUNK) // CHUNK)[None, :]
    valid = key_chunk >= 0
    scores = jnp.where(valid[None, :, None, None, :], scores + bias[None, None], NEG_INF)
    p = jax.nn.softmax(scores, axis=-1).astype(v.dtype)
    out = jnp.einsum('bchir,bcrhd->bcihd', p, vb)
    return out.reshape(b, s, h, d)


def band_attention_sample(q, k, v, ck, cv, rel_bias):
    p_rows, t = ck.shape[1], q.shape[1]
    k_all = jnp.concatenate([ck.astype(k.dtype), k], axis=1)
    v_all = jnp.concatenate([cv.astype(v.dtype), v], axis=1)
    scores = jnp.einsum('bihd,brhd->bhir', q, k_all).astype(jnp.float32) * (HEAD_DIM ** -0.5)
    i = jnp.arange(t)[:, None]
    r = jnp.arange(p_rows + t)[None, :]
    scores = scores + rel_bias_lookup(rel_bias, p_rows + i - r)[None]
    p = jax.nn.softmax(scores, axis=-1).astype(v.dtype)
    out = jnp.einsum('bhir,brhd->bihd', p, v_all)
    return out, k_all[:, t:], v_all[:, t:]


def _blocks(x, block):
    b, t, h = x.shape[:3]
    xh = jnp.moveaxis(x.astype(jnp.float32), 2, 1)
    return xh.reshape((b, h, t // block, block) + xh.shape[3:])


def _unblocks(o):
    n, b, h, l, d = o.shape
    return jnp.moveaxis(o, 0, 2).reshape(b, h, n * l, d).swapaxes(1, 2)


def gated_delta_chunked(q, k, v, g, beta, s0, block):
    qb = _blocks(q, block) * (HEAD_DIM ** -0.5)
    kb = _blocks(k, block)
    vb = _blocks(v, block)
    gcum = jnp.cumsum(_blocks(g, block), axis=-1)
    bb = _blocks(beta, block)
    idx = jnp.arange(block)
    causal = idx[:, None] >= idx[None, :]
    strict = idx[:, None] > idx[None, :]
    decay = jnp.exp(jnp.where(causal, gcum[..., :, None] - gcum[..., None, :], -jnp.inf))
    k_beta = kb * bb[..., None]
    a_mat = jnp.where(strict, jnp.einsum('bhnid,bhnjd->bhnij', k_beta, kb) * decay, 0.0)
    eye = jnp.eye(block, dtype=jnp.float32)
    rhs = jnp.concatenate([vb * bb[..., None], k_beta * jnp.exp(gcum)[..., None]], axis=-1)
    sol = lax.linalg.triangular_solve(a_mat + eye, rhs, left_side=True, lower=True)
    u, w = sol[..., :HEAD_DIM], sol[..., HEAD_DIM:]
    intra = jnp.einsum('bhnid,bhnjd->bhnij', qb, kb) * decay
    q_dec = qb * jnp.exp(gcum)[..., None]
    k_tail = kb * jnp.exp(gcum[..., -1:] - gcum)[..., None]
    g_blk = jnp.exp(gcum[..., -1])[..., None, None]

    def step(s, xs):
        u_c, w_c, q_c, k_c, a_c, g_c = xs
        v_new = u_c - jnp.einsum('bhld,bhde->bhle', w_c, s)
        o = jnp.einsum('bhld,bhde->bhle', q_c, s) + jnp.einsum('bhij,bhje->bhie', a_c, v_new)
        s = s * g_c + jnp.einsum('bhld,bhle->bhde', k_c, v_new)
        return s, o

    xs = tuple(jnp.moveaxis(a, 2, 0) for a in (u, w, q_dec, k_tail, intra, g_blk))
    s, o = lax.scan(step, s0.astype(jnp.float32), xs)
    return _unblocks(o), s


def retention_chunked(q, k, v, log_gamma, s0, block):
    qb, kb, vb = _blocks(q, block), _blocks(k, block), _blocks(v, block)
    idx = jnp.arange(block, dtype=jnp.float32)
    rel = idx[:, None] - idx[None, :]
    lg = log_gamma[:, None, None]
    dmat = jnp.where(rel >= 0, jnp.exp(lg * jnp.maximum(rel, 0.0)), 0.0)
    intra = jnp.einsum('bhnid,bhnjd->bhnij', qb, kb) * dmat[None, :, None]
    xi = jnp.exp(log_gamma[:, None] * (idx + 1.0))[None, :, :, None]
    zeta = jnp.exp(log_gamma[:, None] * (block - 1.0 - idx))[None, :, :, None]
    g_blk = jnp.exp(log_gamma * block)[None, :, None, None]

    def step(s, xs):
        q_c, k_c, v_c, a_c = xs
        o = jnp.einsum('bhij,bhje->bhie', a_c, v_c) + jnp.einsum('bhld,bhde->bhle', q_c, s) * xi
        s = s * g_blk + jnp.einsum('bhld,bhle->bhde', k_c * zeta, v_c)
        return s, o

    xs = tuple(jnp.moveaxis(a, 2, 0) for a in (qb, kb, vb, intra))
    s, o = lax.scan(step, s0.astype(jnp.float32), xs)
    return _unblocks(o), s


def trunk_layer(x, pos, attn_cache, conv_buf, s_delta, s_ret, block, lw):
    (norm_pre, norm_post, w_in, rel_bias, conv_w, a_log, dt_bias, delta_norm, ret_norm,
     w_ba, w_bb, w_bc, w_out) = lw
    b, t, _ = x.shape
    dtype = x.dtype
    h = rms_norm(x, norm_pre).astype(dtype)
    proj = h @ w_in
    cuts = [int(c) for c in np.cumsum(IN_SIZES)[:-1]]
    (aq, ak, av, az, bqkv, bz, bbeta, balpha, cq, ck, cv, cz, ga, gb, gc) = jnp.split(proj, cuts, axis=-1)
    heads = lambda u: u.reshape(b, t, -1, HEAD_DIM)

    qa, ka, va = heads(aq), heads(ak), heads(av)
    if attn_cache is None:
        oa = band_attention_prompt(qa, ka, va, rel_bias)
        keep = min(BAND_ROWS, t)
        new_k, new_v = ka[:, t - keep:], va[:, t - keep:]
    else:
        oa, new_k, new_v = band_attention_sample(qa, ka, va, attn_cache[0], attn_cache[1], rel_bias)
    oa = (oa.reshape(b, t, A_WIDTH) * jax.nn.silu(az)).astype(dtype)

    qkv, new_conv = causal_conv(bqkv, conv_buf, conv_w)
    qb, kb, vb = jnp.split(qkv, 3, axis=-1)
    beta = jax.nn.sigmoid(balpha.astype(jnp.float32) * 0.0 + bbeta.astype(jnp.float32)) if False else jax.nn.sigmoid(bbeta.astype(jnp.float32))
    g = -jnp.exp(a_log.astype(jnp.float32)) * jax.nn.softplus(balpha.astype(jnp.float32) + dt_bias.astype(jnp.float32))
    ob, new_sd = gated_delta_chunked(l2_norm(heads(qb)), l2_norm(heads(kb)), heads(vb), g, beta, s_delta, block)
    ob = (rms_norm(ob, delta_norm).reshape(b, t, B_WIDTH) * jax.nn.silu(bz)).astype(dtype)

    log_gamma = jnp.log1p(-jnp.exp2(-5.0 - jnp.arange(C_HEADS, dtype=jnp.float32)))
    qc = rotary(heads(cq), pos)
    kc = rotary(heads(ck), pos) * (HEAD_DIM ** -0.5)
    oc, new_sr = retention_chunked(qc, kc, heads(cv), log_gamma, s_ret, block)
    oc = (group_norm(oc, ret_norm).reshape(b, t, C_WIDTH) * jax.nn.silu(cz)).astype(dtype)

    merged = (jax.nn.sigmoid(ga) * (oa @ w_ba) + jax.nn.sigmoid(gb) * (ob @ w_bb)
              + jax.nn.sigmoid(gc) * (oc @ w_bc))
    y = rms_norm(merged @ w_out, norm_post).astype(dtype)
    return (x + y, new_k, new_v, new_conv, new_sd.astype(s_delta.dtype), new_sr.astype(s_ret.dtype))


def setup_inputs(seed: int = 0) -> dict:
    key = jax.random.key(seed)
    ks = jax.random.split(key, 24)
    f32 = jnp.float32
    nrm = lambda k, shape, scale: scale * jax.random.normal(k, shape, f32)
    p_cache = min(BAND_ROWS, PAST_LEN)
    dt_init = jnp.exp(jax.random.uniform(ks[13], (DEPTH, B_HEADS), f32, float(np.log(1e-3)), float(np.log(1e-1))))
    return {
        'x_prompt': nrm(ks[0], (BATCH, SEQ, D_MODEL), 1.0),
        'x_sample': nrm(ks[1], (DEC_BATCH, DEC_SEQ, D_MODEL), 1.0),
        'cache_attn_k': nrm(ks[2], (DEPTH, DEC_BATCH, p_cache, A_HEADS, HEAD_DIM), 1.0),
        'cache_attn_v': nrm(ks[3], (DEPTH, DEC_BATCH, p_cache, A_HEADS, HEAD_DIM), 1.0),
        'state_conv': nrm(ks[4], (DEPTH, DEC_BATCH, CONV_W - 1, 3 * B_WIDTH), 1.0),
        'state_delta': nrm(ks[5], (DEPTH, DEC_BATCH, B_HEADS, HEAD_DIM, HEAD_DIM), 0.1),
        'state_ret': nrm(ks[6], (DEPTH, DEC_BATCH, C_HEADS, HEAD_DIM, HEAD_DIM), 0.3),
        'norm_pre': 1.0 + nrm(ks[7], (DEPTH, D_MODEL), 0.02),
        'norm_post': 1.0 + nrm(ks[8], (DEPTH, D_MODEL), 0.02),
        'w_in': nrm(ks[9], (DEPTH, D_MODEL, N_IN), D_MODEL ** -0.5),
        'attn_rel_bias': nrm(ks[10], (DEPTH, A_HEADS, 2 * MAX_REL + 1), 0.3),
        'conv_w': nrm(ks[11], (DEPTH, CONV_W, 3 * B_WIDTH), CONV_W ** -0.5),
        'delta_a_log': jnp.log(jax.random.uniform(ks[12], (DEPTH, B_HEADS), f32, 1.0, 16.0)),
        'delta_dt_bias': jnp.log(jnp.expm1(dt_init)),
        'delta_norm': 1.0 + nrm(ks[14], (DEPTH, HEAD_DIM), 0.02),
        'ret_norm': 1.0 + nrm(ks[15], (DEPTH, C_HEADS, HEAD_DIM), 0.02),
        'w_branch_a': nrm(ks[16], (DEPTH, A_WIDTH, D_MODEL), A_WIDTH ** -0.5),
        'w_branch_b': nrm(ks[17], (DEPTH, B_WIDTH, D_MODEL), B_WIDTH ** -0.5),
        'w_branch_c': nrm(ks[18], (DEPTH, C_WIDTH, D_MODEL), C_WIDTH ** -0.5),
        'w_out': nrm(ks[19], (DEPTH, D_MODEL, D_MODEL), D_MODEL ** -0.5),
    }


def reference(x_prompt, x_sample, cache_attn_k, cache_attn_v, state_conv, state_delta, state_ret,
              norm_pre, norm_post, w_in, attn_rel_bias, conv_w, delta_a_log, delta_dt_bias,
              delta_norm, ret_norm, w_branch_a, w_branch_b, w_branch_c, w_out):
    dtype = x_prompt.dtype
    bp, tp = x_prompt.shape[0], x_prompt.shape[1]
    ts = x_sample.shape[1]
    pos_p = jnp.arange(tp, dtype=jnp.int32)
    pos_s = PAST_LEN + jnp.arange(ts, dtype=jnp.int32)
    zero_conv = jnp.zeros((bp, CONV_W - 1, 3 * B_WIDTH), dtype)
    zero_delta = jnp.zeros((bp, B_HEADS, HEAD_DIM, HEAD_DIM), dtype)
    zero_ret = jnp.zeros((bp, C_HEADS, HEAD_DIM, HEAD_DIM), dtype)
    xp, xs = x_prompt, x_sample
    acc_p = [[], [], [], [], []]
    acc_s = [[], [], [], [], []]
    for l in range(DEPTH):
        lw = (norm_pre[l], norm_post[l], w_in[l], attn_rel_bias[l], conv_w[l], delta_a_log[l],
              delta_dt_bias[l], delta_norm[l], ret_norm[l], w_branch_a[l], w_branch_b[l],
              w_branch_c[l], w_out[l])
        xp, *st_p = trunk_layer(xp, pos_p, None, zero_conv, zero_delta, zero_ret, CHUNK, lw)
        xs, *st_s = trunk_layer(xs, pos_s, (cache_attn_k[l], cache_attn_v[l]), state_conv[l],
                                state_delta[l], state_ret[l], ts, lw)
        for acc, val in zip(acc_p, st_p):
            acc.append(val)
        for acc, val in zip(acc_s, st_s):
            acc.append(val)
    pk, pv, pc, pd, pr = [jnp.stack(a, axis=0) for a in acc_p]
    sk, sv, sc, sd, sr = [jnp.stack(a, axis=0) for a in acc_s]
    return (xp, xs, pk, pv, pc, pd, pr, sk, sv, sc, sd, sr)
```

```cpp
#include <hip/hip_runtime.h>
#include <hip/hip_cooperative_groups.h>
#include <cstdio>
namespace cg = cooperative_groups;
#ifndef R_DP
#define R_DP 1
#endif
#ifndef R_SW
#define R_SW 1
#endif
#ifndef R_AT
#define R_AT 1
#endif
#ifndef R_G1
#define R_G1 1
#endif
#ifndef R_M1
#define R_M1 1
#endif
#ifndef R_M2
#define R_M2 1
#endif
#ifndef R_M3
#define R_M3 1
#endif
#ifndef R_G2
#define R_G2 1
#endif
#ifndef R_G3
#define R_G3 1
#endif
#ifndef T_ROW
#define T_ROW 1
#endif
#ifndef T_G1
#define T_G1 1
#endif
#ifndef T_DP
#define T_DP 1
#endif
#ifndef T_RP
#define T_RP 1
#endif
#ifndef T_MI
#define T_MI 1
#endif
#ifndef T_M2
#define T_M2 1
#endif
#ifndef T_M3
#define T_M3 1
#endif
#ifndef T_G2
#define T_G2 1
#endif
#ifndef T_G3
#define T_G3 1
#endif
#ifndef T_AT
#define T_AT 1
#endif
#ifndef T_SC
#define T_SC 1
#endif

#define DI __device__ __forceinline__
#define LAS __attribute__((address_space(3)))
typedef unsigned short bf16_t;
typedef short bf16x8 __attribute__((ext_vector_type(8)));
typedef float f32x4 __attribute__((ext_vector_type(4)));
typedef float f32x2 __attribute__((ext_vector_type(2)));
typedef unsigned u32x4 __attribute__((ext_vector_type(4)));
typedef unsigned u32x2 __attribute__((ext_vector_type(2)));
typedef __bf16 bf2_t __attribute__((ext_vector_type(2)));

constexpr int DM = 2048, MROWS = 16896, LDP = 18432, NW1 = 18688, NIN = 18448, NITEM = 2112;
constexpr int C_ACAT = 4096, C_OBRAW = 8192, C_OCRAW = 9216;
constexpr size_t O_PK = 34603008, O_PV = 38797312, O_PC = 42991616, O_PD = 43065344, O_PR = 44113920, O_SK = 45162496, O_SV = 53551104, O_SC = 61939712, O_SD = 62087168, O_SR = 64184320;
constexpr size_t OFF_WIN = 0, OFF_WBR = 76546048, OFF_WOUT = 89128960, OFF_H = 97517568, OFF_PROJ = 166723584, OFF_SIDE = 789577728, OFF_DG = 790659072,
                 OFF_CNT = 790667520, OFF_KC = 790675456, OFF_CVT = 799064064, OFF_M1 = 807452672, OFF_BAR = 1118879744, WS_NEED = 1118879744 + 16384;
constexpr size_t M1_BLK = (size_t)NITEM * 8192;

struct Params {
  const float *x_prompt, *x_sample, *cache_k, *cache_v, *state_conv, *state_delta, *state_ret, *norm_pre, *norm_post, *w_in, *rel_bias, *conv_w, *a_log, *dt_bias,
      *delta_norm, *ret_norm, *w_ba, *w_bb, *w_bc, *w_out;
  float* out; unsigned char* ws;
};

DI unsigned pk2(float lo, float hi) { f32x2 v = {lo, hi}; bf2_t b = __builtin_convertvector(v, bf2_t); return __builtin_bit_cast(unsigned, b); }
DI bf16_t f2bf(float x) { return (bf16_t)(pk2(x, 0.f) & 0xffffu); }
DI float bflo(unsigned w) { return __uint_as_float(w << 16); }
DI float bfhi(unsigned w) { return __uint_as_float(w & 0xffff0000u); }
DI float bf2f(bf16_t b) { return __uint_as_float(((unsigned)b) << 16); }
DI float sigmoidf_(float x) { return 1.f / (1.f + __expf(-x)); }
DI float siluf_(float x) { return x / (1.f + __expf(-x)); }
DI int otid() { int t = threadIdx.x; asm volatile("" : "+v"(t)); return t; }
DI int kperm(int p) { return 16 * ((p >> 2) & 1) + 4 * (p >> 3) + (p & 3); }
DI int kinv(int x) { return 8 * ((x >> 2) & 3) + 4 * (x >> 4) + (x & 3); }
DI float wsum(float v) { for (int o = 32; o > 0; o >>= 1) v += __shfl_xor(v, o); return v; }
DI void unpack8(u32x4 a, float* o) { o[0] = bflo(a.x); o[1] = bfhi(a.x); o[2] = bflo(a.y); o[3] = bfhi(a.y); o[4] = bflo(a.z); o[5] = bfhi(a.z); o[6] = bflo(a.w); o[7] = bfhi(a.w); }
DI u32x4 pack8(const float* v) { u32x4 w; w.x = pk2(v[0], v[1]); w.y = pk2(v[2], v[3]); w.z = pk2(v[4], v[5]); w.w = pk2(v[6], v[7]); return w; }
DI bf16x8 pack_frag(f32x4 a, f32x4 b) { u32x4 w; w.x = pk2(a[0], a[1]); w.y = pk2(a[2], a[3]); w.z = pk2(b[0], b[1]); w.w = pk2(b[2], b[3]); return __builtin_bit_cast(bf16x8, w); }
#define MFMA16(a, b, c) __builtin_amdgcn_mfma_f32_16x16x32_bf16((a), (b), (c), 0, 0, 0)

namespace pg8 {
constexpr int BM = 256, BK = 64, HALF = 128, HTB = HALF * BK * 2, STAGE_BYTES = 8 * HTB, NXCD = 8, WGM = 8;
DI int lds_byte(int r, int c) { const int st = (r >> 4) * 2 + (c >> 5), rr = r & 15, cc = c & 31, ob = rr * 64 + cc * 2; return st * 1024 + (ob ^ (((ob >> 9) & 1) << 5)); }
DI void stage_rc(int b, int& R, int& C) { const int st = b / 1024, sb = b % 1024, swz = sb ^ (((sb >> 9) & 1) << 5); R = (st >> 1) * 16 + swz / 64; C = (st & 1) * 32 + (swz % 64) / 2; }
DI int perm32(int rho) { const int n = rho >> 4, i = rho & 15; return 8 * (i >> 2) + 4 * n + (i & 3); }
struct Unit { int pm, pn; };
struct Gemm { const bf16_t* A; const bf16_t* Bt; int M, N, K, lda, ldb, a_div, a_step; };
struct StaticOrder {
  int nM, nN, nwg, G, c;
  DI void init(int M, int N, int G_, int c_) { nM = M / BM; nN = N / BM; nwg = nM * nN; G = G_; c = c_; }
  DI bool next(int i, Unit& u) const {
    const long L = (long)i * G + c; if (L >= nwg) return false;
    int wgid = (int)L; { const int q = nwg / NXCD, r = nwg % NXCD, xcd = wgid % NXCD, off = wgid / NXCD; wgid = (xcd < r ? xcd * (q + 1) : r * (q + 1) + (xcd - r) * q) + off; }
    const int nig = WGM * nN, gid = wgid / nig, fm = gid * WGM, gsz = (nM - fm) < WGM ? (nM - fm) : WGM;
    u.pm = fm + ((wgid % nig) % gsz); u.pn = (wgid % nig) / gsz; return true;
  }
};

template <class Epi>
DI void gemm_phase(LAS unsigned char* lds, const Gemm g, const StaticOrder& S, const Epi& E) {
  const int tid = otid(), wid = __builtin_amdgcn_readfirstlane(tid >> 6), lane = tid & 63, wr = wid >> 2, wc = wid & 3, fr = lane & 15, fq = lane >> 4;
  const int K = g.K, nt = K / BK;
  unsigned voffA[2], voffB[2];
#pragma unroll
  for (int i = 0; i < 2; ++i) { int R, C; stage_rc(tid * 16 + i * 8192, R, C); const int Rb = Epi::PERM ? ((R & ~31) + perm32(R & 31)) : R;
    voffA[i] = (unsigned)(R * g.lda + C) * 2u; voffB[i] = (unsigned)(Rb * g.ldb + C) * 2u; }
  const size_t kstep = (size_t)(BK * 2);
  const size_t hstepA = (size_t)HALF * g.lda * 2, hstepB = (size_t)HALF * g.ldb * 2;
  const size_t tstepA = 2 * hstepA, tstepB = 2 * hstepB;
  const unsigned ldsw = (unsigned)wid * 1024u;
  const int aoff = lds_byte(wr * 64 + fr, fq * 8), boff = lds_byte(wc * 32 + fr, fq * 8);
#define PG8_SA(b, h) (((b) * 2 + (h)) * HTB)
#define PG8_SB(b, h) ((4 + (b) * 2 + (h)) * HTB)
#define PG8_STAGE(bufoff, gbase, voff) do { const char* _gb = (const char*)(gbase); asm volatile("" : "+s"(_gb)); _Pragma("unroll") for (int _i = 0; _i < 2; ++_i) \
    __builtin_amdgcn_global_load_lds((const unsigned*)(_gb + (voff)[_i]), (LAS unsigned*)(lds + (bufoff) + ldsw + _i * 8192), 16, 0, 0); } while (0)
#define PG8_LDA(dst, b, h) do { _Pragma("unroll") for (int m = 0; m < 4; ++m) _Pragma("unroll") for (int k = 0; k < 2; ++k) dst[m][k] = *(const LAS bf16x8*)(lds + PG8_SA(b, h) + aoff + m * 2048 + k * 1024); } while (0)
#define PG8_LDB(dst, b, h) do { _Pragma("unroll") for (int n = 0; n < 2; ++n) _Pragma("unroll") for (int k = 0; k < 2; ++k) dst[n][k] = *(const LAS bf16x8*)(lds + PG8_SB(b, h) + boff + n * 2048 + k * 1024); } while (0)
#define PG8_MMA(ai, bj, At, Bt) do { __builtin_amdgcn_s_setprio(1); _Pragma("unroll") for (int m = 0; m < 4; ++m) _Pragma("unroll") for (int n = 0; n < 2; ++n) _Pragma("unroll") for (int k = 0; k < 2; ++k) \
    acc[ai][bj][m][n] = __builtin_amdgcn_mfma_f32_16x16x32_bf16(Bt[n][k], At[m][k], acc[ai][bj][m][n], 0, 0, 0); __builtin_amdgcn_s_setprio(0); } while (0)
#define PG8_WAIT_V(n) asm volatile("s_waitcnt vmcnt(" #n ")" ::: "memory")
#define PG8_WAIT_L(n) asm volatile("s_waitcnt lgkmcnt(" #n ")" ::: "memory")
#define PG8_BAR __builtin_amdgcn_s_barrier()
#define PG8_SCHED __builtin_amdgcn_sched_barrier(0)
  Unit cur, nxt; int ui = 0;
  if (!S.next(0, cur)) return;
  f32x4 acc[2][2][4][2];
#pragma unroll
  for (int a = 0; a < 2; ++a)
#pragma unroll
    for (int b = 0; b < 2; ++b)
#pragma unroll
      for (int m = 0; m < 4; ++m)
#pragma unroll
        for (int n = 0; n < 2; ++n) acc[a][b][m][n] = (f32x4){0.f, 0.f, 0.f, 0.f};
  bf16x8 At[4][2], B0[2][2], B1[2][2];
  const char* cA = (const char*)g.A + (size_t)cur.pm * tstepA + (size_t)((cur.pn / g.a_div) * g.a_step); const char* cB = (const char*)g.Bt + (size_t)cur.pn * tstepB;
  PG8_STAGE(PG8_SB(0, 0), cB, voffB); PG8_STAGE(PG8_SA(0, 0), cA, voffA); PG8_STAGE(PG8_SB(0, 1), cB + hstepB, voffB); PG8_STAGE(PG8_SA(0, 1), cA + hstepA, voffA);
  if (wr == 1) PG8_BAR;
  PG8_WAIT_V(4); PG8_BAR;
  PG8_STAGE(PG8_SB(1, 0), cB + kstep, voffB); PG8_STAGE(PG8_SA(1, 0), cA + kstep, voffA); PG8_STAGE(PG8_SB(1, 1), cB + hstepB + kstep, voffB);
  PG8_WAIT_V(6); PG8_BAR;
  for (;;) {
    const bool has_next = S.next(ui + 1, nxt);
    const char* nA = has_next ? (const char*)g.A + (size_t)nxt.pm * tstepA + (size_t)((nxt.pn / g.a_div) * g.a_step) : cA; const char* nB = has_next ? (const char*)g.Bt + (size_t)nxt.pn * tstepB : cB;
    for (int t = 0; t < nt; t += 2) {
      const bool last = (t == nt - 2);
      const char* a1 = cA + (size_t)(t + 1) * kstep;
      const char* a2 = last ? nA : cA + (size_t)(t + 2) * kstep; const char* b2 = last ? nB : cB + (size_t)(t + 2) * kstep;
      const char* a3 = a2 + kstep; const char* b3 = b2 + kstep;
      PG8_LDB(B0, 0, 0); PG8_SCHED; PG8_LDA(At, 0, 0); PG8_STAGE(PG8_SA(1, 1), a1 + hstepA, voffA);
      PG8_WAIT_L(8); PG8_BAR; PG8_WAIT_L(0); PG8_MMA(0, 0, At, B0); PG8_BAR; PG8_SCHED;
      PG8_LDB(B1, 0, 1); PG8_STAGE(PG8_SB(0, 0), b2, voffB);
      PG8_BAR; PG8_WAIT_L(0); PG8_MMA(0, 1, At, B1); PG8_BAR;
      PG8_LDA(At, 0, 1); PG8_STAGE(PG8_SA(0, 0), a2, voffA);
      PG8_BAR; PG8_WAIT_L(0); PG8_MMA(1, 0, At, B0); PG8_BAR; PG8_SCHED;
      PG8_STAGE(PG8_SB(0, 1), b2 + hstepB, voffB);
      PG8_WAIT_V(6); PG8_BAR; PG8_MMA(1, 1, At, B1); PG8_BAR;
      PG8_LDB(B0, 1, 0); PG8_SCHED; PG8_LDA(At, 1, 0); PG8_STAGE(PG8_SA(0, 1), a2 + hstepA, voffA);
      PG8_WAIT_L(8); PG8_BAR; PG8_WAIT_L(0); PG8_MMA(0, 0, At, B0); PG8_BAR; PG8_SCHED;
      PG8_LDB(B1, 1, 1); PG8_STAGE(PG8_SB(1, 0), b3, voffB);
      PG8_BAR; PG8_WAIT_L(0); PG8_MMA(0, 1, At, B1); PG8_BAR;
      PG8_LDA(At, 1, 1); PG8_STAGE(PG8_SA(1, 0), a3, voffA);
      PG8_BAR; PG8_WAIT_L(0); PG8_MMA(1, 0, At, B0); PG8_BAR; PG8_SCHED;
      PG8_STAGE(PG8_SB(1, 1), b3 + hstepB, voffB);
      PG8_WAIT_V(6); PG8_BAR; PG8_MMA(1, 1, At, B1); PG8_BAR;
    }
    E(acc, cur, wr, wc, fr, fq);
    if (!has_next) break;
#pragma unroll
    for (int a = 0; a < 2; ++a)
#pragma unroll
      for (int b = 0; b < 2; ++b)
#pragma unroll
        for (int m = 0; m < 4; ++m)
#pragma unroll
          for (int n = 0; n < 2; ++n) acc[a][b][m][n] = (f32x4){0.f, 0.f, 0.f, 0.f};
    cur = nxt; cA = nA; cB = nB; ++ui;
  }
  PG8_WAIT_V(0);
  if (wr == 0) PG8_BAR;
  PG8_BAR;
#undef PG8_SA
#undef PG8_SB
#undef PG8_STAGE
#undef PG8_LDA
#undef PG8_LDB
#undef PG8_MMA
#undef PG8_WAIT_V
#undef PG8_WAIT_L
#undef PG8_BAR
#undef PG8_SCHED
}
}

struct EpiProj {
  static constexpr bool PERM = true;
  bf16_t* O; float* side; int ldc, nmain;
  DI void operator()(const f32x4 (&acc)[2][2][4][2], const pg8::Unit& u, int wr, int wc, int fr, int fq) const {
    const int row0 = u.pm * 256 + wr * 64 + fr;
    if (u.pn < nmain) {
      const int col0 = u.pn * 256 + wc * 32 + 8 * fq;
#pragma unroll
      for (int ai = 0; ai < 2; ++ai)
#pragma unroll
        for (int m = 0; m < 4; ++m) { bf16_t* rowp = O + (size_t)(row0 + ai * 128 + m * 16) * ldc + col0;
#pragma unroll
          for (int bj = 0; bj < 2; ++bj) { const f32x4 v0 = acc[ai][bj][m][0], v1 = acc[ai][bj][m][1];
            u32x4 w; w.x = pk2(v0[0], v0[1]); w.y = pk2(v0[2], v0[3]); w.z = pk2(v1[0], v1[1]); w.w = pk2(v1[2], v1[3]);
            *(u32x4*)(rowp + bj * 128) = w; } }
    } else if (wc == 0 && fq < 2) {
#pragma unroll
      for (int ai = 0; ai < 2; ++ai)
#pragma unroll
        for (int m = 0; m < 4; ++m) { float* sp = side + (size_t)(row0 + ai * 128 + m * 16) * 16 + 8 * fq;
          *(f32x4*)sp = acc[ai][0][m][0]; *(f32x4*)(sp + 4) = acc[ai][0][m][1]; }
    }
  }
};
struct EpiGate {
  static constexpr bool PERM = true;
  bf16_t* O; const bf16_t* proj; int br;
  DI void operator()(const f32x4 (&acc)[2][2][4][2], const pg8::Unit& u, int wr, int wc, int fr, int fq) const {
    const int row0 = u.pm * 256 + wr * 64 + fr, col0 = u.pn * 256 + wc * 32 + 8 * fq;
#pragma unroll
    for (int ai = 0; ai < 2; ++ai)
#pragma unroll
      for (int m = 0; m < 4; ++m) { const int row = row0 + ai * 128 + m * 16;
        bf16_t* rowp = O + (size_t)row * DM + col0; const bf16_t* gp = proj + (size_t)row * LDP + 12288 + br * 2048 + col0;
#pragma unroll
        for (int bj = 0; bj < 2; ++bj) { const f32x4 v0 = acc[ai][bj][m][0], v1 = acc[ai][bj][m][1];
          float gt[8], v[8]; unpack8(*(const u32x4*)(gp + bj * 128), gt);
#pragma unroll
          for (int j = 0; j < 4; ++j) { v[j] = v0[j] * sigmoidf_(gt[j]); v[4 + j] = v1[j] * sigmoidf_(gt[4 + j]); }
          if (br > 0) { float pv[8]; unpack8(*(const u32x4*)(rowp + bj * 128), pv);
#pragma unroll
            for (int j = 0; j < 8; ++j) v[j] += pv[j]; }
          *(u32x4*)(rowp + bj * 128) = pack8(v); } }
  }
};
struct EpiF32 {
  static constexpr bool PERM = false;
  float* C;
  DI void operator()(const f32x4 (&acc)[2][2][4][2], const pg8::Unit& u, int wr, int wc, int fr, int fq) const {
    const int row0 = u.pm * 256 + wr * 64 + fr, col0 = u.pn * 256 + wc * 32 + 4 * fq;
#pragma unroll
    for (int ai = 0; ai < 2; ++ai)
#pragma unroll
      for (int m = 0; m < 4; ++m) { float* rowp = C + (size_t)(row0 + ai * 128 + m * 16) * DM + col0;
#pragma unroll
        for (int bj = 0; bj < 2; ++bj)
#pragma unroll
          for (int n = 0; n < 2; ++n) *(f32x4*)(rowp + bj * 128 + n * 16) = acc[ai][bj][m][n]; }
  }
};

DI void conv_tile(float* T, const float* src, int ldsrc, int n0, int nvalid, int k0, bf16_t* dst, int K) {
  const int tid = otid();
  f32x4 v[8];
#pragma unroll
  for (int ps = 0; ps < 8; ++ps) { const int k = ps * 8 + (tid >> 6), c4 = (tid & 63) * 4;
    v[ps] = (f32x4){0.f, 0.f, 0.f, 0.f};
    if (c4 < nvalid) v[ps] = *(const f32x4*)(src + (size_t)(k0 + k) * ldsrc + n0 + c4); }
#pragma unroll
  for (int ps = 0; ps < 8; ++ps) { const int k = ps * 8 + (tid >> 6), c4 = (tid & 63) * 4;
    T[k * 257 + c4] = v[ps][0]; T[k * 257 + c4 + 1] = v[ps][1]; T[k * 257 + c4 + 2] = v[ps][2]; T[k * 257 + c4 + 3] = v[ps][3]; }
  __syncthreads();
#pragma unroll
  for (int i = 0; i < 4; ++i) { const int n = (tid >> 3) + 64 * i, kg = tid & 7; float w[8];
#pragma unroll
    for (int j = 0; j < 8; ++j) w[j] = T[(8 * kg + j) * 257 + n];
    *(u32x4*)(dst + (size_t)n * K + k0 + 8 * kg) = pack8(w); }
  __syncthreads();
}
DI void convert_weights(const Params& p, int l, float* T, int part, int first, int stride) {
  bf16_t* win = (bf16_t*)(p.ws + OFF_WIN); bf16_t* wbr = (bf16_t*)(p.ws + OFF_WBR); bf16_t* wout = (bf16_t*)(p.ws + OFF_WOUT);
  const int n_in = 73 * 32, n_br = 3 * 8 * 16, n_out = 8 * 32;
  const int t_lo = (part == 1) ? n_in + n_br : 0, t_hi = (part == 0) ? n_in + n_br : n_in + n_br + n_out;
  for (int t = t_lo + first; t < t_hi; t += stride) {
    if (t < n_in) { const int ntile = t >> 5, kt = t & 31, np0 = ntile * 256; int n0 = 0, nv = 256;
      if (np0 < 8192) n0 = np0; else if (np0 < 18432) n0 = np0 + 16; else { n0 = 8192; nv = 16; }
      conv_tile(T, p.w_in + (size_t)l * DM * NIN, NIN, n0, nv, kt * 64, win + (size_t)np0 * DM, DM);
    } else if (t < n_in + n_br) { const int u = t - n_in, br = u >> 7, r = u & 127, ntile = r >> 4, kt = r & 15;
      const float* src = (br == 0 ? p.w_ba : br == 1 ? p.w_bb : p.w_bc) + (size_t)l * 1024 * DM;
      conv_tile(T, src, DM, ntile * 256, 256, kt * 64, wbr + (size_t)br * DM * 1024 + (size_t)ntile * 256 * 1024, 1024);
    } else { const int u = t - n_in - n_br, ntile = u >> 5, kt = u & 31;
      conv_tile(T, p.w_out + (size_t)l * DM * DM, DM, ntile * 256, 256, kt * 64, wout + (size_t)ntile * 256 * DM, DM); }
  }
}

DI void prenorm_phase(const Params& p, int l) {
  bf16_t* h = (bf16_t*)(p.ws + OFF_H); const float* g = p.norm_pre + (size_t)l * DM;
  const int tid_ = otid(); const int lane = tid_ & 63, gw = blockIdx.x * 8 + (tid_ >> 6), nw = gridDim.x * 8;
  for (int r = gw; r < MROWS; r += nw) {
    const float* xr = (r < 16384) ? p.x_prompt + (size_t)r * DM : p.x_sample + (size_t)(r - 16384) * DM;
    f32x4 v[8]; float ss = 0.f;
#pragma unroll
    for (int i = 0; i < 8; ++i) { v[i] = *(const f32x4*)(xr + i * 256 + lane * 4); ss += v[i][0] * v[i][0] + v[i][1] * v[i][1] + v[i][2] * v[i][2] + v[i][3] * v[i][3]; }
    ss = wsum(ss); const float rn = rsqrtf(ss * (1.f / DM) + 1e-6f);
#pragma unroll
    for (int i = 0; i < 8; ++i) { const f32x4 gg = *(const f32x4*)(g + i * 256 + lane * 4);
      u32x2 w; w.x = pk2(v[i][0] * rn * gg[0], v[i][1] * rn * gg[1]); w.y = pk2(v[i][2] * rn * gg[2], v[i][3] * rn * gg[3]);
      *(u32x2*)(h + (size_t)r * DM + i * 256 + lane * 4) = w; }
  }
}
DI void postnorm_phase(const Params& p, int l) {
  bf16_t* h = (bf16_t*)(p.ws + OFF_H); const float* ypre = (const float*)(p.ws + OFF_M1 + 69206016);
  const float* gpost = p.norm_post + (size_t)l * DM; const float* gpre = p.norm_pre + (size_t)(l + 1) * DM;
  const int tid_ = otid(); const int lane = tid_ & 63, gw = blockIdx.x * 8 + (tid_ >> 6), nw = gridDim.x * 8;
  for (int r = gw; r < MROWS; r += nw) {
    const float* xr = (l > 0) ? p.out + (size_t)r * DM : ((r < 16384) ? p.x_prompt + (size_t)r * DM : p.x_sample + (size_t)(r - 16384) * DM);
    const float* yr = ypre + (size_t)r * DM;
    f32x4 v[8]; float ss = 0.f;
#pragma unroll
    for (int i = 0; i < 8; ++i) { v[i] = __builtin_nontemporal_load((const f32x4*)(yr + i * 256 + lane * 4)); ss += v[i][0] * v[i][0] + v[i][1] * v[i][1] + v[i][2] * v[i][2] + v[i][3] * v[i][3]; }
    ss = wsum(ss); const float rn = rsqrtf(ss * (1.f / DM) + 1e-6f); float s2 = 0.f;
#pragma unroll
    for (int i = 0; i < 8; ++i) { const f32x4 gg = *(const f32x4*)(gpost + i * 256 + lane * 4); const f32x4 xx = *(const f32x4*)(xr + i * 256 + lane * 4);
#pragma unroll
      for (int j = 0; j < 4; ++j) { v[i][j] = xx[j] + v[i][j] * rn * gg[j]; s2 += v[i][j] * v[i][j]; }
      *(f32x4*)(p.out + (size_t)r * DM + i * 256 + lane * 4) = v[i]; }
    if (l == 0) { s2 = wsum(s2); const float r2 = rsqrtf(s2 * (1.f / DM) + 1e-6f);
#pragma unroll
      for (int i = 0; i < 8; ++i) { const f32x4 gg = *(const f32x4*)(gpre + i * 256 + lane * 4);
        u32x2 w; w.x = pk2(v[i][0] * r2 * gg[0], v[i][1] * r2 * gg[1]); w.y = pk2(v[i][2] * r2 * gg[2], v[i][3] * r2 * gg[3]);
        *(u32x2*)(h + (size_t)r * DM + i * 256 + lane * 4) = w; } }
  }
}

template <class F> DI void write_T_perm(bf16_t* dst, F&& val) {
  const int t = otid(), r = t >> 2, q4 = t & 3, tb = q4 >> 1, p0 = 16 * (q4 & 1);
  float v[16];
#pragma unroll
  for (int j = 0; j < 16; ++j) v[j] = val(32 * tb + kperm(p0 + j), r);
  *(u32x4*)(dst + r * 64 + 32 * tb + p0) = pack8(v); *(u32x4*)(dst + r * 64 + 32 * tb + p0 + 8) = pack8(v + 8);
}
template <class F> DI void write_perm(bf16_t* dst, F&& val) {
  const int t = otid(), tok = t >> 3, cgp = t & 7, db = cgp >> 1, p0 = 16 * (cgp & 1);
  float v[16];
#pragma unroll
  for (int j = 0; j < 16; ++j) v[j] = val(tok, 32 * db + kperm(p0 + j));
  *(u32x4*)(dst + tok * 128 + 32 * db + p0) = pack8(v); *(u32x4*)(dst + tok * 128 + 32 * db + p0 + 8) = pack8(v + 8);
}

DI void conv16(const Params& p, const bf16_t* proj, int l, int ci, int ch0, int tok, float (&y)[16]) {
  const float* cw = p.conv_w + (size_t)l * 4 * 3072 + ch0;
#pragma unroll
  for (int c = 0; c < 16; ++c) y[c] = 0.f;
#pragma unroll
  for (int o = 0; o < 4; ++o) {
    const int t = tok - 3 + o; float xv[16];
    if (t >= 0 || (ci < 256 && (ci & 63) != 0)) {
      const bf16_t* src = proj + (size_t)(ci * 64 + t) * LDP + 4096 + ch0;
      unpack8(*(const u32x4*)src, xv); unpack8(*(const u32x4*)(src + 8), xv + 8);
    } else if (ci >= 256) {
      const float* sc = p.state_conv + ((size_t)(l * 8 + (ci - 256)) * 3 + (3 + t)) * 3072 + ch0;
#pragma unroll
      for (int q = 0; q < 4; ++q) { const f32x4 a = *(const f32x4*)(sc + 4 * q); xv[4 * q] = a[0]; xv[4 * q + 1] = a[1]; xv[4 * q + 2] = a[2]; xv[4 * q + 3] = a[3]; }
    } else {
#pragma unroll
      for (int c = 0; c < 16; ++c) xv[c] = 0.f;
    }
#pragma unroll
    for (int q = 0; q < 4; ++q) { const f32x4 w = *(const f32x4*)(cw + o * 3072 + 4 * q);
      y[4 * q] += w[0] * xv[4 * q]; y[4 * q + 1] += w[1] * xv[4 * q + 1]; y[4 * q + 2] += w[2] * xv[4 * q + 2]; y[4 * q + 3] += w[3] * xv[4 * q + 3]; }
  }
#pragma unroll
  for (int c = 0; c < 16; ++c) y[c] = siluf_(y[c]);
}

DI void conv_fetch(const Params& p, const bf16_t* proj, int l, int ci, int hh, int cgp, int tok, u32x4 (&raw)[3][4][2]) {
#pragma unroll
  for (int o = 0; o < 4; ++o) {
    const int t = tok - 3 + o;
#pragma unroll
    for (int mat = 0; mat < 3; ++mat) {
      const int ch0 = mat * 1024 + hh * 128 + 16 * cgp;
      if (t >= 0 || (ci < 256 && (ci & 63) != 0)) {
        const bf16_t* src = proj + (size_t)(ci * 64 + t) * LDP + 4096 + ch0;
        raw[mat][o][0] = *(const u32x4*)src; raw[mat][o][1] = *(const u32x4*)(src + 8);
      } else if (ci >= 256) {
        const float* sc = p.state_conv + ((size_t)(l * 8 + (ci - 256)) * 3 + (3 + t)) * 3072 + ch0; float f[16];
#pragma unroll
        for (int q = 0; q < 4; ++q) { const f32x4 a = *(const f32x4*)(sc + 4 * q); f[4 * q] = a[0]; f[4 * q + 1] = a[1]; f[4 * q + 2] = a[2]; f[4 * q + 3] = a[3]; }
        raw[mat][o][0] = pack8(f); raw[mat][o][1] = pack8(f + 8);
      } else { raw[mat][o][0] = (u32x4){0u, 0u, 0u, 0u}; raw[mat][o][1] = (u32x4){0u, 0u, 0u, 0u}; }
    }
  }
}
DI void conv_apply(const float* sCW, int mat, int cgp, const u32x4 (&raw)[3][4][2], float (&y)[16]) {
#pragma unroll
  for (int c = 0; c < 16; ++c) y[c] = 0.f;
#pragma unroll
  for (int o = 0; o < 4; ++o) { float xv[16]; unpack8(raw[mat][o][0], xv); unpack8(raw[mat][o][1], xv + 8);
#pragma unroll
    for (int q = 0; q < 4; ++q) { const f32x4 w = *(const f32x4*)(sCW + (mat * 4 + o) * 128 + 16 * cgp + 4 * q);
      y[4 * q] += w[0] * xv[4 * q]; y[4 * q + 1] += w[1] * xv[4 * q + 1]; y[4 * q + 2] += w[2] * xv[4 * q + 2]; y[4 * q + 3] += w[3] * xv[4 * q + 3]; } }
#pragma unroll
  for (int c = 0; c < 16; ++c) y[c] = siluf_(y[c]);
}

DI void delta_pre(const Params& p, int l, int it, unsigned char* smem) {
  const int ci = it >> 3, hh = it & 7, tid = otid(), wid = tid >> 6, lane = tid & 63, fr = lane & 15, fq = lane >> 4;
  bf16_t* sKB = (bf16_t*)smem; bf16_t* sQB = (bf16_t*)(smem + 17408); float* sKF = (float*)(smem + 34816); float* sVF = (float*)(smem + 68608);
  float* sA = (float*)(smem + 102400); float* sGC = (float*)(smem + 118784); float* sBT = sGC + 64; float* sEG = sGC + 128; float* sR1 = sGC + 192;
  const bf16_t* proj = (const bf16_t*)(p.ws + OFF_PROJ); const float* side = (const float*)(p.ws + OFF_SIDE);
  bf16_t* m1 = (bf16_t*)(p.ws + OFF_M1);
  bf16_t* dW = m1 + 0 * M1_BLK + (size_t)it * 8192; bf16_t* dQ = m1 + 1 * M1_BLK + (size_t)it * 8192; bf16_t* dKT = m1 + 2 * M1_BLK + (size_t)it * 8192;
  bf16_t* dUT = m1 + 3 * M1_BLK + (size_t)it * 8192; bf16_t* dIN = m1 + 8 * M1_BLK + (size_t)it * 4096;
  if (wid == 0) {
    const int row = ci * 64 + lane;
    const float bl = side[(size_t)row * 16 + hh], al = side[(size_t)row * 16 + 8 + hh] + p.dt_bias[l * 8 + hh];
    const float sp = al > 20.f ? al : log1pf(__expf(al));
    float g = -__expf(p.a_log[l * 8 + hh]) * sp;
#pragma unroll
    for (int o = 1; o < 64; o <<= 1) { const float t = __shfl_up(g, o); if (lane >= o) g += t; }
    const float bt = sigmoidf_(bl), eg = __expf(g);
    sGC[lane] = g; sBT[lane] = bt; sEG[lane] = eg; sR1[lane] = bt * eg;
    if (lane == 63) ((float*)(p.ws + OFF_DG))[it] = eg;
  }
  { const int tok = tid >> 3, cgp = tid & 7; float y[16]; const float* sCW = (const float*)(smem + 122880);
    u32x4 raw[3][4][2]; conv_fetch(p, proj, l, ci, hh, cgp, tok, raw);
    conv_apply(sCW, 0, cgp, raw, y);
    { float ss = 0.f;
#pragma unroll
      for (int c = 0; c < 16; ++c) ss += y[c] * y[c];
      ss += __shfl_xor(ss, 1); ss += __shfl_xor(ss, 2); ss += __shfl_xor(ss, 4);
      const float rn = rsqrtf(ss + 1e-6f) * 0.08838834764831845f;
#pragma unroll
      for (int c = 0; c < 16; ++c) y[c] *= rn;
      *(u32x4*)(sQB + tok * 136 + 16 * cgp) = pack8(y); *(u32x4*)(sQB + tok * 136 + 16 * cgp + 8) = pack8(y + 8); }
    conv_apply(sCW, 1, cgp, raw, y);
    { float ss = 0.f;
#pragma unroll
      for (int c = 0; c < 16; ++c) ss += y[c] * y[c];
      ss += __shfl_xor(ss, 1); ss += __shfl_xor(ss, 2); ss += __shfl_xor(ss, 4);
      const float rn = rsqrtf(ss + 1e-6f);
#pragma unroll
      for (int c = 0; c < 16; ++c) { y[c] *= rn; sKF[tok * 132 + 16 * cgp + c] = y[c]; }
      *(u32x4*)(sKB + tok * 136 + 16 * cgp) = pack8(y); *(u32x4*)(sKB + tok * 136 + 16 * cgp + 8) = pack8(y + 8); }
    conv_apply(sCW, 2, cgp, raw, y);
#pragma unroll
    for (int c = 0; c < 16; ++c) sVF[tok * 132 + 16 * cgp + c] = y[c];
  }
  __syncthreads();
  {
    const int mt = wid & 3; const bf16_t* Asrc = (wid < 4) ? sKB : sQB;
    bf16x8 a[4];
#pragma unroll
    for (int s = 0; s < 4; ++s) a[s] = *(const bf16x8*)(Asrc + (16 * mt + fr) * 136 + 32 * s + 8 * fq);
#pragma unroll
    for (int nt = 0; nt < 4; ++nt) {
      f32x4 c = {0.f, 0.f, 0.f, 0.f};
#pragma unroll
      for (int s = 0; s < 4; ++s) { const bf16x8 b = *(const bf16x8*)(sKB + (16 * nt + fr) * 136 + 32 * s + 8 * fq); c = MFMA16(a[s], b, c); }
      const int j = 16 * nt + fr; const float gj = sGC[j];
#pragma unroll
      for (int r = 0; r < 4; ++r) { const int i = 16 * mt + 4 * fq + r; const float gi = sGC[i]; const float dec = __expf(fminf(gi - gj, 0.f));
        if (wid < 4) sA[i * 64 + j] = (i > j) ? sBT[i] * c[r] * dec : 0.f;
        else dIN[i * 64 + (j & 32) + kinv(j & 31)] = f2bf((i >= j) ? c[r] * dec : 0.f); }
    }
  }
  __syncthreads();
  if (wid < 4) {
    int zv = 0; asm volatile("" : "+v"(zv));
    const int c = tid; const float* src = (c < 128) ? sVF + c : sKF + (c - 128); const float* scl = ((c < 128) ? sBT : sR1) + zv; const float* sAz = sA + zv;
    float sol[64];
    f32x2 sp[32];
#pragma unroll
    for (int i = 0; i < 32; ++i) sp[i] = (f32x2){0.f, 0.f};
#pragma unroll
    for (int i = 0; i < 64; ++i) {
      f32x2 a0 = {src[i * 132] * scl[i], 0.f}, a1 = {0.f, 0.f};
#pragma unroll
      for (int j4 = 0; j4 < (i + 3) / 4; ++j4) { const f32x4 a = *(const f32x4*)(sAz + i * 64 + 4 * j4);
        a0 -= (f32x2){a[0], a[1]} * sp[2 * j4]; a1 -= (f32x2){a[2], a[3]} * sp[2 * j4 + 1]; }
      const f32x2 t = a0 + a1; const float r = t[0] + t[1];
      sol[i] = r; sp[i >> 1][i & 1] = r;
    }
    if (c < 128) {
#pragma unroll
      for (int q = 0; q < 8; ++q) *(u32x4*)(dUT + c * 64 + 8 * q) = pack8(sol + 8 * q);
    } else { const int d = c - 128, pos = (d & ~31) + kinv(d & 31);
#pragma unroll
      for (int i = 0; i < 64; ++i) dW[i * 128 + pos] = f2bf(-sol[i]); }
  } else {
    const int t = tid - 256; const float gl = sGC[63];
    { const int tok = t >> 2, db = t & 3; const float eg = sEG[tok]; float v[32];
#pragma unroll
      for (int pp = 0; pp < 32; ++pp) v[pp] = bf2f(sQB[tok * 136 + 32 * db + kperm(pp)]) * eg;
#pragma unroll
      for (int q = 0; q < 4; ++q) *(u32x4*)(dQ + tok * 128 + 32 * db + 8 * q) = pack8(v + 8 * q); }
    { const int d = t >> 1, tb = t & 1; float v[32];
#pragma unroll
      for (int pp = 0; pp < 32; ++pp) { const int tok = 32 * tb + kperm(pp); v[pp] = sKF[tok * 132 + d] * __expf(gl - sGC[tok]); }
#pragma unroll
      for (int q = 0; q < 4; ++q) *(u32x4*)(dKT + d * 64 + 32 * tb + 8 * q) = pack8(v + 8 * q); }
  }
  __syncthreads();
}

DI void ret_pre(const Params& p, int l, int it, unsigned char* smem) {
  const int ci = it >> 3, hh = it & 7, tid = otid(), wid = tid >> 6, lane = tid & 63, fr = lane & 15, fq = lane >> 4;
  bf16_t* sQB = (bf16_t*)smem; bf16_t* sKB = (bf16_t*)(smem + 17408); float* sKZ = (float*)(smem + 34816); float* sVF = (float*)(smem + 68608);
  const bf16_t* proj = (const bf16_t*)(p.ws + OFF_PROJ);
  bf16_t* m1 = (bf16_t*)(p.ws + OFF_M1);
  bf16_t* rQ = m1 + 4 * M1_BLK + (size_t)it * 8192; bf16_t* rKT = m1 + 5 * M1_BLK + (size_t)it * 8192; bf16_t* rVT = m1 + 6 * M1_BLK + (size_t)it * 8192;
  bf16_t* rIN = m1 + 8 * M1_BLK + (size_t)NITEM * 4096 + (size_t)it * 4096;
  const float lg = __logf(1.f - exp2f(-5.f - (float)hh));
  { const int tok = tid >> 3, cgp = tid & 7; const bf16_t* rp = proj + (size_t)(ci * 64 + tok) * LDP;
    const int pos = (ci >= 256) ? 2048 + tok : (ci & 63) * 64 + tok;
    float q1[8], q2[8], k1[8], k2[8], vv[16];
    unpack8(*(const u32x4*)(rp + 8192 + hh * 128 + 8 * cgp), q1); unpack8(*(const u32x4*)(rp + 8192 + hh * 128 + 64 + 8 * cgp), q2);
    unpack8(*(const u32x4*)(rp + 9216 + hh * 128 + 8 * cgp), k1); unpack8(*(const u32x4*)(rp + 9216 + hh * 128 + 64 + 8 * cgp), k2);
    unpack8(*(const u32x4*)(rp + 10240 + hh * 128 + 16 * cgp), vv); unpack8(*(const u32x4*)(rp + 10240 + hh * 128 + 16 * cgp + 8), vv + 8);
    const float zeta = __expf(lg * (float)(63 - tok)) * 0.08838834764831845f;
    float qa[8], qb[8], ka[8], kb[8];
#pragma unroll
    for (int j = 0; j < 8; ++j) { const int i = 8 * cgp + j;
      const float inv = exp2f(-(float)i * (13.287712379549449f / 64.f)); const float ang = (float)pos * inv;
      float rv = ang * 0.15915494309189535f; rv = rv - floorf(rv);
      const float sn = __builtin_amdgcn_sinf(rv), cs = __builtin_amdgcn_cosf(rv);
      qa[j] = q1[j] * cs - q2[j] * sn; qb[j] = q1[j] * sn + q2[j] * cs;
      ka[j] = (k1[j] * cs - k2[j] * sn); kb[j] = (k1[j] * sn + k2[j] * cs);
      sKZ[tok * 132 + i] = ka[j] * zeta; sKZ[tok * 132 + 64 + i] = kb[j] * zeta;
      ka[j] *= 0.08838834764831845f; kb[j] *= 0.08838834764831845f; }
    *(u32x4*)(sQB + tok * 136 + 8 * cgp) = pack8(qa); *(u32x4*)(sQB + tok * 136 + 64 + 8 * cgp) = pack8(qb);
    *(u32x4*)(sKB + tok * 136 + 8 * cgp) = pack8(ka); *(u32x4*)(sKB + tok * 136 + 64 + 8 * cgp) = pack8(kb);
#pragma unroll
    for (int c = 0; c < 16; ++c) sVF[tok * 132 + 16 * cgp + c] = vv[c];
  }
  __syncthreads();
  { const int mt = wid >> 1;
    bf16x8 a[4];
#pragma unroll
    for (int s = 0; s < 4; ++s) a[s] = *(const bf16x8*)(sQB + (16 * mt + fr) * 136 + 32 * s + 8 * fq);
#pragma unroll
    for (int n2 = 0; n2 < 2; ++n2) { const int nt = 2 * (wid & 1) + n2;
      f32x4 c = {0.f, 0.f, 0.f, 0.f};
#pragma unroll
      for (int s = 0; s < 4; ++s) { const bf16x8 b = *(const bf16x8*)(sKB + (16 * nt + fr) * 136 + 32 * s + 8 * fq); c = MFMA16(a[s], b, c); }
      const int j = 16 * nt + fr;
#pragma unroll
      for (int r = 0; r < 4; ++r) { const int i = 16 * mt + 4 * fq + r;
        rIN[i * 64 + (j & 32) + kinv(j & 31)] = f2bf((i >= j) ? c[r] * __expf(lg * (float)(i - j)) : 0.f); }
    }
  }
  write_perm(rQ, [&](int tok, int d) { return bf2f(sQB[tok * 136 + d]) * __expf(lg * (float)(tok + 1)); });
  write_T_perm(rKT, [&](int tok, int d) { return sKZ[tok * 132 + d]; });
  write_T_perm(rVT, [&](int tok, int e) { return sVF[tok * 132 + e]; });
  __syncthreads();
}

DI void misc_item(const Params& p, int l, int it, unsigned char* smem) {
  const int ci = it >> 3, hh = it & 7, tid = otid();
  bf16_t* sVB = (bf16_t*)smem;
  const bf16_t* proj = (const bf16_t*)(p.ws + OFF_PROJ);
  bf16_t* aVT = (bf16_t*)(p.ws + OFF_M1) + 7 * M1_BLK + (size_t)it * 8192;
  { const int tok = tid >> 3, cgp = tid & 7; const bf16_t* rp = proj + (size_t)(ci * 64 + tok) * LDP;
    const u32x4 v0 = *(const u32x4*)(rp + 2048 + hh * 128 + 16 * cgp), v1 = *(const u32x4*)(rp + 2048 + hh * 128 + 16 * cgp + 8);
    *(u32x4*)(sVB + tok * 136 + 16 * cgp) = v0; *(u32x4*)(sVB + tok * 136 + 16 * cgp + 8) = v1;
    float* ok = nullptr; float* ov = nullptr;
    if (ci < 256) { const int b = ci >> 6, c = ci & 63;
      if (c >= 56) { const size_t o = ((((size_t)l * 4 + b) * 512 + (c - 56) * 64 + tok) * 8 + hh) * 128 + 16 * cgp; ok = p.out + O_PK + o; ov = p.out + O_PV + o; }
    } else { const size_t o = ((((size_t)l * 8 + (ci - 256)) * 512 + 448 + tok) * 8 + hh) * 128 + 16 * cgp; ok = p.out + O_SK + o; ov = p.out + O_SV + o; }
    if (ok) { float f[16]; unpack8(v0, f); unpack8(v1, f + 8);
#pragma unroll
      for (int q = 0; q < 4; ++q) *(f32x4*)(ov + 4 * q) = (f32x4){f[4 * q], f[4 * q + 1], f[4 * q + 2], f[4 * q + 3]};
      unpack8(*(const u32x4*)(rp + 1024 + hh * 128 + 16 * cgp), f); unpack8(*(const u32x4*)(rp + 1024 + hh * 128 + 16 * cgp + 8), f + 8);
#pragma unroll
      for (int q = 0; q < 4; ++q) *(f32x4*)(ok + 4 * q) = (f32x4){f[4 * q], f[4 * q + 1], f[4 * q + 2], f[4 * q + 3]}; }
  }
  if (ci >= 256 || (ci & 63) == 63) {
    float* oc = (ci < 256) ? p.out + O_PC + ((size_t)l * 4 + (ci >> 6)) * 3 * 3072 : p.out + O_SC + ((size_t)l * 8 + (ci - 256)) * 3 * 3072;
    for (int idx = tid; idx < 3 * 384; idx += 512) { const int rr = idx / 384, ch = hh * 384 + idx % 384;
      oc[rr * 3072 + ch] = bf2f(proj[(size_t)(ci * 64 + 61 + rr) * LDP + 4096 + ch]); }
  }
  __syncthreads();
  write_T_perm(aVT, [&](int tok, int e) { return bf2f(sVB[tok * 136 + e]); });
  __syncthreads();
}
DI void cache_item(const Params& p, int l, int cit, unsigned char* smem) {
  const int hh = cit & 7, j = (cit >> 3) & 7, sb = cit >> 6, tid = otid();
  float* sVF = (float*)smem;
  bf16_t* kc = (bf16_t*)(p.ws + OFF_KC) + (size_t)cit * 8192; bf16_t* cvt = (bf16_t*)(p.ws + OFF_CVT) + (size_t)cit * 8192;
  { const int key = tid >> 3, cgp = tid & 7;
    const size_t so = ((((size_t)l * 8 + sb) * 512 + 64 * j + key) * 8 + hh) * 128 + 16 * cgp;
    float fk[16], fv[16];
#pragma unroll
    for (int q = 0; q < 4; ++q) { const f32x4 a = *(const f32x4*)(p.cache_k + so + 4 * q); const f32x4 b = *(const f32x4*)(p.cache_v + so + 4 * q);
#pragma unroll
      for (int e = 0; e < 4; ++e) { fk[4 * q + e] = a[e]; fv[4 * q + e] = b[e]; } }
    *(u32x4*)(kc + key * 128 + 16 * cgp) = pack8(fk); *(u32x4*)(kc + key * 128 + 16 * cgp + 8) = pack8(fk + 8);
#pragma unroll
    for (int c = 0; c < 16; ++c) sVF[key * 132 + 16 * cgp + c] = fv[c];
    if (j >= 1) { const size_t oo = ((((size_t)l * 8 + sb) * 512 + 64 * (j - 1) + key) * 8 + hh) * 128 + 16 * cgp;
#pragma unroll
      for (int q = 0; q < 4; ++q) { *(f32x4*)(p.out + O_SK + oo + 4 * q) = (f32x4){fk[4 * q], fk[4 * q + 1], fk[4 * q + 2], fk[4 * q + 3]};
        *(f32x4*)(p.out + O_SV + oo + 4 * q) = (f32x4){fv[4 * q], fv[4 * q + 1], fv[4 * q + 2], fv[4 * q + 3]}; } }
  }
  __syncthreads();
  write_T_perm(cvt, [&](int tok, int e) { return sVF[tok * 132 + e]; });
  __syncthreads();
}

template <int TYPE> DI void scan_item(const Params& p, int l, int seq, int hh, int sl) {
  const int lane = otid() & 63, fr = lane & 15, fq = lane >> 4, e0 = 16 * sl;
  const int nsteps = seq < 4 ? 64 : 1, ci0 = seq < 4 ? seq * 64 : 256 + (seq - 4);
  const bf16_t* m1 = (const bf16_t*)(p.ws + OFF_M1);
  bf16_t* proj = (bf16_t*)(p.ws + OFF_PROJ);
  const float* dG = (const float*)(p.ws + OFF_DG);
  f32x4 S[8];
  if (seq < 4) {
#pragma unroll
    for (int t = 0; t < 8; ++t) S[t] = (f32x4){0.f, 0.f, 0.f, 0.f};
  } else { const float* st = (TYPE == 0 ? p.state_delta : p.state_ret) + (((size_t)l * 8 + (seq - 4)) * 8 + hh) * 16384 + e0 + fr;
#pragma unroll
    for (int t = 0; t < 8; ++t)
#pragma unroll
      for (int i = 0; i < 4; ++i) S[t][i] = st[(16 * t + 4 * fq + i) * 128]; }
  const float gret = __expf(64.f * __logf(1.f - exp2f(-5.f - (float)hh)));
  for (int n = 0; n < nsteps; ++n) {
    const int it = (ci0 + n) * 8 + hh;
    const bf16_t* W = m1 + 0 * M1_BLK + (size_t)it * 8192;
    const bf16_t* Q = m1 + (TYPE == 0 ? 1 : 4) * M1_BLK + (size_t)it * 8192;
    const bf16_t* KT = m1 + (TYPE == 0 ? 2 : 5) * M1_BLK + (size_t)it * 8192;
    const bf16_t* UT = m1 + (TYPE == 0 ? 3 : 6) * M1_BLK + (size_t)it * 8192;
    const bf16_t* IN = m1 + 8 * M1_BLK + (TYPE == 0 ? 0 : (size_t)NITEM * 4096) + (size_t)it * 4096;
    bf16x8 Sf[4];
#pragma unroll
    for (int s = 0; s < 4; ++s) Sf[s] = pack_frag(S[2 * s], S[2 * s + 1]);
    bf16x8 Vf[2];
    if (TYPE == 0) {
      f32x4 Vn[4];
#pragma unroll
      for (int mt = 0; mt < 4; ++mt) { const u32x2 u = *(const u32x2*)(UT + (e0 + fr) * 64 + 16 * mt + 4 * fq); Vn[mt] = (f32x4){bflo(u.x), bfhi(u.x), bflo(u.y), bfhi(u.y)}; }
#pragma unroll
      for (int s = 0; s < 4; ++s)
#pragma unroll
        for (int mt = 0; mt < 4; ++mt) { const bf16x8 a = *(const bf16x8*)(W + (16 * mt + fr) * 128 + 32 * s + 8 * fq); Vn[mt] = MFMA16(a, Sf[s], Vn[mt]); }
      Vf[0] = pack_frag(Vn[0], Vn[1]); Vf[1] = pack_frag(Vn[2], Vn[3]);
    } else {
      Vf[0] = *(const bf16x8*)(UT + (e0 + fr) * 64 + 8 * fq); Vf[1] = *(const bf16x8*)(UT + (e0 + fr) * 64 + 32 + 8 * fq);
    }
    f32x4 O[4];
#pragma unroll
    for (int nt = 0; nt < 4; ++nt) O[nt] = (f32x4){0.f, 0.f, 0.f, 0.f};
#pragma unroll
    for (int s = 0; s < 4; ++s)
#pragma unroll
      for (int nt = 0; nt < 4; ++nt) { const bf16x8 b = *(const bf16x8*)(Q + (16 * nt + fr) * 128 + 32 * s + 8 * fq); O[nt] = MFMA16(Sf[s], b, O[nt]); }
#pragma unroll
    for (int s2 = 0; s2 < 2; ++s2)
#pragma unroll
      for (int nt = 0; nt < 4; ++nt) { const bf16x8 b = *(const bf16x8*)(IN + (16 * nt + fr) * 64 + 32 * s2 + 8 * fq); O[nt] = MFMA16(Vf[s2], b, O[nt]); }
#pragma unroll
    for (int nt = 0; nt < 4; ++nt) { u32x2 w; w.x = pk2(O[nt][0], O[nt][1]); w.y = pk2(O[nt][2], O[nt][3]);
      *(u32x2*)(proj + (size_t)((ci0 + n) * 64 + 16 * nt + fr) * LDP + (TYPE == 0 ? C_OBRAW : C_OCRAW) + hh * 128 + e0 + 4 * fq) = w; }
    const float gb = (TYPE == 0) ? dG[it] : gret;
#pragma unroll
    for (int dt = 0; dt < 8; ++dt) { S[dt] = S[dt] * gb;
#pragma unroll
      for (int s2 = 0; s2 < 2; ++s2) { const bf16x8 a = *(const bf16x8*)(KT + (16 * dt + fr) * 64 + 32 * s2 + 8 * fq); S[dt] = MFMA16(a, Vf[s2], S[dt]); } }
  }
  { float* so = p.out + (seq < 4 ? (TYPE == 0 ? O_PD : O_PR) + (((size_t)l * 4 + seq) * 8 + hh) * 16384 : (TYPE == 0 ? O_SD : O_SR) + (((size_t)l * 8 + (seq - 4)) * 8 + hh) * 16384) + e0 + fr;
#pragma unroll
    for (int t = 0; t < 8; ++t)
#pragma unroll
      for (int i = 0; i < 4; ++i) so[(16 * t + 4 * fq + i) * 128] = S[t][i]; }
}

template <int TYPE> DI void scan_step(const unsigned char* B, f32x4 (&S)[8], const u32x4 (&uc)[2], float gb, bf16_t* orow, int fr, int fq) {
#define SW_A128(base_, row_, s_) (*(const bf16x8*)((base_) + (((row_) * 16 + ((4 * (s_) + fq) ^ fr)) * 16)))
#define SW_A64(base_, row_, s_) (*(const bf16x8*)((base_) + (((row_) * 8 + ((4 * (s_) + fq) ^ (fr >> 1))) * 16)))
  bf16x8 Sf[4];
#pragma unroll
  for (int s = 0; s < 4; ++s) Sf[s] = pack_frag(S[2 * s], S[2 * s + 1]);
  bf16x8 Vf[2];
  if (TYPE == 0) {
    f32x4 Vn[4];
#pragma unroll
    for (int mt = 0; mt < 4; ++mt) { const unsigned ux = uc[mt >> 1][(mt & 1) * 2], uy = uc[mt >> 1][(mt & 1) * 2 + 1]; Vn[mt] = (f32x4){bflo(ux), bfhi(ux), bflo(uy), bfhi(uy)}; }
#pragma unroll
    for (int s = 0; s < 4; ++s)
#pragma unroll
      for (int mt = 0; mt < 4; ++mt) Vn[mt] = MFMA16(SW_A128(B, 16 * mt + fr, s), Sf[s], Vn[mt]);
    Vf[0] = pack_frag(Vn[0], Vn[1]); Vf[1] = pack_frag(Vn[2], Vn[3]);
  } else { Vf[0] = __builtin_bit_cast(bf16x8, uc[0]); Vf[1] = __builtin_bit_cast(bf16x8, uc[1]); }
  f32x4 O[4];
#pragma unroll
  for (int nt = 0; nt < 4; ++nt) O[nt] = (f32x4){0.f, 0.f, 0.f, 0.f};
#pragma unroll
  for (int s = 0; s < 4; ++s)
#pragma unroll
    for (int nt = 0; nt < 4; ++nt) O[nt] = MFMA16(Sf[s], SW_A128(B + 16384, 16 * nt + fr, s), O[nt]);
#pragma unroll
  for (int s2 = 0; s2 < 2; ++s2)
#pragma unroll
    for (int nt = 0; nt < 4; ++nt) O[nt] = MFMA16(Vf[s2], SW_A64(B + 49152, 16 * nt + fr, s2), O[nt]);
#pragma unroll
  for (int nt = 0; nt < 4; ++nt) { u32x2 w; w.x = pk2(O[nt][0], O[nt][1]); w.y = pk2(O[nt][2], O[nt][3]); *(u32x2*)(orow + (size_t)(16 * nt) * LDP) = w; }
#pragma unroll
  for (int dt = 0; dt < 8; ++dt) { S[dt] = S[dt] * gb;
#pragma unroll
    for (int s2 = 0; s2 < 2; ++s2) S[dt] = MFMA16(SW_A64(B + 32768, 16 * dt + fr, s2), Vf[s2], S[dt]); }
#undef SW_A128
#undef SW_A64
}
template <int TYPE> DI void scan_wg(const Params& p, int l, int seq, int hh, unsigned char* smem) {
  const int tid = otid(), lane = tid & 63, wv = tid >> 6, fr = lane & 15, fq = lane >> 4, e0 = 16 * wv;
  const int ci0 = seq * 64;
  const bf16_t* m1 = (const bf16_t*)(p.ws + OFF_M1);
  bf16_t* proj = (bf16_t*)(p.ws + OFF_PROJ);
  const float* dG = (const float*)(p.ws + OFF_DG);
  const bf16_t* gW = m1 + 0 * M1_BLK; const bf16_t* gQ = m1 + (TYPE == 0 ? 1 : 4) * M1_BLK; const bf16_t* gKT = m1 + (TYPE == 0 ? 2 : 5) * M1_BLK;
  const bf16_t* gUT = m1 + (TYPE == 0 ? 3 : 6) * M1_BLK; const bf16_t* gIN = m1 + 8 * M1_BLK + (TYPE == 0 ? 0 : (size_t)NITEM * 4096);
  f32x4 S[8];
#pragma unroll
  for (int t = 0; t < 8; ++t) S[t] = (f32x4){0.f, 0.f, 0.f, 0.f};
  const float gvec = (TYPE == 0) ? dG[(ci0 + lane) * 8 + hh] : __expf(64.f * __logf(1.f - exp2f(-5.f - (float)hh)));
  int d128[2], d64[2];
#pragma unroll
  for (int k = 0; k < 2; ++k) { const int q = tid + 512 * k; { const int r = q >> 4, c = q & 15; d128[k] = (r * 16 + (c ^ (r & 15))) * 16; }
    { const int r = q >> 3, c = q & 7; d64[k] = (r * 8 + (c ^ ((r >> 1) & 7))) * 16; } }
  u32x4 st[2][7]; u32x4 uv[2][2];
#define SW_ISSUE(n_, X_) do { const size_t it_ = (size_t)((ci0 + (n_)) * 8 + hh); \
    if (TYPE == 0) { st[X_][0] = *(const u32x4*)(gW + it_ * 8192 + tid * 8); st[X_][1] = *(const u32x4*)(gW + it_ * 8192 + (tid + 512) * 8); } \
    st[X_][2] = *(const u32x4*)(gQ + it_ * 8192 + tid * 8); st[X_][3] = *(const u32x4*)(gQ + it_ * 8192 + (tid + 512) * 8); \
    st[X_][4] = *(const u32x4*)(gKT + it_ * 8192 + tid * 8); st[X_][5] = *(const u32x4*)(gKT + it_ * 8192 + (tid + 512) * 8); \
    st[X_][6] = *(const u32x4*)(gIN + it_ * 4096 + tid * 8); \
    if (TYPE == 0) { _Pragma("unroll") for (int mt = 0; mt < 4; ++mt) { const u32x2 u_ = *(const u32x2*)(gUT + it_ * 8192 + (e0 + fr) * 64 + 16 * mt + 4 * fq); uv[X_][mt >> 1][(mt & 1) * 2] = u_.x; uv[X_][mt >> 1][(mt & 1) * 2 + 1] = u_.y; } } \
    else { uv[X_][0] = *(const u32x4*)(gUT + it_ * 8192 + (e0 + fr) * 64 + 8 * fq); uv[X_][1] = *(const u32x4*)(gUT + it_ * 8192 + (e0 + fr) * 64 + 32 + 8 * fq); } } while (0)
#define SW_COMMIT(b_, X_) do { unsigned char* B_ = smem + (b_) * 57344; \
    if (TYPE == 0) { *(u32x4*)(B_ + d128[0]) = st[X_][0]; *(u32x4*)(B_ + d128[1]) = st[X_][1]; } \
    *(u32x4*)(B_ + 16384 + d128[0]) = st[X_][2]; *(u32x4*)(B_ + 16384 + d128[1]) = st[X_][3]; \
    *(u32x4*)(B_ + 32768 + d64[0]) = st[X_][4]; *(u32x4*)(B_ + 32768 + d64[1]) = st[X_][5]; *(u32x4*)(B_ + 49152 + d64[0]) = st[X_][6]; \
    ucur[0] = uv[X_][0]; ucur[1] = uv[X_][1]; } while (0)
  u32x4 ucur[2];
  bf16_t* obase = proj + (size_t)(ci0 * 64 + fr) * LDP + (TYPE == 0 ? C_OBRAW : C_OCRAW) + hh * 128 + e0 + 4 * fq;
  SW_ISSUE(0, 0);
  SW_COMMIT(0, 0);
  SW_ISSUE(1, 1);
  __syncthreads();
  for (int n = 0; n < 64; n += 2) {
    if (n + 2 < 64) SW_ISSUE(n + 2, 0);
    scan_step<TYPE>(smem, S, ucur, __shfl(gvec, n), obase + (size_t)(n * 64) * LDP, fr, fq);
    SW_COMMIT(1, 1);
    __syncthreads();
    if (n + 3 < 64) SW_ISSUE(n + 3, 1);
    scan_step<TYPE>(smem + 57344, S, ucur, __shfl(gvec, n + 1), obase + (size_t)((n + 1) * 64) * LDP, fr, fq);
    if (n + 2 < 64) SW_COMMIT(0, 0);
    __syncthreads();
  }
#undef SW_ISSUE
#undef SW_COMMIT
  { float* so = p.out + (TYPE == 0 ? O_PD : O_PR) + (((size_t)l * 4 + seq) * 8 + hh) * 16384 + e0 + fr;
#pragma unroll
    for (int t = 0; t < 8; ++t)
#pragma unroll
      for (int i = 0; i < 4; ++i) so[(16 * t + 4 * fq + i) * 128] = S[t][i]; }
}

template <int TYPE> DI void scan_step2(const unsigned char* B, f32x4 (&S)[2][8], const u32x4 (&uc)[2][2], float gb, bf16_t* orow, int fr, int fq) {
#define SW_A128(base_, row_, s_) (*(const bf16x8*)((base_) + (((row_) * 16 + ((4 * (s_) + fq) ^ fr)) * 16)))
#define SW_A64(base_, row_, s_) (*(const bf16x8*)((base_) + (((row_) * 8 + ((4 * (s_) + fq) ^ (fr >> 1))) * 16)))
  bf16x8 Sf[2][4];
#pragma unroll
  for (int c = 0; c < 2; ++c)
#pragma unroll
    for (int s = 0; s < 4; ++s) Sf[c][s] = pack_frag(S[c][2 * s], S[c][2 * s + 1]);
  bf16x8 Vf[2][2];
  if (TYPE == 0) {
    f32x4 Vn[2][4];
#pragma unroll
    for (int c = 0; c < 2; ++c)
#pragma unroll
      for (int mt = 0; mt < 4; ++mt) { const unsigned ux = uc[c][mt >> 1][(mt & 1) * 2], uy = uc[c][mt >> 1][(mt & 1) * 2 + 1]; Vn[c][mt] = (f32x4){bflo(ux), bfhi(ux), bflo(uy), bfhi(uy)}; }
#pragma unroll
    for (int s = 0; s < 4; ++s)
#pragma unroll
      for (int mt = 0; mt < 4; ++mt) { const bf16x8 a = SW_A128(B, 16 * mt + fr, s); Vn[0][mt] = MFMA16(a, Sf[0][s], Vn[0][mt]); Vn[1][mt] = MFMA16(a, Sf[1][s], Vn[1][mt]); }
#pragma unroll
    for (int c = 0; c < 2; ++c) { Vf[c][0] = pack_frag(Vn[c][0], Vn[c][1]); Vf[c][1] = pack_frag(Vn[c][2], Vn[c][3]); }
  } else {
#pragma unroll
    for (int c = 0; c < 2; ++c) { Vf[c][0] = __builtin_bit_cast(bf16x8, uc[c][0]); Vf[c][1] = __builtin_bit_cast(bf16x8, uc[c][1]); }
  }
  f32x4 O[2][4];
#pragma unroll
  for (int c = 0; c < 2; ++c)
#pragma unroll
    for (int nt = 0; nt < 4; ++nt) O[c][nt] = (f32x4){0.f, 0.f, 0.f, 0.f};
#pragma unroll
  for (int s = 0; s < 4; ++s)
#pragma unroll
    for (int nt = 0; nt < 4; ++nt) { const bf16x8 b = SW_A128(B + 16384, 16 * nt + fr, s); O[0][nt] = MFMA16(Sf[0][s], b, O[0][nt]); O[1][nt] = MFMA16(Sf[1][s], b, O[1][nt]); }
#pragma unroll
  for (int s2 = 0; s2 < 2; ++s2)
#pragma unroll
    for (int nt = 0; nt < 4; ++nt) { const bf16x8 b = SW_A64(B + 49152, 16 * nt + fr, s2); O[0][nt] = MFMA16(Vf[0][s2], b, O[0][nt]); O[1][nt] = MFMA16(Vf[1][s2], b, O[1][nt]); }
#pragma unroll
  for (int c = 0; c < 2; ++c)
#pragma unroll
    for (int nt = 0; nt < 4; ++nt) { u32x2 w; w.x = pk2(O[c][nt][0], O[c][nt][1]); w.y = pk2(O[c][nt][2], O[c][nt][3]); *(u32x2*)(orow + (size_t)(16 * nt) * LDP + 16 * c) = w; }
#pragma unroll
  for (int dt = 0; dt < 8; ++dt) { S[0][dt] = S[0][dt] * gb; S[1][dt] = S[1][dt] * gb;
#pragma unroll
    for (int s2 = 0; s2 < 2; ++s2) { const bf16x8 a = SW_A64(B + 32768, 16 * dt + fr, s2); S[0][dt] = MFMA16(a, Vf[0][s2], S[0][dt]); S[1][dt] = MFMA16(a, Vf[1][s2], S[1][dt]); } }
#undef SW_A128
#undef SW_A64
}
template <int TYPE> DI void scan_wg2(const Params& p, int l, int seq, int hh, unsigned char* smem) {
  const int tid = otid(), lane = tid & 63, wv = tid >> 6, fr = lane & 15, fq = lane >> 4;
  const int ci0 = seq * 64;
  const bf16_t* m1 = (const bf16_t*)(p.ws + OFF_M1);
  const bf16_t* gW = m1 + 0 * M1_BLK; const bf16_t* gQ = m1 + (TYPE == 0 ? 1 : 4) * M1_BLK; const bf16_t* gKT = m1 + (TYPE == 0 ? 2 : 5) * M1_BLK;
  const bf16_t* gUT = m1 + (TYPE == 0 ? 3 : 6) * M1_BLK; const bf16_t* gIN = m1 + 8 * M1_BLK + (TYPE == 0 ? 0 : (size_t)NITEM * 4096);
  if (wv >= 4) {
    const int lt = tid - 256;
    const int b128 = ((lt >> 4) * 16 + ((lt & 15) ^ ((lt >> 4) & 15))) * 16, b64 = ((lt >> 3) * 8 + ((lt & 7) ^ ((lt >> 4) & 7))) * 16;
    u32x4 st[2][14];
#define LW_ISSUE(n_, X_) do { const size_t it_ = (size_t)((ci0 + (n_)) * 8 + hh); \
      _Pragma("unroll") for (int k = 0; k < 4; ++k) { if (TYPE == 0) st[X_][k] = *(const u32x4*)(gW + it_ * 8192 + (lt + 256 * k) * 8); \
        st[X_][4 + k] = *(const u32x4*)(gQ + it_ * 8192 + (lt + 256 * k) * 8); st[X_][8 + k] = *(const u32x4*)(gKT + it_ * 8192 + (lt + 256 * k) * 8); } \
      st[X_][12] = *(const u32x4*)(gIN + it_ * 4096 + lt * 8); st[X_][13] = *(const u32x4*)(gIN + it_ * 4096 + (lt + 256) * 8); } while (0)
#define LW_COMMIT(b_, X_) do { unsigned char* B_ = smem + (b_) * 57344; \
      _Pragma("unroll") for (int k = 0; k < 4; ++k) { if (TYPE == 0) *(u32x4*)(B_ + b128 + k * 4096) = st[X_][k]; \
        *(u32x4*)(B_ + 16384 + b128 + k * 4096) = st[X_][4 + k]; *(u32x4*)(B_ + 32768 + b64 + k * 4096) = st[X_][8 + k]; } \
      *(u32x4*)(B_ + 49152 + b64) = st[X_][12]; *(u32x4*)(B_ + 49152 + b64 + 4096) = st[X_][13]; } while (0)
    LW_ISSUE(0, 0); LW_COMMIT(0, 0); LW_ISSUE(1, 1);
    __syncthreads();
    for (int n = 0; n < 64; n += 2) {
      if (n + 2 < 64) LW_ISSUE(n + 2, 0);
      LW_COMMIT(1, 1);
      __syncthreads();
      if (n + 3 < 64) LW_ISSUE(n + 3, 1);
      if (n + 2 < 64) LW_COMMIT(0, 0);
      __syncthreads();
    }
#undef LW_ISSUE
#undef LW_COMMIT
  } else {
    const int e0 = 32 * wv;
    bf16_t* proj = (bf16_t*)(p.ws + OFF_PROJ);
    const float* dG = (const float*)(p.ws + OFF_DG);
    f32x4 S[2][8];
#pragma unroll
    for (int c = 0; c < 2; ++c)
#pragma unroll
      for (int t = 0; t < 8; ++t) S[c][t] = (f32x4){0.f, 0.f, 0.f, 0.f};
    const float gvec = (TYPE == 0) ? dG[(ci0 + lane) * 8 + hh] : __expf(64.f * __logf(1.f - exp2f(-5.f - (float)hh)));
    u32x4 ucur[2][2], unext[2][2];
#define CW_ULOAD(n_, dst_) do { const size_t it_ = (size_t)((ci0 + (n_)) * 8 + hh); _Pragma("unroll") for (int c = 0; c < 2; ++c) { \
      if (TYPE == 0) { _Pragma("unroll") for (int mt = 0; mt < 4; ++mt) { const u32x2 u_ = *(const u32x2*)(gUT + it_ * 8192 + (e0 + 16 * c + fr) * 64 + 16 * mt + 4 * fq); dst_[c][mt >> 1][(mt & 1) * 2] = u_.x; dst_[c][mt >> 1][(mt & 1) * 2 + 1] = u_.y; } } \
      else { dst_[c][0] = *(const u32x4*)(gUT + it_ * 8192 + (e0 + 16 * c + fr) * 64 + 8 * fq); dst_[c][1] = *(const u32x4*)(gUT + it_ * 8192 + (e0 + 16 * c + fr) * 64 + 32 + 8 * fq); } } } while (0)
    bf16_t* obase = proj + (size_t)(ci0 * 64 + fr) * LDP + (TYPE == 0 ? C_OBRAW : C_OCRAW) + hh * 128 + e0 + 4 * fq;
    CW_ULOAD(0, ucur);
    __syncthreads();
    for (int n = 0; n < 64; ++n) {
      if (n + 1 < 64) CW_ULOAD(n + 1, unext);
      scan_step2<TYPE>(smem + (n & 1) * 57344, S, ucur, __shfl(gvec, n), obase + (size_t)(n * 64) * LDP, fr, fq);
#pragma unroll
      for (int c = 0; c < 2; ++c) { ucur[c][0] = unext[c][0]; ucur[c][1] = unext[c][1]; }
      __syncthreads();
    }
#undef CW_ULOAD
    { float* so = p.out + (TYPE == 0 ? O_PD : O_PR) + (((size_t)l * 4 + seq) * 8 + hh) * 16384 + e0 + fr;
#pragma unroll
      for (int c = 0; c < 2; ++c)
#pragma unroll
        for (int t = 0; t < 8; ++t)
#pragma unroll
          for (int i = 0; i < 4; ++i) so[(16 * t + 4 * fq + i) * 128 + 16 * c] = S[c][t][i]; }
  }
}

DI void attn_item(const Params& p, int l, int ai) {
  const int qt = ai & 3, hh = (ai >> 2) & 7, ci = ai >> 5;
  const int lane = otid() & 63, fr = lane & 15, fq = lane >> 4;
  bf16_t* proj = (bf16_t*)(p.ws + OFF_PROJ);
  const bf16_t* aVT = (const bf16_t*)(p.ws + OFF_M1) + 7 * M1_BLK;
  const bf16_t* kcb = (const bf16_t*)(p.ws + OFF_KC); const bf16_t* cvt = (const bf16_t*)(p.ws + OFF_CVT);
  const float* rb = p.rel_bias + ((size_t)l * 8 + hh) * 257;
  const int qrow = ci * 64 + 16 * qt + fr;
  bf16x8 Qf[4];
#pragma unroll
  for (int s = 0; s < 4; ++s) Qf[s] = *(const bf16x8*)(proj + (size_t)qrow * LDP + hh * 128 + 32 * s + 8 * fq);
  const int jmin = (ci < 256) ? ((ci & 63) >= 8 ? 0 : 8 - (ci & 63)) : 0;
  const float bfar = rb[256]; const int iq = 16 * qt + fr;
  float m = -1e30f, lsum = 0.f;
  f32x4 O[8];
#pragma unroll
  for (int et = 0; et < 8; ++et) O[et] = (f32x4){0.f, 0.f, 0.f, 0.f};
#pragma unroll 1
  for (int grp = 0; grp < 3; ++grp) {
    if (3 * grp + 2 < jmin) continue;
    f32x4 sc[12]; float gmx = -1e30f;
#pragma unroll
    for (int jj = 0; jj < 3; ++jj) { const int j = 3 * grp + jj;
      if (j >= jmin) {
        const bf16_t* Kp; int ks;
        if (ci < 256 || j == 8) { Kp = proj + (size_t)((ci < 256 ? ci - 8 + j : ci) * 64) * LDP + 1024 + hh * 128; ks = LDP; }
        else { Kp = kcb + (size_t)(((ci - 256) * 8 + j) * 8 + hh) * 8192; ks = 128; }
#pragma unroll
        for (int kt = 0; kt < 4; ++kt) {
          f32x4 c = {0.f, 0.f, 0.f, 0.f};
#pragma unroll
          for (int s = 0; s < 4; ++s) { const bf16x8 a = *(const bf16x8*)(Kp + (size_t)(16 * kt + fr) * ks + 32 * s + 8 * fq); c = MFMA16(a, Qf[s], c); }
#pragma unroll
          for (int i = 0; i < 4; ++i) { float bias = bfar;
            if (grp == 2) { const int r = 64 * j + 16 * kt + 4 * fq + i; int dist = 512 + iq - r; dist = dist < -128 ? -128 : (dist > 128 ? 128 : dist); bias = rb[dist + 128]; }
            c[i] = c[i] * 0.08838834764831845f + bias; gmx = fmaxf(gmx, c[i]); }
          sc[4 * jj + kt] = c;
        }
      } else {
#pragma unroll
        for (int kt = 0; kt < 4; ++kt) sc[4 * jj + kt] = (f32x4){-1e30f, -1e30f, -1e30f, -1e30f};
      }
    }
    gmx = fmaxf(gmx, __shfl_xor(gmx, 16)); gmx = fmaxf(gmx, __shfl_xor(gmx, 32));
    const float mnew = fmaxf(m, gmx), alpha = __expf(m - mnew); m = mnew;
    lsum *= alpha;
#pragma unroll
    for (int et = 0; et < 8; ++et) O[et] = O[et] * alpha;
#pragma unroll
    for (int t = 0; t < 12; ++t)
#pragma unroll
      for (int i = 0; i < 4; ++i) { const float e = __expf(sc[t][i] - m); sc[t][i] = e; lsum += e; }
#pragma unroll
    for (int jj = 0; jj < 3; ++jj) { const int j = 3 * grp + jj;
      if (j >= jmin) {
        const bf16_t* Vp;
        if (ci < 256 || j == 8) Vp = aVT + (size_t)((ci < 256 ? ci - 8 + j : ci) * 8 + hh) * 8192;
        else Vp = cvt + (size_t)(((ci - 256) * 8 + j) * 8 + hh) * 8192;
#pragma unroll
        for (int s2 = 0; s2 < 2; ++s2) { const bf16x8 pf = pack_frag(sc[4 * jj + 2 * s2], sc[4 * jj + 2 * s2 + 1]);
#pragma unroll
          for (int et = 0; et < 8; ++et) { const bf16x8 a = *(const bf16x8*)(Vp + (16 * et + fr) * 64 + 32 * s2 + 8 * fq); O[et] = MFMA16(a, pf, O[et]); } }
      }
    }
  }
  lsum += __shfl_xor(lsum, 16); lsum += __shfl_xor(lsum, 32);
  const float inv = 1.f / lsum;
#pragma unroll
  for (int et = 0; et < 8; ++et) { const u32x2 z = *(const u32x2*)(proj + (size_t)qrow * LDP + 3072 + hh * 128 + 16 * et + 4 * fq);
    u32x2 w; w.x = pk2(O[et][0] * inv * siluf_(bflo(z.x)), O[et][1] * inv * siluf_(bfhi(z.x))); w.y = pk2(O[et][2] * inv * siluf_(bflo(z.y)), O[et][3] * inv * siluf_(bfhi(z.y)));
    *(u32x2*)(proj + (size_t)qrow * LDP + C_ACAT + hh * 128 + 16 * et + 4 * fq) = w; }
}

DI void attn_stage(const unsigned char* Kl, const float* sB, int j, int iq, float bfar, const bf16x8 (&Qf)[4], f32x4 (&O)[8], float& m, float& lsum, int fr, int fq) {
#define AW_A128(base_, row_, s_) (*(const bf16x8*)((base_) + (((row_) * 16 + ((4 * (s_) + fq) ^ fr)) * 16)))
#define AW_A64(base_, row_, s_) (*(const bf16x8*)((base_) + (((row_) * 8 + ((4 * (s_) + fq) ^ (fr >> 1))) * 16)))
  const unsigned char* Vl = Kl + 32768;
  f32x4 sc[4]; float gmx = -1e30f;
#pragma unroll
  for (int kt = 0; kt < 4; ++kt) {
    f32x4 c = {0.f, 0.f, 0.f, 0.f};
#pragma unroll
    for (int s = 0; s < 4; ++s) c = MFMA16(AW_A128(Kl, 16 * kt + fr, s), Qf[s], c);
#pragma unroll
    for (int i = 0; i < 4; ++i) { float bias = bfar;
      if (j >= 6) { const int r = 64 * j + 16 * kt + 4 * fq + i; int dist = 512 + iq - r; dist = dist < -128 ? -128 : (dist > 128 ? 128 : dist); bias = sB[dist + 128]; }
      c[i] = c[i] * 0.08838834764831845f + bias; gmx = fmaxf(gmx, c[i]); }
    sc[kt] = c;
  }
  gmx = fmaxf(gmx, __shfl_xor(gmx, 16)); gmx = fmaxf(gmx, __shfl_xor(gmx, 32));
  const float mnew = fmaxf(m, gmx), alpha = __expf(m - mnew); m = mnew;
  lsum *= alpha;
#pragma unroll
  for (int et = 0; et < 8; ++et) O[et] = O[et] * alpha;
#pragma unroll
  for (int kt = 0; kt < 4; ++kt)
#pragma unroll
    for (int i = 0; i < 4; ++i) { const float e = __expf(sc[kt][i] - m); sc[kt][i] = e; lsum += e; }
#pragma unroll
  for (int s2 = 0; s2 < 2; ++s2) { const bf16x8 pf = pack_frag(sc[2 * s2], sc[2 * s2 + 1]);
#pragma unroll
    for (int et = 0; et < 8; ++et) O[et] = MFMA16(AW_A64(Vl, 16 * et + fr, s2), pf, O[et]); }
#undef AW_A128
#undef AW_A64
}
DI void attn_wg(const Params& p, int l, int wi, unsigned char* smem) {
  const int tid = otid(), lane = tid & 63, wv = tid >> 6, fr = lane & 15, fq = lane >> 4;
  const int ci = wi >> 2, hp = wi & 3, hsel = wv >> 2, hh = 2 * hp + hsel, qt = wv & 3;
  bf16_t* proj = (bf16_t*)(p.ws + OFF_PROJ);
  const bf16_t* aVT = (const bf16_t*)(p.ws + OFF_M1) + 7 * M1_BLK;
  const bf16_t* kcb = (const bf16_t*)(p.ws + OFF_KC); const bf16_t* cvt = (const bf16_t*)(p.ws + OFF_CVT);
  const float* rb = p.rel_bias + ((size_t)l * 8 + 2 * hp) * 257;
  float* sBias = (float*)(smem + 131072 + 256);
  const int qrow = ci * 64 + 16 * qt + fr;
  bf16x8 Qf[4];
#pragma unroll
  for (int s = 0; s < 4; ++s) Qf[s] = *(const bf16x8*)(proj + (size_t)qrow * LDP + hh * 128 + 32 * s + 8 * fq);
  const int jmin = (ci < 256) ? ((ci & 63) >= 8 ? 0 : 8 - (ci & 63)) : 0;
  const float bfar = rb[hsel * 257 + 256]; const int iq = 16 * qt + fr;
  const int row0 = tid >> 4, kcol = tid & 15;
  const int dKb = (row0 * 16 + (kcol ^ (row0 & 15))) * 16, dVb = 32768 + ((tid >> 3) * 8 + ((tid & 7) ^ ((tid >> 4) & 7))) * 16;
  u32x4 st[2][8];
#define AW_ISSUE(j_, X_) do { const bf16_t* Kb_; const bf16_t* Vb_; int ks_; size_t khs_; \
    if (ci < 256 || (j_) == 8) { const int cj_ = (ci < 256) ? ci - 8 + (j_) : ci; Kb_ = proj + (size_t)(cj_ * 64) * LDP + 1024 + 2 * hp * 128; ks_ = LDP; khs_ = 128; Vb_ = aVT + (size_t)(cj_ * 8 + 2 * hp) * 8192; } \
    else { const size_t o_ = (size_t)(((ci - 256) * 8 + (j_)) * 8 + 2 * hp) * 8192; Kb_ = kcb + o_; ks_ = 128; khs_ = 8192; Vb_ = cvt + o_; } \
    const bf16_t* kp_ = Kb_ + (size_t)row0 * ks_ + kcol * 8; \
    _Pragma("unroll") for (int k = 0; k < 4; ++k) { st[X_][k] = *(const u32x4*)(kp_ + (k >> 1) * khs_ + (size_t)(32 * (k & 1)) * ks_); st[X_][4 + k] = *(const u32x4*)(Vb_ + (size_t)(tid + 512 * k) * 8); } } while (0)
#define AW_COMMIT(b_, X_) do { unsigned char* B_ = smem + (b_) * 65536; _Pragma("unroll") for (int k = 0; k < 4; ++k) { \
    *(u32x4*)(B_ + dKb + (k >> 1) * 16384 + (k & 1) * 8192) = st[X_][k]; *(u32x4*)(B_ + dVb + (k >> 1) * 16384 + (k & 1) * 8192) = st[X_][4 + k]; } } while (0)
  float m = -1e30f, lsum = 0.f;
  f32x4 O[8];
#pragma unroll
  for (int et = 0; et < 8; ++et) O[et] = (f32x4){0.f, 0.f, 0.f, 0.f};
  AW_ISSUE(jmin, 0);
  if (tid < 257) { sBias[tid] = rb[tid]; sBias[260 + tid] = rb[257 + tid]; }
  AW_COMMIT(0, 0);
  if (jmin + 1 < 9) AW_ISSUE(jmin + 1, 1);
  __syncthreads();
  const float* sB = sBias + hsel * 260;
  for (int j = jmin; j < 9; j += 2) {
    if (j + 2 < 9) AW_ISSUE(j + 2, 0);
    attn_stage(smem + hsel * 16384, sB, j, iq, bfar, Qf, O, m, lsum, fr, fq);
    if (j + 1 < 9) AW_COMMIT(1, 1);
    __syncthreads();
    if (j + 1 >= 9) break;
    if (j + 3 < 9) AW_ISSUE(j + 3, 1);
    attn_stage(smem + 65536 + hsel * 16384, sB, j + 1, iq, bfar, Qf, O, m, lsum, fr, fq);
    if (j + 2 < 9) AW_COMMIT(0, 0);
    __syncthreads();
  }
#undef AW_ISSUE
#undef AW_COMMIT
  lsum += __shfl_xor(lsum, 16); lsum += __shfl_xor(lsum, 32);
  const float inv = 1.f / lsum;
#pragma unroll
  for (int et = 0; et < 8; ++et) { const u32x2 z = *(const u32x2*)(proj + (size_t)qrow * LDP + 3072 + hh * 128 + 16 * et + 4 * fq);
    u32x2 w; w.x = pk2(O[et][0] * inv * siluf_(bflo(z.x)), O[et][1] * inv * siluf_(bfhi(z.x))); w.y = pk2(O[et][2] * inv * siluf_(bflo(z.y)), O[et][3] * inv * siluf_(bfhi(z.y)));
    *(u32x2*)(proj + (size_t)qrow * LDP + C_ACAT + hh * 128 + 16 * et + 4 * fq) = w; }
}

DI void m2_phase(const Params& p, int l, int rep, unsigned char* smem) {
  const int tid_ = otid(); const int wv = tid_ >> 6;
  if (blockIdx.x < 64) {
    const int chain = blockIdx.x, ty = chain >> 5, sq = (chain & 31) >> 3, hh = chain & 7;
    for (int r3 = 0; r3 < R_SW; ++r3) { if (ty == 0) scan_wg2<0>(p, l, sq, hh, smem); else scan_wg2<1>(p, l, sq, hh, smem); }
  } else {
    for (int idx = (blockIdx.x - 64) * 8 + wv; idx < 1024; idx += (gridDim.x - 64) * 8) {
      const int ty = idx >> 9, r = idx & 511, sq = 4 + (r >> 6), hh = (r >> 3) & 7, sl = r & 7;
      if (ty == 0) scan_item<0>(p, l, sq, hh, sl); else scan_item<1>(p, l, sq, hh, sl); }
  }
  unsigned* cnt = (unsigned*)(p.ws + OFF_CNT) + 64 * (l * 2 + rep);
  for (;;) {
    __syncthreads();
    if (tid_ == 0) *(volatile unsigned*)(smem + 131072) = atomicAdd(cnt, 1u);
    __syncthreads();
    const unsigned idx = *(volatile unsigned*)(smem + 131072);
    if (idx >= 1056u) break;
    for (int r2 = 0; r2 < R_AT; ++r2) attn_wg(p, l, (int)idx, smem);
  }
}

DI void m3_phase(const Params& p, int l) {
  bf16_t* proj = (bf16_t*)(p.ws + OFF_PROJ);
  const int tid_ = otid(); const int lane = tid_ & 63, gw = blockIdx.x * 8 + (tid_ >> 6), nw = gridDim.x * 8;
  for (int wi = gw; wi < 2 * MROWS; wi += nw) {
    const int r = wi >> 1, br = wi & 1; bf16_t* rp = proj + (size_t)r * LDP;
    float v[16], z[16];
    unpack8(*(const u32x4*)(rp + (br ? C_OCRAW : C_OBRAW) + 16 * lane), v); unpack8(*(const u32x4*)(rp + (br ? C_OCRAW : C_OBRAW) + 16 * lane + 8), v + 8);
    unpack8(*(const u32x4*)(rp + (br ? 11264 : 7168) + 16 * lane), z); unpack8(*(const u32x4*)(rp + (br ? 11264 : 7168) + 16 * lane + 8), z + 8);
    const float* nw_ = br ? p.ret_norm + (size_t)l * 1024 + 16 * lane : p.delta_norm + (size_t)l * 128 + 16 * (lane & 7);
    float mu = 0.f;
    if (br) {
#pragma unroll
      for (int c = 0; c < 16; ++c) mu += v[c];
      mu += __shfl_xor(mu, 1); mu += __shfl_xor(mu, 2); mu += __shfl_xor(mu, 4); mu *= (1.f / 128.f); }
    float ss = 0.f;
#pragma unroll
    for (int c = 0; c < 16; ++c) { v[c] -= mu; ss += v[c] * v[c]; }
    ss += __shfl_xor(ss, 1); ss += __shfl_xor(ss, 2); ss += __shfl_xor(ss, 4);
    const float rn = rsqrtf(ss * (1.f / 128.f) + 1e-6f);
#pragma unroll
    for (int c = 0; c < 16; ++c) v[c] = v[c] * rn * nw_[c] * siluf_(z[c]);
    *(u32x4*)(rp + C_ACAT + 1024 + br * 1024 + 16 * lane) = pack8(v); *(u32x4*)(rp + C_ACAT + 1024 + br * 1024 + 16 * lane + 8) = pack8(v + 8);
  }
}

DI void merge_phase(const Params& p) {
  const bf16_t* proj = (const bf16_t*)(p.ws + OFF_PROJ); const bf16_t* P = (const bf16_t*)(p.ws + OFF_M1); bf16_t* mg = (bf16_t*)(p.ws + OFF_H);
  const int tid_ = otid(); const int lane = tid_ & 63, gw = blockIdx.x * 8 + (tid_ >> 6), nw = gridDim.x * 8;
  for (int r = gw; r < MROWS; r += nw) {
    const bf16_t* pr = P + (size_t)r * (3 * DM); const bf16_t* gr = proj + (size_t)r * LDP + 12288;
#pragma unroll
    for (int q = 0; q < 4; ++q) { const int c = q * 512 + lane * 8; float acc[8];
#pragma unroll
      for (int j = 0; j < 8; ++j) acc[j] = 0.f;
#pragma unroll
      for (int br = 0; br < 3; ++br) { float pv[8], gv[8]; unpack8(__builtin_nontemporal_load((const u32x4*)(pr + br * DM + c)), pv); unpack8(__builtin_nontemporal_load((const u32x4*)(gr + br * DM + c)), gv);
#pragma unroll
        for (int j = 0; j < 8; ++j) acc[j] += pv[j] * sigmoidf_(gv[j]); }
      *(u32x4*)(mg + (size_t)r * DM + c) = pack8(acc); }
  }
}

#define XB_TMO      128
#define XB_XCNT(j)  (256  + 64 * (j))
#define XB_XSUB(j)  (1280 + 64 * (j))
#define XB_XGEN(j)  (2304 + 64 * (j))
#define XB_TOP      3328
#define XB_TOPGEN   3392
#define XCD_BAR_WORDS 3456
#define XB_SPIN_CAP (1u << 18)
DI unsigned xb_ld(unsigned* p) { return __hip_atomic_load(p, __ATOMIC_RELAXED, __HIP_MEMORY_SCOPE_AGENT); }
DI unsigned xb_add(unsigned* p, unsigned v) { return __hip_atomic_fetch_add(p, v, __ATOMIC_RELAXED, __HIP_MEMORY_SCOPE_AGENT); }
DI unsigned xb_xcc_id() { return (unsigned)__builtin_amdgcn_s_getreg((3 << 11) | 20) & 0xFu; }
#define XB_SPIN(cond, bar) do { unsigned _sp = 0; while (cond) { __builtin_amdgcn_s_sleep(1); \
    if ((++_sp & 255u) == 0u) { if (xb_ld(&(bar)[XB_TMO])) break; if (_sp > XB_SPIN_CAP) { atomicAdd(&(bar)[XB_TMO], 1u); break; } } } } while (0)
struct XcdBarrier { unsigned* bar; unsigned x; volatile LAS unsigned* st; };
DI XcdBarrier xcd_barrier_post(unsigned* bar, volatile LAS unsigned* st) {
  XcdBarrier b; b.bar = bar; b.x = xb_xcc_id(); b.st = st;
  if (threadIdx.x == 0) (void)xb_add(&bar[XB_XCNT(b.x)], 1u);
  return b;
}
DI void xcd_barrier_complete(unsigned* bar, unsigned x, unsigned& nloc, unsigned& nx) {
  const unsigned G = gridDim.x * gridDim.y * gridDim.z;
  unsigned sum, cnt, mine, sp = 0u;
  for (;;) {
    sum = 0u; cnt = 0u; mine = 0u;
#pragma unroll
    for (unsigned j = 0; j < 16; ++j) { const unsigned c = xb_ld(&bar[XB_XCNT(j)]); sum += c; cnt += (c > 0u) ? 1u : 0u; mine = (j == x) ? c : mine; }
    if (sum == G) break;
    __builtin_amdgcn_s_sleep(1);
    if ((++sp & 255u) == 0u) { if (xb_ld(&bar[XB_TMO])) break; if (sp > XB_SPIN_CAP) { atomicAdd(&bar[XB_TMO], 1u); break; } }
  }
  nloc = mine > 0u ? mine : 1u; nx = cnt > 0u ? cnt : 1u;
}
DI void xcd_barrier(const XcdBarrier& b) {
  asm volatile("s_waitcnt vmcnt(0)" ::: "memory");
  __syncthreads();
  if (threadIdx.x == 0) {
    unsigned* bar = b.bar;
    __builtin_amdgcn_s_waitcnt(0);
    unsigned nloc = b.st[0], nx = b.st[1];
    if (nloc == 0u) { xcd_barrier_complete(bar, b.x, nloc, nx); b.st[0] = nloc; b.st[1] = nx; }
    const unsigned old = xb_add(&bar[XB_XSUB(b.x)], 1u);
    const unsigned gen = old / nloc;
    if (old + 1u == (gen + 1u) * nloc) {
      __builtin_amdgcn_fence(__ATOMIC_RELEASE, "agent");
      asm volatile("s_waitcnt vmcnt(0)" ::: "memory");
      const unsigned og = xb_add(&bar[XB_TOP], 1u);
      const unsigned tg = og / nx;
      if (og + 1u == (tg + 1u) * nx) xb_add(&bar[XB_TOPGEN], 1u);
      else XB_SPIN(xb_ld(&bar[XB_TOPGEN]) == tg, bar);
      __builtin_amdgcn_fence(__ATOMIC_ACQUIRE, "agent");
      xb_add(&bar[XB_XGEN(b.x)], 1u);
      asm volatile("s_waitcnt vmcnt(0)" ::: "memory");
    } else {
      XB_SPIN(xb_ld(&bar[XB_XGEN(b.x)]) == gen, bar);
      __builtin_amdgcn_fence(__ATOMIC_ACQUIRE, "agent");
      asm volatile("s_waitcnt vmcnt(0)" ::: "memory");
    }
  }
  __syncthreads();
}

__global__ void __launch_bounds__(512, 2) mega(Params p) {
  extern __shared__ __attribute__((aligned(16))) unsigned char smem[];
  cg::grid_group grid = cg::this_grid();
  const int G = gridDim.x;
  if (threadIdx.x == 0) { ((volatile LAS unsigned*)(LAS unsigned char*)smem)[(131072 + 16) / 4] = 0u; ((volatile LAS unsigned*)(LAS unsigned char*)smem)[(131072 + 20) / 4] = 0u; }
  __syncthreads();
  XcdBarrier xb = xcd_barrier_post((unsigned*)(p.ws + OFF_BAR), (volatile LAS unsigned*)((LAS unsigned char*)smem + 131072 + 16));
  if (blockIdx.x == 0 && threadIdx.x < 4) ((unsigned*)(p.ws + OFF_CNT))[64 * threadIdx.x] = 0u;
  if (T_ROW) { convert_weights(p, 0, (float*)smem, 2, blockIdx.x, gridDim.x);
  prenorm_phase(p, 0); }
  grid.sync();
  for (int l = 0; l < 2; ++l) {
    { pg8::Gemm g{(const bf16_t*)(p.ws + OFF_H), (const bf16_t*)(p.ws + OFF_WIN), MROWS, NW1, DM, DM, DM, 1 << 20, 0};
      pg8::StaticOrder S; S.init(MROWS, NW1, G, blockIdx.x);
      EpiProj E{(bf16_t*)(p.ws + OFF_PROJ), (float*)(p.ws + OFF_SIDE), LDP, 72};
      for (int rep = 0; rep < R_G1; ++rep) pg8::gemm_phase(( LAS unsigned char*)smem, g, S, E); }
    xcd_barrier(xb);
    { float* sCW = (float*)(smem + 122880); const int hh0 = blockIdx.x & 7;
      for (int idx = threadIdx.x; idx < 1536; idx += 512) { const int mat = idx / 512, tap = (idx >> 7) & 3, col = idx & 127;
        sCW[idx] = p.conv_w[((size_t)l * 4 + tap) * 3072 + mat * 1024 + hh0 * 128 + col]; }
      __syncthreads(); }
    for (int rep = 0; rep < R_M1; ++rep)
    for (int t = blockIdx.x; t < 3 * NITEM + 512; t += G) {
      if (t < NITEM) { for (int r2 = 0; r2 < R_DP; ++r2) delta_pre(p, l, t, smem); }
      else if (t < 2 * NITEM) { if (T_RP) ret_pre(p, l, t - NITEM, smem); }
      else if (t < 3 * NITEM) { if (T_MI) misc_item(p, l, t - 2 * NITEM, smem); }
      else { if (T_MI) cache_item(p, l, t - 3 * NITEM, smem); }
    }
    xcd_barrier(xb);
    for (int rep = 0; rep < R_M2; ++rep) m2_phase(p, l, rep, smem);
    xcd_barrier(xb);
    for (int rep = 0; rep < R_M3; ++rep) m3_phase(p, l);
    xcd_barrier(xb);
    for (int rep = 0; rep < R_G2; ++rep) {
      pg8::Gemm g{(const bf16_t*)(p.ws + OFF_PROJ) + C_ACAT, (const bf16_t*)(p.ws + OFF_WBR), MROWS, 3 * DM, 1024, LDP, 1024, 8, 2048};
      pg8::StaticOrder S; S.init(MROWS, 3 * DM, G, blockIdx.x);
      EpiProj E{(bf16_t*)(p.ws + OFF_M1), nullptr, 3 * DM, 1 << 20};
      pg8::gemm_phase((LAS unsigned char*)smem, g, S, E); }
    xcd_barrier(xb);
    merge_phase(p);
    xcd_barrier(xb);
    { pg8::Gemm g{(const bf16_t*)(p.ws + OFF_H), (const bf16_t*)(p.ws + OFF_WOUT), MROWS, DM, DM, DM, DM, 1 << 20, 0};
      pg8::StaticOrder S; S.init(MROWS, DM, G, blockIdx.x);
      EpiF32 E{(float*)(p.ws + OFF_M1 + 69206016)};
      for (int rep = 0; rep < R_G3; ++rep) pg8::gemm_phase((LAS unsigned char*)smem, g, S, E); }
    if (l == 0) { const int c0 = 528 - ((528 + G - 1) / G - 1) * G;
      if (c0 < G && (int)blockIdx.x >= c0) convert_weights(p, 1, (float*)smem, 0, blockIdx.x - c0, G - c0);
      else if (c0 >= G) convert_weights(p, 1, (float*)smem, 0, blockIdx.x, G); }
    xcd_barrier(xb);
    if (T_ROW) postnorm_phase(p, l);
    if (l == 0) { if (T_ROW) convert_weights(p, 1, (float*)smem, 1, blockIdx.x, gridDim.x); xcd_barrier(xb); }
  }
}

extern "C" void kernel_launch(void* const* d_in, const int* in_sizes, int n_in, void* d_out, int out_size,
                              void* d_ws, size_t ws_size, hipStream_t stream) {
  constexpr size_t kLds = 131072 + 256 + 4096;
  static int grid_blocks = 0;
  if (!grid_blocks) {
    (void)hipFuncSetAttribute((const void*)mega, hipFuncAttributeMaxDynamicSharedMemorySize, (int)kLds);
    int dev = 0, cus = 0, per_cu = 0;
    (void)hipGetDevice(&dev);
    (void)hipDeviceGetAttribute(&cus, hipDeviceAttributeMultiprocessorCount, dev);
    (void)hipOccupancyMaxActiveBlocksPerMultiprocessor(&per_cu, mega, 512, kLds);
    if (per_cu > 1) per_cu = 1;
    grid_blocks = cus * per_cu;
    if (grid_blocks > 256) grid_blocks = 256;
  }
  if (ws_size < WS_NEED) { fprintf(stderr, "workspace too small: %zu < %zu\n", ws_size, (size_t)WS_NEED); return; }
  (void)hipMemsetAsync((unsigned char*)d_ws + OFF_BAR, 0, 16384, stream);
  Params p{};
  const float** pp = (const float**)&p;
  for (int i = 0; i < 20; ++i) pp[i] = (const float*)d_in[i];
  p.out = (float*)d_out; p.ws = (unsigned char*)d_ws;
  void* args[] = {&p};
  hipError_t e = hipLaunchCooperativeKernel((void*)mega, dim3(grid_blocks), dim3(512), args, kLds, stream);
  if (e != hipSuccess) fprintf(stderr, "cooperative launch failed: %s (grid %d)\n", hipGetErrorString(e), grid_blocks);
}
```

```cpp
#include <hip/hip_runtime.h>
#include <hip/hip_cooperative_groups.h>
#include <cstdio>
namespace cg = cooperative_groups;
#ifndef R_DP
#define R_DP 1
#endif
#ifndef R_SW
#define R_SW 1
#endif
#ifndef R_AT
#define R_AT 1
#endif
#ifndef R_G1
#define R_G1 1
#endif
#ifndef R_M1
#define R_M1 1
#endif
#ifndef R_M2
#define R_M2 1
#endif
#ifndef R_M3
#define R_M3 1
#endif
#ifndef R_G2
#define R_G2 1
#endif
#ifndef R_G3
#define R_G3 1
#endif
#ifndef T_ROW
#define T_ROW 1
#endif
#ifndef T_G1
#define T_G1 1
#endif
#ifndef T_DP
#define T_DP 1
#endif
#ifndef T_RP
#define T_RP 1
#endif
#ifndef T_MI
#define T_MI 1
#endif
#ifndef T_M2
#define T_M2 1
#endif
#ifndef T_M3
#define T_M3 1
#endif
#ifndef T_G2
#define T_G2 1
#endif
#ifndef T_G3
#define T_G3 1
#endif
#ifndef T_AT
#define T_AT 1
#endif
#ifndef T_SC
#define T_SC 1
#endif

#define DI __device__ __forceinline__
#define LAS __attribute__((address_space(3)))
typedef unsigned short bf16_t;
typedef short bf16x8 __attribute__((ext_vector_type(8)));
typedef float f32x4 __attribute__((ext_vector_type(4)));
typedef float f32x2 __attribute__((ext_vector_type(2)));
typedef unsigned u32x4 __attribute__((ext_vector_type(4)));
typedef unsigned u32x2 __attribute__((ext_vector_type(2)));
typedef __bf16 bf2_t __attribute__((ext_vector_type(2)));

constexpr int DM = 2048, MROWS = 16896, LDP = 18432, NW1 = 18688, NIN = 18448, NITEM = 2112;
constexpr int C_ACAT = 4096, C_OBRAW = 8192, C_OCRAW = 9216;
constexpr size_t O_PK = 34603008, O_PV = 38797312, O_PC = 42991616, O_PD = 43065344, O_PR = 44113920, O_SK = 45162496, O_SV = 53551104, O_SC = 61939712, O_SD = 62087168, O_SR = 64184320;
constexpr size_t OFF_WIN = 0, OFF_WBR = 76546048, OFF_WOUT = 89128960, OFF_H = 97517568, OFF_PROJ = 166723584, OFF_SIDE = 789577728, OFF_DG = 790659072,
                 OFF_CNT = 790667520, OFF_KC = 790675456, OFF_CVT = 799064064, OFF_M1 = 807452672, OFF_BAR = 1118879744, WS_NEED = 1118879744 + 16384;
constexpr size_t M1_BLK = (size_t)NITEM * 8192;

struct Params {
  const float *x_prompt, *x_sample, *cache_k, *cache_v, *state_conv, *state_delta, *state_ret, *norm_pre, *norm_post, *w_in, *rel_bias, *conv_w, *a_log, *dt_bias,
      *delta_norm, *ret_norm, *w_ba, *w_bb, *w_bc, *w_out;
  float* out; unsigned char* ws;
};

DI unsigned pk2(float lo, float hi) { f32x2 v = {lo, hi}; bf2_t b = __builtin_convertvector(v, bf2_t); return __builtin_bit_cast(unsigned, b); }
DI bf16_t f2bf(float x) { return (bf16_t)(pk2(x, 0.f) & 0xffffu); }
DI float bflo(unsigned w) { return __uint_as_float(w << 16); }
DI float bfhi(unsigned w) { return __uint_as_float(w & 0xffff0000u); }
DI float bf2f(bf16_t b) { return __uint_as_float(((unsigned)b) << 16); }
DI float sigmoidf_(float x) { return 1.f / (1.f + __expf(-x)); }
DI float siluf_(float x) { return x / (1.f + __expf(-x)); }
DI int oblk() { int b = blockIdx.x; asm volatile("" : "+s"(b)); return __builtin_amdgcn_readfirstlane(b); }
DI int otid() { int t = threadIdx.x; asm volatile("" : "+v"(t)); return t; }
DI int kperm(int p) { return 16 * ((p >> 2) & 1) + 4 * (p >> 3) + (p & 3); }
DI int kinv(int x) { return 8 * ((x >> 2) & 3) + 4 * (x >> 4) + (x & 3); }
DI float wsum(float v) { for (int o = 32; o > 0; o >>= 1) v += __shfl_xor(v, o); return v; }
DI void unpack8(u32x4 a, float* o) { o[0] = bflo(a.x); o[1] = bfhi(a.x); o[2] = bflo(a.y); o[3] = bfhi(a.y); o[4] = bflo(a.z); o[5] = bfhi(a.z); o[6] = bflo(a.w); o[7] = bfhi(a.w); }
DI u32x4 pack8(const float* v) { u32x4 w; w.x = pk2(v[0], v[1]); w.y = pk2(v[2], v[3]); w.z = pk2(v[4], v[5]); w.w = pk2(v[6], v[7]); return w; }
DI bf16x8 pack_frag(f32x4 a, f32x4 b) { u32x4 w; w.x = pk2(a[0], a[1]); w.y = pk2(a[2], a[3]); w.z = pk2(b[0], b[1]); w.w = pk2(b[2], b[3]); return __builtin_bit_cast(bf16x8, w); }
#define MFMA16(a, b, c) __builtin_amdgcn_mfma_f32_16x16x32_bf16((a), (b), (c), 0, 0, 0)

namespace pg8 {
constexpr int BM = 256, BK = 64, HALF = 128, HTB = HALF * BK * 2, STAGE_BYTES = 8 * HTB, NXCD = 8, WGM = 8;
DI int lds_byte(int r, int c) { const int st = (r >> 4) * 2 + (c >> 5), rr = r & 15, cc = c & 31, ob = rr * 64 + cc * 2; return st * 1024 + (ob ^ (((ob >> 9) & 1) << 5)); }
DI void stage_rc(int b, int& R, int& C) { const int st = b / 1024, sb = b % 1024, swz = sb ^ (((sb >> 9) & 1) << 5); R = (st >> 1) * 16 + swz / 64; C = (st & 1) * 32 + (swz % 64) / 2; }
DI int perm32(int rho) { const int n = rho >> 4, i = rho & 15; return 8 * (i >> 2) + 4 * n + (i & 3); }
struct Unit { int pm, pn; };
struct Gemm { const bf16_t* A; const bf16_t* Bt; int M, N, K, lda, ldb, a_div, a_step; };
struct StaticOrder {
  int nM, nN, nwg, G, c;
  DI void init(int M, int N, int G_, int c_) { nM = M / BM; nN = N / BM; nwg = nM * nN; G = G_; c = c_; }
  DI bool next(int i, Unit& u) const {
    const long L = (long)i * G + c; if (L >= nwg) return false;
    int wgid = (int)L; { const int q = nwg / NXCD, r = nwg % NXCD, xcd = wgid % NXCD, off = wgid / NXCD; wgid = (xcd < r ? xcd * (q + 1) : r * (q + 1) + (xcd - r) * q) + off; }
    const int nig = WGM * nN, gid = wgid / nig, fm = gid * WGM, gsz = (nM - fm) < WGM ? (nM - fm) : WGM;
    u.pm = fm + ((wgid % nig) % gsz); u.pn = (wgid % nig) / gsz; return true;
  }
};

template <class Epi>
DI void gemm_phase(LAS unsigned char* lds, const Gemm g, const StaticOrder& S, const Epi& E) {
  const int tid = otid(), wid = __builtin_amdgcn_readfirstlane(tid >> 6), lane = tid & 63, wr = wid >> 2, wc = wid & 3, fr = lane & 15, fq = lane >> 4;
  const int K = g.K, nt = K / BK;
  unsigned voffA[2], voffB[2];
#pragma unroll
  for (int i = 0; i < 2; ++i) { int R, C; stage_rc(tid * 16 + i * 8192, R, C); const int Rb = Epi::PERM ? ((R & ~31) + perm32(R & 31)) : R;
    voffA[i] = (unsigned)(R * g.lda + C) * 2u; voffB[i] = (unsigned)(Rb * g.ldb + C) * 2u; }
  const size_t kstep = (size_t)(BK * 2);
  const size_t hstepA = (size_t)HALF * g.lda * 2, hstepB = (size_t)HALF * g.ldb * 2;
  const size_t tstepA = 2 * hstepA, tstepB = 2 * hstepB;
  const unsigned ldsw = (unsigned)wid * 1024u;
  const int aoff = lds_byte(wr * 64 + fr, fq * 8), boff = lds_byte(wc * 32 + fr, fq * 8);
#define PG8_SA(b, h) (((b) * 2 + (h)) * HTB)
#define PG8_SB(b, h) ((4 + (b) * 2 + (h)) * HTB)
#define PG8_STAGE(bufoff, gbase, voff) do { const char* _gb = (const char*)(gbase); asm volatile("" : "+s"(_gb)); _Pragma("unroll") for (int _i = 0; _i < 2; ++_i) \
    __builtin_amdgcn_global_load_lds((const unsigned*)(_gb + (voff)[_i]), (LAS unsigned*)(lds + (bufoff) + ldsw + _i * 8192), 16, 0, 0); } while (0)
#define PG8_LDA(dst, b, h) do { _Pragma("unroll") for (int m = 0; m < 4; ++m) _Pragma("unroll") for (int k = 0; k < 2; ++k) dst[m][k] = *(const LAS bf16x8*)(lds + PG8_SA(b, h) + aoff + m * 2048 + k * 1024); } while (0)
#define PG8_LDB(dst, b, h) do { _Pragma("unroll") for (int n = 0; n < 2; ++n) _Pragma("unroll") for (int k = 0; k < 2; ++k) dst[n][k] = *(const LAS bf16x8*)(lds + PG8_SB(b, h) + boff + n * 2048 + k * 1024); } while (0)
#define PG8_MMA(ai, bj, At, Bt) do { __builtin_amdgcn_s_setprio(1); _Pragma("unroll") for (int m = 0; m < 4; ++m) _Pragma("unroll") for (int n = 0; n < 2; ++n) _Pragma("unroll") for (int k = 0; k < 2; ++k) \
    acc[ai][bj][m][n] = __builtin_amdgcn_mfma_f32_16x16x32_bf16(Bt[n][k], At[m][k], acc[ai][bj][m][n], 0, 0, 0); __builtin_amdgcn_s_setprio(0); } while (0)
#define PG8_WAIT_V(n) asm volatile("s_waitcnt vmcnt(" #n ")" ::: "memory")
#define PG8_WAIT_L(n) asm volatile("s_waitcnt lgkmcnt(" #n ")" ::: "memory")
#define PG8_BAR __builtin_amdgcn_s_barrier()
#define PG8_SCHED __builtin_amdgcn_sched_barrier(0)
  Unit cur, nxt; int ui = 0;
  if (!S.next(0, cur)) return;
  f32x4 acc[2][2][4][2];
#pragma unroll
  for (int a = 0; a < 2; ++a)
#pragma unroll
    for (int b = 0; b < 2; ++b)
#pragma unroll
      for (int m = 0; m < 4; ++m)
#pragma unroll
        for (int n = 0; n < 2; ++n) acc[a][b][m][n] = (f32x4){0.f, 0.f, 0.f, 0.f};
  bf16x8 At[4][2], B0[2][2], B1[2][2];
  const char* cA = (const char*)g.A + (size_t)cur.pm * tstepA + (size_t)((cur.pn / g.a_div) * g.a_step); const char* cB = (const char*)g.Bt + (size_t)cur.pn * tstepB;
  PG8_STAGE(PG8_SB(0, 0), cB, voffB); PG8_STAGE(PG8_SA(0, 0), cA, voffA); PG8_STAGE(PG8_SB(0, 1), cB + hstepB, voffB); PG8_STAGE(PG8_SA(0, 1), cA + hstepA, voffA);
  if (wr == 1) PG8_BAR;
  PG8_WAIT_V(4); PG8_BAR;
  PG8_STAGE(PG8_SB(1, 0), cB + kstep, voffB); PG8_STAGE(PG8_SA(1, 0), cA + kstep, voffA); PG8_STAGE(PG8_SB(1, 1), cB + hstepB + kstep, voffB);
  PG8_WAIT_V(6); PG8_BAR;
  for (;;) {
    const bool has_next = S.next(ui + 1, nxt);
    const char* nA = has_next ? (const char*)g.A + (size_t)nxt.pm * tstepA + (size_t)((nxt.pn / g.a_div) * g.a_step) : cA; const char* nB = has_next ? (const char*)g.Bt + (size_t)nxt.pn * tstepB : cB;
    for (int t = 0; t < nt; t += 2) {
      const bool last = (t == nt - 2);
      const char* a1 = cA + (size_t)(t + 1) * kstep;
      const char* a2 = last ? nA : cA + (size_t)(t + 2) * kstep; const char* b2 = last ? nB : cB + (size_t)(t + 2) * kstep;
      const char* a3 = a2 + kstep; const char* b3 = b2 + kstep;
      PG8_LDB(B0, 0, 0); PG8_SCHED; PG8_LDA(At, 0, 0); PG8_STAGE(PG8_SA(1, 1), a1 + hstepA, voffA);
      PG8_WAIT_L(8); PG8_BAR; PG8_WAIT_L(0); PG8_MMA(0, 0, At, B0); PG8_BAR; PG8_SCHED;
      PG8_LDB(B1, 0, 1); PG8_STAGE(PG8_SB(0, 0), b2, voffB);
      PG8_BAR; PG8_WAIT_L(0); PG8_MMA(0, 1, At, B1); PG8_BAR;
      PG8_LDA(At, 0, 1); PG8_STAGE(PG8_SA(0, 0), a2, voffA);
      PG8_BAR; PG8_WAIT_L(0); PG8_MMA(1, 0, At, B0); PG8_BAR; PG8_SCHED;
      PG8_STAGE(PG8_SB(0, 1), b2 + hstepB, voffB);
      PG8_WAIT_V(6); PG8_BAR; PG8_MMA(1, 1, At, B1); PG8_BAR;
      PG8_LDB(B0, 1, 0); PG8_SCHED; PG8_LDA(At, 1, 0); PG8_STAGE(PG8_SA(0, 1), a2 + hstepA, voffA);
      PG8_WAIT_L(8); PG8_BAR; PG8_WAIT_L(0); PG8_MMA(0, 0, At, B0); PG8_BAR; PG8_SCHED;
      PG8_LDB(B1, 1, 1); PG8_STAGE(PG8_SB(1, 0), b3, voffB);
      PG8_BAR; PG8_WAIT_L(0); PG8_MMA(0, 1, At, B1); PG8_BAR;
      PG8_LDA(At, 1, 1); PG8_STAGE(PG8_SA(1, 0), a3, voffA);
      PG8_BAR; PG8_WAIT_L(0); PG8_MMA(1, 0, At, B0); PG8_BAR; PG8_SCHED;
      PG8_STAGE(PG8_SB(1, 1), b3 + hstepB, voffB);
      PG8_WAIT_V(6); PG8_BAR; PG8_MMA(1, 1, At, B1); PG8_BAR;
    }
    E(acc, cur, wr, wc, fr, fq);
    if (!has_next) break;
#pragma unroll
    for (int a = 0; a < 2; ++a)
#pragma unroll
      for (int b = 0; b < 2; ++b)
#pragma unroll
        for (int m = 0; m < 4; ++m)
#pragma unroll
          for (int n = 0; n < 2; ++n) acc[a][b][m][n] = (f32x4){0.f, 0.f, 0.f, 0.f};
    cur = nxt; cA = nA; cB = nB; ++ui;
  }
  PG8_WAIT_V(0);
  if (wr == 0) PG8_BAR;
  PG8_BAR;
#undef PG8_SA
#undef PG8_SB
#undef PG8_STAGE
#undef PG8_LDA
#undef PG8_LDB
#undef PG8_MMA
#undef PG8_WAIT_V
#undef PG8_WAIT_L
#undef PG8_BAR
#undef PG8_SCHED
}
}

struct EpiProj {
  static constexpr bool PERM = true;
  bf16_t* O; float* side; int ldc, nmain;
  DI void operator()(const f32x4 (&acc)[2][2][4][2], const pg8::Unit& u, int wr, int wc, int fr, int fq) const {
    const int row0 = u.pm * 256 + wr * 64 + fr;
    if (u.pn < nmain) {
      const int col0 = u.pn * 256 + wc * 32 + 8 * fq;
#pragma unroll
      for (int ai = 0; ai < 2; ++ai)
#pragma unroll
        for (int m = 0; m < 4; ++m) { bf16_t* rowp = O + (size_t)(row0 + ai * 128 + m * 16) * ldc + col0;
#pragma unroll
          for (int bj = 0; bj < 2; ++bj) { const f32x4 v0 = acc[ai][bj][m][0], v1 = acc[ai][bj][m][1];
            u32x4 w; w.x = pk2(v0[0], v0[1]); w.y = pk2(v0[2], v0[3]); w.z = pk2(v1[0], v1[1]); w.w = pk2(v1[2], v1[3]);
            *(u32x4*)(rowp + bj * 128) = w; } }
    } else if (wc == 0 && fq < 2) {
#pragma unroll
      for (int ai = 0; ai < 2; ++ai)
#pragma unroll
        for (int m = 0; m < 4; ++m) { float* sp = side + (size_t)(row0 + ai * 128 + m * 16) * 16 + 8 * fq;
          *(f32x4*)sp = acc[ai][0][m][0]; *(f32x4*)(sp + 4) = acc[ai][0][m][1]; }
    }
  }
};
struct EpiGate {
  static constexpr bool PERM = true;
  bf16_t* O; const bf16_t* proj; int br;
  DI void operator()(const f32x4 (&acc)[2][2][4][2], const pg8::Unit& u, int wr, int wc, int fr, int fq) const {
    const int row0 = u.pm * 256 + wr * 64 + fr, col0 = u.pn * 256 + wc * 32 + 8 * fq;
#pragma unroll
    for (int ai = 0; ai < 2; ++ai)
#pragma unroll
      for (int m = 0; m < 4; ++m) { const int row = row0 + ai * 128 + m * 16;
        bf16_t* rowp = O + (size_t)row * DM + col0; const bf16_t* gp = proj + (size_t)row * LDP + 12288 + br * 2048 + col0;
#pragma unroll
        for (int bj = 0; bj < 2; ++bj) { const f32x4 v0 = acc[ai][bj][m][0], v1 = acc[ai][bj][m][1];
          float gt[8], v[8]; unpack8(*(const u32x4*)(gp + bj * 128), gt);
#pragma unroll
          for (int j = 0; j < 4; ++j) { v[j] = v0[j] * sigmoidf_(gt[j]); v[4 + j] = v1[j] * sigmoidf_(gt[4 + j]); }
          if (br > 0) { float pv[8]; unpack8(*(const u32x4*)(rowp + bj * 128), pv);
#pragma unroll
            for (int j = 0; j < 8; ++j) v[j] += pv[j]; }
          *(u32x4*)(rowp + bj * 128) = pack8(v); } }
  }
};
struct EpiF32 {
  static constexpr bool PERM = false;
  float* C;
  DI void operator()(const f32x4 (&acc)[2][2][4][2], const pg8::Unit& u, int wr, int wc, int fr, int fq) const {
    const int row0 = u.pm * 256 + wr * 64 + fr, col0 = u.pn * 256 + wc * 32 + 4 * fq;
#pragma unroll
    for (int ai = 0; ai < 2; ++ai)
#pragma unroll
      for (int m = 0; m < 4; ++m) { float* rowp = C + (size_t)(row0 + ai * 128 + m * 16) * DM + col0;
#pragma unroll
        for (int bj = 0; bj < 2; ++bj)
#pragma unroll
          for (int n = 0; n < 2; ++n) *(f32x4*)(rowp + bj * 128 + n * 16) = acc[ai][bj][m][n]; }
  }
};

DI void conv_tile(float* T, const float* src, int ldsrc, int n0, int nvalid, int k0, bf16_t* dst, int K) {
  const int tid = otid();
  f32x4 v[8];
#pragma unroll
  for (int ps = 0; ps < 8; ++ps) { const int k = ps * 8 + (tid >> 6), c4 = (tid & 63) * 4;
    v[ps] = (f32x4){0.f, 0.f, 0.f, 0.f};
    if (c4 < nvalid) v[ps] = *(const f32x4*)(src + (size_t)(k0 + k) * ldsrc + n0 + c4); }
#pragma unroll
  for (int ps = 0; ps < 8; ++ps) { const int k = ps * 8 + (tid >> 6), c4 = (tid & 63) * 4;
    T[k * 257 + c4] = v[ps][0]; T[k * 257 + c4 + 1] = v[ps][1]; T[k * 257 + c4 + 2] = v[ps][2]; T[k * 257 + c4 + 3] = v[ps][3]; }
  __syncthreads();
#pragma unroll
  for (int i = 0; i < 4; ++i) { const int n = (tid >> 3) + 64 * i, kg = tid & 7; float w[8];
#pragma unroll
    for (int j = 0; j < 8; ++j) w[j] = T[(8 * kg + j) * 257 + n];
    *(u32x4*)(dst + (size_t)n * K + k0 + 8 * kg) = pack8(w); }
  __syncthreads();
}
DI void convert_weights(const Params& p, int l, float* T, int part, int first, int stride) {
  bf16_t* win = (bf16_t*)(p.ws + OFF_WIN); bf16_t* wbr = (bf16_t*)(p.ws + OFF_WBR); bf16_t* wout = (bf16_t*)(p.ws + OFF_WOUT);
  const int n_in = 73 * 32, n_br = 3 * 8 * 16, n_out = 8 * 32;
  const int t_lo = (part == 1) ? n_in + n_br : 0, t_hi = (part == 0) ? n_in + n_br : n_in + n_br + n_out;
  for (int t = t_lo + first; t < t_hi; t += stride) {
    if (t < n_in) { const int ntile = t >> 5, kt = t & 31, np0 = ntile * 256; int n0 = 0, nv = 256;
      if (np0 < 8192) n0 = np0; else if (np0 < 18432) n0 = np0 + 16; else { n0 = 8192; nv = 16; }
      conv_tile(T, p.w_in + (size_t)l * DM * NIN, NIN, n0, nv, kt * 64, win + (size_t)np0 * DM, DM);
    } else if (t < n_in + n_br) { const int u = t - n_in, br = u >> 7, r = u & 127, ntile = r >> 4, kt = r & 15;
      const float* src = (br == 0 ? p.w_ba : br == 1 ? p.w_bb : p.w_bc) + (size_t)l * 1024 * DM;
      conv_tile(T, src, DM, ntile * 256, 256, kt * 64, wbr + (size_t)br * DM * 1024 + (size_t)ntile * 256 * 1024, 1024);
    } else { const int u = t - n_in - n_br, ntile = u >> 5, kt = u & 31;
      conv_tile(T, p.w_out + (size_t)l * DM * DM, DM, ntile * 256, 256, kt * 64, wout + (size_t)ntile * 256 * DM, DM); }
  }
}

DI void prenorm_phase(const Params& p, int l) {
  bf16_t* h = (bf16_t*)(p.ws + OFF_H); const float* g = p.norm_pre + (size_t)l * DM;
  const int tid_ = otid(); const int lane = tid_ & 63, gw = oblk() * 8 + (tid_ >> 6), nw = gridDim.x * 8;
  for (int r = gw; r < MROWS; r += nw) {
    const float* xr = (r < 16384) ? p.x_prompt + (size_t)r * DM : p.x_sample + (size_t)(r - 16384) * DM;
    f32x4 v[8]; float ss = 0.f;
#pragma unroll
    for (int i = 0; i < 8; ++i) { v[i] = *(const f32x4*)(xr + i * 256 + lane * 4); ss += v[i][0] * v[i][0] + v[i][1] * v[i][1] + v[i][2] * v[i][2] + v[i][3] * v[i][3]; }
    ss = wsum(ss); const float rn = rsqrtf(ss * (1.f / DM) + 1e-6f);
#pragma unroll
    for (int i = 0; i < 8; ++i) { const f32x4 gg = *(const f32x4*)(g + i * 256 + lane * 4);
      u32x2 w; w.x = pk2(v[i][0] * rn * gg[0], v[i][1] * rn * gg[1]); w.y = pk2(v[i][2] * rn * gg[2], v[i][3] * rn * gg[3]);
      *(u32x2*)(h + (size_t)r * DM + i * 256 + lane * 4) = w; }
  }
}
DI void postnorm_phase(const Params& p, int l, int row_lo, int row_hi, int wg_first, int wg_count) {
  bf16_t* h = (bf16_t*)(p.ws + OFF_H); const float* ypre = (const float*)(p.ws + OFF_M1 + 69206016);
  const float* gpost = p.norm_post + (size_t)l * DM; const float* gpre = p.norm_pre + (size_t)(l + 1) * DM;
  const int tid_ = otid(); const int lane = tid_ & 63, gw = (oblk() - wg_first) * 8 + (tid_ >> 6), nw = wg_count * 8;
  for (int r = row_lo + gw; r < row_hi; r += nw) {
    const float* xr = (l > 0) ? p.out + (size_t)r * DM : ((r < 16384) ? p.x_prompt + (size_t)r * DM : p.x_sample + (size_t)(r - 16384) * DM);
    const float* yr = ypre + (size_t)r * DM;
    f32x4 v[8]; float ss = 0.f;
#pragma unroll
    for (int i = 0; i < 8; ++i) { v[i] = *(const f32x4*)(yr + i * 256 + lane * 4); ss += v[i][0] * v[i][0] + v[i][1] * v[i][1] + v[i][2] * v[i][2] + v[i][3] * v[i][3]; }
    ss = wsum(ss); const float rn = rsqrtf(ss * (1.f / DM) + 1e-6f); float s2 = 0.f;
#pragma unroll
    for (int i = 0; i < 8; ++i) { const f32x4 gg = *(const f32x4*)(gpost + i * 256 + lane * 4); const f32x4 xx = *(const f32x4*)(xr + i * 256 + lane * 4);
#pragma unroll
      for (int j = 0; j < 4; ++j) { v[i][j] = xx[j] + v[i][j] * rn * gg[j]; s2 += v[i][j] * v[i][j]; }
      *(f32x4*)(p.out + (size_t)r * DM + i * 256 + lane * 4) = v[i]; }
    if (l == 0) { s2 = wsum(s2); const float r2 = rsqrtf(s2 * (1.f / DM) + 1e-6f);
#pragma unroll
      for (int i = 0; i < 8; ++i) { const f32x4 gg = *(const f32x4*)(gpre + i * 256 + lane * 4);
        u32x2 w; w.x = pk2(v[i][0] * r2 * gg[0], v[i][1] * r2 * gg[1]); w.y = pk2(v[i][2] * r2 * gg[2], v[i][3] * r2 * gg[3]);
        *(u32x2*)(h + (size_t)r * DM + i * 256 + lane * 4) = w; } }
  }
}

template <class F> DI void write_T_perm(bf16_t* dst, F&& val) {
  const int t = otid(), r = t >> 2, q4 = t & 3, tb = q4 >> 1, p0 = 16 * (q4 & 1);
  float v[16];
#pragma unroll
  for (int j = 0; j < 16; ++j) v[j] = val(32 * tb + kperm(p0 + j), r);
  *(u32x4*)(dst + r * 64 + 32 * tb + p0) = pack8(v); *(u32x4*)(dst + r * 64 + 32 * tb + p0 + 8) = pack8(v + 8);
}
template <class F> DI void write_perm(bf16_t* dst, F&& val) {
  const int t = otid(), tok = t >> 3, cgp = t & 7, db = cgp >> 1, p0 = 16 * (cgp & 1);
  float v[16];
#pragma unroll
  for (int j = 0; j < 16; ++j) v[j] = val(tok, 32 * db + kperm(p0 + j));
  *(u32x4*)(dst + tok * 128 + 32 * db + p0) = pack8(v); *(u32x4*)(dst + tok * 128 + 32 * db + p0 + 8) = pack8(v + 8);
}

DI void conv16(const Params& p, const bf16_t* proj, int l, int ci, int ch0, int tok, float (&y)[16]) {
  const float* cw = p.conv_w + (size_t)l * 4 * 3072 + ch0;
#pragma unroll
  for (int c = 0; c < 16; ++c) y[c] = 0.f;
#pragma unroll
  for (int o = 0; o < 4; ++o) {
    const int t = tok - 3 + o; float xv[16];
    if (t >= 0 || (ci < 256 && (ci & 63) != 0)) {
      const bf16_t* src = proj + (size_t)(ci * 64 + t) * LDP + 4096 + ch0;
      unpack8(*(const u32x4*)src, xv); unpack8(*(const u32x4*)(src + 8), xv + 8);
    } else if (ci >= 256) {
      const float* sc = p.state_conv + ((size_t)(l * 8 + (ci - 256)) * 3 + (3 + t)) * 3072 + ch0;
#pragma unroll
      for (int q = 0; q < 4; ++q) { const f32x4 a = *(const f32x4*)(sc + 4 * q); xv[4 * q] = a[0]; xv[4 * q + 1] = a[1]; xv[4 * q + 2] = a[2]; xv[4 * q + 3] = a[3]; }
    } else {
#pragma unroll
      for (int c = 0; c < 16; ++c) xv[c] = 0.f;
    }
#pragma unroll
    for (int q = 0; q < 4; ++q) { const f32x4 w = *(const f32x4*)(cw + o * 3072 + 4 * q);
      y[4 * q] += w[0] * xv[4 * q]; y[4 * q + 1] += w[1] * xv[4 * q + 1]; y[4 * q + 2] += w[2] * xv[4 * q + 2]; y[4 * q + 3] += w[3] * xv[4 * q + 3]; }
  }
#pragma unroll
  for (int c = 0; c < 16; ++c) y[c] = siluf_(y[c]);
}

DI void conv_fetch(const Params& p, const bf16_t* proj, int l, int ci, int hh, int cgp, int tok, u32x4 (&raw)[3][4][2]) {
#pragma unroll
  for (int o = 0; o < 4; ++o) {
    const int t = tok - 3 + o;
#pragma unroll
    for (int mat = 0; mat < 3; ++mat) {
      const int ch0 = mat * 1024 + hh * 128 + 16 * cgp;
      if (t >= 0 || (ci < 256 && (ci & 63) != 0)) {
        const bf16_t* src = proj + (size_t)(ci * 64 + t) * LDP + 4096 + ch0;
        raw[mat][o][0] = *(const u32x4*)src; raw[mat][o][1] = *(const u32x4*)(src + 8);
      } else if (ci >= 256) {
        const float* sc = p.state_conv + ((size_t)(l * 8 + (ci - 256)) * 3 + (3 + t)) * 3072 + ch0; float f[16];
#pragma unroll
        for (int q = 0; q < 4; ++q) { const f32x4 a = *(const f32x4*)(sc + 4 * q); f[4 * q] = a[0]; f[4 * q + 1] = a[1]; f[4 * q + 2] = a[2]; f[4 * q + 3] = a[3]; }
        raw[mat][o][0] = pack8(f); raw[mat][o][1] = pack8(f + 8);
      } else { raw[mat][o][0] = (u32x4){0u, 0u, 0u, 0u}; raw[mat][o][1] = (u32x4){0u, 0u, 0u, 0u}; }
    }
  }
}
DI void conv_apply(const float* sCW, int mat, int cgp, const u32x4 (&raw)[3][4][2], float (&y)[16]) {
#pragma unroll
  for (int c = 0; c < 16; ++c) y[c] = 0.f;
#pragma unroll
  for (int o = 0; o < 4; ++o) { float xv[16]; unpack8(raw[mat][o][0], xv); unpack8(raw[mat][o][1], xv + 8);
#pragma unroll
    for (int q = 0; q < 4; ++q) { const f32x4 w = *(const f32x4*)(sCW + (mat * 4 + o) * 128 + 16 * cgp + 4 * q);
      y[4 * q] += w[0] * xv[4 * q]; y[4 * q + 1] += w[1] * xv[4 * q + 1]; y[4 * q + 2] += w[2] * xv[4 * q + 2]; y[4 * q + 3] += w[3] * xv[4 * q + 3]; } }
#pragma unroll
  for (int c = 0; c < 16; ++c) y[c] = siluf_(y[c]);
}

DI void delta_pre(const Params& p, int l, int it, unsigned char* smem) {
  const int ci = it >> 3, hh = it & 7, tid = otid(), wid = tid >> 6, lane = tid & 63, fr = lane & 15, fq = lane >> 4;
  bf16_t* sKB = (bf16_t*)smem; bf16_t* sQB = (bf16_t*)(smem + 17408); float* sKF = (float*)(smem + 34816); float* sVF = (float*)(smem + 68608);
  float* sA = (float*)(smem + 102400); float* sGC = (float*)(smem + 118784); float* sBT = sGC + 64; float* sEG = sGC + 128; float* sR1 = sGC + 192;
  const bf16_t* proj = (const bf16_t*)(p.ws + OFF_PROJ); const float* side = (const float*)(p.ws + OFF_SIDE);
  bf16_t* m1 = (bf16_t*)(p.ws + OFF_M1);
  bf16_t* dW = m1 + 0 * M1_BLK + (size_t)it * 8192; bf16_t* dQ = m1 + 1 * M1_BLK + (size_t)it * 8192; bf16_t* dKT = m1 + 2 * M1_BLK + (size_t)it * 8192;
  bf16_t* dUT = m1 + 3 * M1_BLK + (size_t)it * 8192; bf16_t* dIN = m1 + 8 * M1_BLK + (size_t)it * 4096;
  if (wid == 0) {
    const int row = ci * 64 + lane;
    const float bl = side[(size_t)row * 16 + hh], al = side[(size_t)row * 16 + 8 + hh] + p.dt_bias[l * 8 + hh];
    const float sp = al > 20.f ? al : log1pf(__expf(al));
    float g = -__expf(p.a_log[l * 8 + hh]) * sp;
#pragma unroll
    for (int o = 1; o < 64; o <<= 1) { const float t = __shfl_up(g, o); if (lane >= o) g += t; }
    const float bt = sigmoidf_(bl), eg = __expf(g);
    sGC[lane] = g; sBT[lane] = bt; sEG[lane] = eg; sR1[lane] = bt * eg;
    if (lane == 63) ((float*)(p.ws + OFF_DG))[it] = eg;
  }
  { const int tok = tid >> 3, cgp = tid & 7; float y[16]; const float* sCW = (const float*)(smem + 122880);
    u32x4 raw[3][4][2]; conv_fetch(p, proj, l, ci, hh, cgp, tok, raw);
    conv_apply(sCW, 0, cgp, raw, y);
    { float ss = 0.f;
#pragma unroll
      for (int c = 0; c < 16; ++c) ss += y[c] * y[c];
      ss += __shfl_xor(ss, 1); ss += __shfl_xor(ss, 2); ss += __shfl_xor(ss, 4);
      const float rn = rsqrtf(ss + 1e-6f) * 0.08838834764831845f;
#pragma unroll
      for (int c = 0; c < 16; ++c) y[c] *= rn;
      *(u32x4*)(sQB + tok * 136 + 16 * cgp) = pack8(y); *(u32x4*)(sQB + tok * 136 + 16 * cgp + 8) = pack8(y + 8); }
    conv_apply(sCW, 1, cgp, raw, y);
    { float ss = 0.f;
#pragma unroll
      for (int c = 0; c < 16; ++c) ss += y[c] * y[c];
      ss += __shfl_xor(ss, 1); ss += __shfl_xor(ss, 2); ss += __shfl_xor(ss, 4);
      const float rn = rsqrtf(ss + 1e-6f);
#pragma unroll
      for (int c = 0; c < 16; ++c) { y[c] *= rn; sKF[tok * 132 + 16 * cgp + c] = y[c]; }
      *(u32x4*)(sKB + tok * 136 + 16 * cgp) = pack8(y); *(u32x4*)(sKB + tok * 136 + 16 * cgp + 8) = pack8(y + 8); }
    conv_apply(sCW, 2, cgp, raw, y);
#pragma unroll
    for (int c = 0; c < 16; ++c) sVF[tok * 132 + 16 * cgp + c] = y[c];
  }
  __syncthreads();
  {
    const int mt = wid & 3; const bf16_t* Asrc = (wid < 4) ? sKB : sQB;
    bf16x8 a[4];
#pragma unroll
    for (int s = 0; s < 4; ++s) a[s] = *(const bf16x8*)(Asrc + (16 * mt + fr) * 136 + 32 * s + 8 * fq);
#pragma unroll
    for (int nt = 0; nt < 4; ++nt) {
      f32x4 c = {0.f, 0.f, 0.f, 0.f};
#pragma unroll
      for (int s = 0; s < 4; ++s) { const bf16x8 b = *(const bf16x8*)(sKB + (16 * nt + fr) * 136 + 32 * s + 8 * fq); c = MFMA16(a[s], b, c); }
      const int j = 16 * nt + fr; const float gj = sGC[j];
#pragma unroll
      for (int r = 0; r < 4; ++r) { const int i = 16 * mt + 4 * fq + r; const float gi = sGC[i]; const float dec = __expf(fminf(gi - gj, 0.f));
        if (wid < 4) sA[i * 64 + j] = (i > j) ? sBT[i] * c[r] * dec : 0.f;
        else dIN[i * 64 + (j & 32) + kinv(j & 31)] = f2bf((i >= j) ? c[r] * dec : 0.f); }
    }
  }
  __syncthreads();
  if (wid < 4) {
    int zv = 0; asm volatile("" : "+v"(zv));
    const int c = tid; const float* src = (c < 128) ? sVF + c : sKF + (c - 128); const float* scl = ((c < 128) ? sBT : sR1) + zv; const float* sAz = sA + zv;
    float sol[64];
    f32x2 sp[32];
#pragma unroll
    for (int i = 0; i < 32; ++i) sp[i] = (f32x2){0.f, 0.f};
#pragma unroll
    for (int i = 0; i < 64; ++i) {
      f32x2 a0 = {src[i * 132] * scl[i], 0.f}, a1 = {0.f, 0.f};
#pragma unroll
      for (int j4 = 0; j4 < (i + 3) / 4; ++j4) { const f32x4 a = *(const f32x4*)(sAz + i * 64 + 4 * j4);
        a0 -= (f32x2){a[0], a[1]} * sp[2 * j4]; a1 -= (f32x2){a[2], a[3]} * sp[2 * j4 + 1]; }
      const f32x2 t = a0 + a1; const float r = t[0] + t[1];
      sol[i] = r; sp[i >> 1][i & 1] = r;
    }
    if (c < 128) {
#pragma unroll
      for (int q = 0; q < 8; ++q) *(u32x4*)(dUT + c * 64 + 8 * q) = pack8(sol + 8 * q);
    } else { const int d = c - 128, pos = (d & ~31) + kinv(d & 31);
#pragma unroll
      for (int i = 0; i < 64; ++i) dW[i * 128 + pos] = f2bf(-sol[i]); }
  } else {
    const int t = tid - 256; const float gl = sGC[63];
    { const int tok = t >> 2, db = t & 3; const float eg = sEG[tok]; float v[32];
#pragma unroll
      for (int pp = 0; pp < 32; ++pp) v[pp] = bf2f(sQB[tok * 136 + 32 * db + kperm(pp)]) * eg;
#pragma unroll
      for (int q = 0; q < 4; ++q) *(u32x4*)(dQ + tok * 128 + 32 * db + 8 * q) = pack8(v + 8 * q); }
    { const int d = t >> 1, tb = t & 1; float v[32];
#pragma unroll
      for (int pp = 0; pp < 32; ++pp) { const int tok = 32 * tb + kperm(pp); v[pp] = sKF[tok * 132 + d] * __expf(gl - sGC[tok]); }
#pragma unroll
      for (int q = 0; q < 4; ++q) *(u32x4*)(dKT + d * 64 + 32 * tb + 8 * q) = pack8(v + 8 * q); }
  }
  __syncthreads();
}

DI void ret_pre(const Params& p, int l, int it, unsigned char* smem) {
  const int ci = it >> 3, hh = it & 7, tid = otid(), wid = tid >> 6, lane = tid & 63, fr = lane & 15, fq = lane >> 4;
  bf16_t* sQB = (bf16_t*)smem; bf16_t* sKB = (bf16_t*)(smem + 17408); float* sKZ = (float*)(smem + 34816); float* sVF = (float*)(smem + 68608);
  const bf16_t* proj = (const bf16_t*)(p.ws + OFF_PROJ);
  bf16_t* m1 = (bf16_t*)(p.ws + OFF_M1);
  bf16_t* rQ = m1 + 4 * M1_BLK + (size_t)it * 8192; bf16_t* rKT = m1 + 5 * M1_BLK + (size_t)it * 8192; bf16_t* rVT = m1 + 6 * M1_BLK + (size_t)it * 8192;
  bf16_t* rIN = m1 + 8 * M1_BLK + (size_t)NITEM * 4096 + (size_t)it * 4096;
  const float lg = __logf(1.f - exp2f(-5.f - (float)hh));
  { const int tok = tid >> 3, cgp = tid & 7; const bf16_t* rp = proj + (size_t)(ci * 64 + tok) * LDP;
    const int pos = (ci >= 256) ? 2048 + tok : (ci & 63) * 64 + tok;
    float q1[8], q2[8], k1[8], k2[8], vv[16];
    unpack8(*(const u32x4*)(rp + 8192 + hh * 128 + 8 * cgp), q1); unpack8(*(const u32x4*)(rp + 8192 + hh * 128 + 64 + 8 * cgp), q2);
    unpack8(*(const u32x4*)(rp + 9216 + hh * 128 + 8 * cgp), k1); unpack8(*(const u32x4*)(rp + 9216 + hh * 128 + 64 + 8 * cgp), k2);
    unpack8(*(const u32x4*)(rp + 10240 + hh * 128 + 16 * cgp), vv); unpack8(*(const u32x4*)(rp + 10240 + hh * 128 + 16 * cgp + 8), vv + 8);
    const float zeta = __expf(lg * (float)(63 - tok)) * 0.08838834764831845f;
    float qa[8], qb[8], ka[8], kb[8];
#pragma unroll
    for (int j = 0; j < 8; ++j) { const int i = 8 * cgp + j;
      const float inv = exp2f(-(float)i * (13.287712379549449f / 64.f)); const float ang = (float)pos * inv;
      float rv = ang * 0.15915494309189535f; rv = rv - floorf(rv);
      const float sn = __builtin_amdgcn_sinf(rv), cs = __builtin_amdgcn_cosf(rv);
      qa[j] = q1[j] * cs - q2[j] * sn; qb[j] = q1[j] * sn + q2[j] * cs;
      ka[j] = (k1[j] * cs - k2[j] * sn); kb[j] = (k1[j] * sn + k2[j] * cs);
      sKZ[tok * 132 + i] = ka[j] * zeta; sKZ[tok * 132 + 64 + i] = kb[j] * zeta;
      ka[j] *= 0.08838834764831845f; kb[j] *= 0.08838834764831845f; }
    *(u32x4*)(sQB + tok * 136 + 8 * cgp) = pack8(qa); *(u32x4*)(sQB + tok * 136 + 64 + 8 * cgp) = pack8(qb);
    *(u32x4*)(sKB + tok * 136 + 8 * cgp) = pack8(ka); *(u32x4*)(sKB + tok * 136 + 64 + 8 * cgp) = pack8(kb);
#pragma unroll
    for (int c = 0; c < 16; ++c) sVF[tok * 132 + 16 * cgp + c] = vv[c];
  }
  __syncthreads();
  { const int mt = wid >> 1;
    bf16x8 a[4];
#pragma unroll
    for (int s = 0; s < 4; ++s) a[s] = *(const bf16x8*)(sQB + (16 * mt + fr) * 136 + 32 * s + 8 * fq);
#pragma unroll
    for (int n2 = 0; n2 < 2; ++n2) { const int nt = 2 * (wid & 1) + n2;
      f32x4 c = {0.f, 0.f, 0.f, 0.f};
#pragma unroll
      for (int s = 0; s < 4; ++s) { const bf16x8 b = *(const bf16x8*)(sKB + (16 * nt + fr) * 136 + 32 * s + 8 * fq); c = MFMA16(a[s], b, c); }
      const int j = 16 * nt + fr;
#pragma unroll
      for (int r = 0; r < 4; ++r) { const int i = 16 * mt + 4 * fq + r;
        rIN[i * 64 + (j & 32) + kinv(j & 31)] = f2bf((i >= j) ? c[r] * __expf(lg * (float)(i - j)) : 0.f); }
    }
  }
  write_perm(rQ, [&](int tok, int d) { return bf2f(sQB[tok * 136 + d]) * __expf(lg * (float)(tok + 1)); });
  write_T_perm(rKT, [&](int tok, int d) { return sKZ[tok * 132 + d]; });
  write_T_perm(rVT, [&](int tok, int e) { return sVF[tok * 132 + e]; });
  __syncthreads();
}

DI void misc_item(const Params& p, int l, int it, unsigned char* smem) {
  const int ci = it >> 3, hh = it & 7, tid = otid();
  bf16_t* sVB = (bf16_t*)smem;
  const bf16_t* proj = (const bf16_t*)(p.ws + OFF_PROJ);
  bf16_t* aVT = (bf16_t*)(p.ws + OFF_M1) + 7 * M1_BLK + (size_t)it * 8192;
  { const int tok = tid >> 3, cgp = tid & 7; const bf16_t* rp = proj + (size_t)(ci * 64 + tok) * LDP;
    const u32x4 v0 = *(const u32x4*)(rp + 2048 + hh * 128 + 16 * cgp), v1 = *(const u32x4*)(rp + 2048 + hh * 128 + 16 * cgp + 8);
    *(u32x4*)(sVB + tok * 136 + 16 * cgp) = v0; *(u32x4*)(sVB + tok * 136 + 16 * cgp + 8) = v1;
    float* ok = nullptr; float* ov = nullptr;
    if (ci < 256) { const int b = ci >> 6, c = ci & 63;
      if (c >= 56) { const size_t o = ((((size_t)l * 4 + b) * 512 + (c - 56) * 64 + tok) * 8 + hh) * 128 + 16 * cgp; ok = p.out + O_PK + o; ov = p.out + O_PV + o; }
    } else { const size_t o = ((((size_t)l * 8 + (ci - 256)) * 512 + 448 + tok) * 8 + hh) * 128 + 16 * cgp; ok = p.out + O_SK + o; ov = p.out + O_SV + o; }
    if (ok) { float f[16]; unpack8(v0, f); unpack8(v1, f + 8);
#pragma unroll
      for (int q = 0; q < 4; ++q) *(f32x4*)(ov + 4 * q) = (f32x4){f[4 * q], f[4 * q + 1], f[4 * q + 2], f[4 * q + 3]};
      unpack8(*(const u32x4*)(rp + 1024 + hh * 128 + 16 * cgp), f); unpack8(*(const u32x4*)(rp + 1024 + hh * 128 + 16 * cgp + 8), f + 8);
#pragma unroll
      for (int q = 0; q < 4; ++q) *(f32x4*)(ok + 4 * q) = (f32x4){f[4 * q], f[4 * q + 1], f[4 * q + 2], f[4 * q + 3]}; }
  }
  if (ci >= 256 || (ci & 63) == 63) {
    float* oc = (ci < 256) ? p.out + O_PC + ((size_t)l * 4 + (ci >> 6)) * 3 * 3072 : p.out + O_SC + ((size_t)l * 8 + (ci - 256)) * 3 * 3072;
    for (int idx = tid; idx < 3 * 384; idx += 512) { const int rr = idx / 384, ch = hh * 384 + idx % 384;
      oc[rr * 3072 + ch] = bf2f(proj[(size_t)(ci * 64 + 61 + rr) * LDP + 4096 + ch]); }
  }
  __syncthreads();
  write_T_perm(aVT, [&](int tok, int e) { return bf2f(sVB[tok * 136 + e]); });
  __syncthreads();
}
DI void cache_item(const Params& p, int l, int cit, unsigned char* smem) {
  const int hh = cit & 7, j = (cit >> 3) & 7, sb = cit >> 6, tid = otid();
  float* sVF = (float*)smem;
  bf16_t* kc = (bf16_t*)(p.ws + OFF_KC) + (size_t)cit * 8192; bf16_t* cvt = (bf16_t*)(p.ws + OFF_CVT) + (size_t)cit * 8192;
  { const int key = tid >> 3, cgp = tid & 7;
    const size_t so = ((((size_t)l * 8 + sb) * 512 + 64 * j + key) * 8 + hh) * 128 + 16 * cgp;
    float fk[16], fv[16];
#pragma unroll
    for (int q = 0; q < 4; ++q) { const f32x4 a = *(const f32x4*)(p.cache_k + so + 4 * q); const f32x4 b = *(const f32x4*)(p.cache_v + so + 4 * q);
#pragma unroll
      for (int e = 0; e < 4; ++e) { fk[4 * q + e] = a[e]; fv[4 * q + e] = b[e]; } }
    *(u32x4*)(kc + key * 128 + 16 * cgp) = pack8(fk); *(u32x4*)(kc + key * 128 + 16 * cgp + 8) = pack8(fk + 8);
#pragma unroll
    for (int c = 0; c < 16; ++c) sVF[key * 132 + 16 * cgp + c] = fv[c];
    if (j >= 1) { const size_t oo = ((((size_t)l * 8 + sb) * 512 + 64 * (j - 1) + key) * 8 + hh) * 128 + 16 * cgp;
#pragma unroll
      for (int q = 0; q < 4; ++q) { *(f32x4*)(p.out + O_SK + oo + 4 * q) = (f32x4){fk[4 * q], fk[4 * q + 1], fk[4 * q + 2], fk[4 * q + 3]};
        *(f32x4*)(p.out + O_SV + oo + 4 * q) = (f32x4){fv[4 * q], fv[4 * q + 1], fv[4 * q + 2], fv[4 * q + 3]}; } }
  }
  __syncthreads();
  write_T_perm(cvt, [&](int tok, int e) { return sVF[tok * 132 + e]; });
  __syncthreads();
}

template <int TYPE> DI void scan_item(const Params& p, int l, int seq, int hh, int sl) {
  const int lane = otid() & 63, fr = lane & 15, fq = lane >> 4, e0 = 16 * sl;
  const int nsteps = seq < 4 ? 64 : 1, ci0 = seq < 4 ? seq * 64 : 256 + (seq - 4);
  const bf16_t* m1 = (const bf16_t*)(p.ws + OFF_M1);
  bf16_t* proj = (bf16_t*)(p.ws + OFF_PROJ);
  const float* dG = (const float*)(p.ws + OFF_DG);
  f32x4 S[8];
  if (seq < 4) {
#pragma unroll
    for (int t = 0; t < 8; ++t) S[t] = (f32x4){0.f, 0.f, 0.f, 0.f};
  } else { const float* st = (TYPE == 0 ? p.state_delta : p.state_ret) + (((size_t)l * 8 + (seq - 4)) * 8 + hh) * 16384 + e0 + fr;
#pragma unroll
    for (int t = 0; t < 8; ++t)
#pragma unroll
      for (int i = 0; i < 4; ++i) S[t][i] = st[(16 * t + 4 * fq + i) * 128]; }
  const float gret = __expf(64.f * __logf(1.f - exp2f(-5.f - (float)hh)));
  for (int n = 0; n < nsteps; ++n) {
    const int it = (ci0 + n) * 8 + hh;
    const bf16_t* W = m1 + 0 * M1_BLK + (size_t)it * 8192;
    const bf16_t* Q = m1 + (TYPE == 0 ? 1 : 4) * M1_BLK + (size_t)it * 8192;
    const bf16_t* KT = m1 + (TYPE == 0 ? 2 : 5) * M1_BLK + (size_t)it * 8192;
    const bf16_t* UT = m1 + (TYPE == 0 ? 3 : 6) * M1_BLK + (size_t)it * 8192;
    const bf16_t* IN = m1 + 8 * M1_BLK + (TYPE == 0 ? 0 : (size_t)NITEM * 4096) + (size_t)it * 4096;
    bf16x8 Sf[4];
#pragma unroll
    for (int s = 0; s < 4; ++s) Sf[s] = pack_frag(S[2 * s], S[2 * s + 1]);
    bf16x8 Vf[2];
    if (TYPE == 0) {
      f32x4 Vn[4];
#pragma unroll
      for (int mt = 0; mt < 4; ++mt) { const u32x2 u = *(const u32x2*)(UT + (e0 + fr) * 64 + 16 * mt + 4 * fq); Vn[mt] = (f32x4){bflo(u.x), bfhi(u.x), bflo(u.y), bfhi(u.y)}; }
#pragma unroll
      for (int s = 0; s < 4; ++s)
#pragma unroll
        for (int mt = 0; mt < 4; ++mt) { const bf16x8 a = *(const bf16x8*)(W + (16 * mt + fr) * 128 + 32 * s + 8 * fq); Vn[mt] = MFMA16(a, Sf[s], Vn[mt]); }
      Vf[0] = pack_frag(Vn[0], Vn[1]); Vf[1] = pack_frag(Vn[2], Vn[3]);
    } else {
      Vf[0] = *(const bf16x8*)(UT + (e0 + fr) * 64 + 8 * fq); Vf[1] = *(const bf16x8*)(UT + (e0 + fr) * 64 + 32 + 8 * fq);
    }
    f32x4 O[4];
#pragma unroll
    for (int nt = 0; nt < 4; ++nt) O[nt] = (f32x4){0.f, 0.f, 0.f, 0.f};
#pragma unroll
    for (int s = 0; s < 4; ++s)
#pragma unroll
      for (int nt = 0; nt < 4; ++nt) { const bf16x8 b = *(const bf16x8*)(Q + (16 * nt + fr) * 128 + 32 * s + 8 * fq); O[nt] = MFMA16(Sf[s], b, O[nt]); }
#pragma unroll
    for (int s2 = 0; s2 < 2; ++s2)
#pragma unroll
      for (int nt = 0; nt < 4; ++nt) { const bf16x8 b = *(const bf16x8*)(IN + (16 * nt + fr) * 64 + 32 * s2 + 8 * fq); O[nt] = MFMA16(Vf[s2], b, O[nt]); }
#pragma unroll
    for (int nt = 0; nt < 4; ++nt) { u32x2 w; w.x = pk2(O[nt][0], O[nt][1]); w.y = pk2(O[nt][2], O[nt][3]);
      *(u32x2*)(proj + (size_t)((ci0 + n) * 64 + 16 * nt + fr) * LDP + (TYPE == 0 ? C_OBRAW : C_OCRAW) + hh * 128 + e0 + 4 * fq) = w; }
    const float gb = (TYPE == 0) ? dG[it] : gret;
#pragma unroll
    for (int dt = 0; dt < 8; ++dt) { S[dt] = S[dt] * gb;
#pragma unroll
      for (int s2 = 0; s2 < 2; ++s2) { const bf16x8 a = *(const bf16x8*)(KT + (16 * dt + fr) * 64 + 32 * s2 + 8 * fq); S[dt] = MFMA16(a, Vf[s2], S[dt]); } }
  }
  { float* so = p.out + (seq < 4 ? (TYPE == 0 ? O_PD : O_PR) + (((size_t)l * 4 + seq) * 8 + hh) * 16384 : (TYPE == 0 ? O_SD : O_SR) + (((size_t)l * 8 + (seq - 4)) * 8 + hh) * 16384) + e0 + fr;
#pragma unroll
    for (int t = 0; t < 8; ++t)
#pragma unroll
      for (int i = 0; i < 4; ++i) so[(16 * t + 4 * fq + i) * 128] = S[t][i]; }
}

template <int TYPE> DI void scan_step(const unsigned char* B, f32x4 (&S)[8], const u32x4 (&uc)[2], float gb, bf16_t* orow, int fr, int fq) {
#define SW_A128(base_, row_, s_) (*(const bf16x8*)((base_) + (((row_) * 16 + ((4 * (s_) + fq) ^ fr)) * 16)))
#define SW_A64(base_, row_, s_) (*(const bf16x8*)((base_) + (((row_) * 8 + ((4 * (s_) + fq) ^ (fr >> 1))) * 16)))
  bf16x8 Sf[4];
#pragma unroll
  for (int s = 0; s < 4; ++s) Sf[s] = pack_frag(S[2 * s], S[2 * s + 1]);
  bf16x8 Vf[2];
  if (TYPE == 0) {
    f32x4 Vn[4];
#pragma unroll
    for (int mt = 0; mt < 4; ++mt) { const unsigned ux = uc[mt >> 1][(mt & 1) * 2], uy = uc[mt >> 1][(mt & 1) * 2 + 1]; Vn[mt] = (f32x4){bflo(ux), bfhi(ux), bflo(uy), bfhi(uy)}; }
#pragma unroll
    for (int s = 0; s < 4; ++s)
#pragma unroll
      for (int mt = 0; mt < 4; ++mt) Vn[mt] = MFMA16(SW_A128(B, 16 * mt + fr, s), Sf[s], Vn[mt]);
    Vf[0] = pack_frag(Vn[0], Vn[1]); Vf[1] = pack_frag(Vn[2], Vn[3]);
  } else { Vf[0] = __builtin_bit_cast(bf16x8, uc[0]); Vf[1] = __builtin_bit_cast(bf16x8, uc[1]); }
  f32x4 O[4];
#pragma unroll
  for (int nt = 0; nt < 4; ++nt) O[nt] = (f32x4){0.f, 0.f, 0.f, 0.f};
#pragma unroll
  for (int s = 0; s < 4; ++s)
#pragma unroll
    for (int nt = 0; nt < 4; ++nt) O[nt] = MFMA16(Sf[s], SW_A128(B + 16384, 16 * nt + fr, s), O[nt]);
#pragma unroll
  for (int s2 = 0; s2 < 2; ++s2)
#pragma unroll
    for (int nt = 0; nt < 4; ++nt) O[nt] = MFMA16(Vf[s2], SW_A64(B + 49152, 16 * nt + fr, s2), O[nt]);
#pragma unroll
  for (int nt = 0; nt < 4; ++nt) { u32x2 w; w.x = pk2(O[nt][0], O[nt][1]); w.y = pk2(O[nt][2], O[nt][3]); *(u32x2*)(orow + (size_t)(16 * nt) * LDP) = w; }
#pragma unroll
  for (int dt = 0; dt < 8; ++dt) { S[dt] = S[dt] * gb;
#pragma unroll
    for (int s2 = 0; s2 < 2; ++s2) S[dt] = MFMA16(SW_A64(B + 32768, 16 * dt + fr, s2), Vf[s2], S[dt]); }
#undef SW_A128
#undef SW_A64
}
template <int TYPE> DI void scan_wg(const Params& p, int l, int seq, int hh, unsigned char* smem) {
  const int tid = otid(), lane = tid & 63, wv = tid >> 6, fr = lane & 15, fq = lane >> 4, e0 = 16 * wv;
  const int ci0 = seq * 64;
  const bf16_t* m1 = (const bf16_t*)(p.ws + OFF_M1);
  bf16_t* proj = (bf16_t*)(p.ws + OFF_PROJ);
  const float* dG = (const float*)(p.ws + OFF_DG);
  const bf16_t* gW = m1 + 0 * M1_BLK; const bf16_t* gQ = m1 + (TYPE == 0 ? 1 : 4) * M1_BLK; const bf16_t* gKT = m1 + (TYPE == 0 ? 2 : 5) * M1_BLK;
  const bf16_t* gUT = m1 + (TYPE == 0 ? 3 : 6) * M1_BLK; const bf16_t* gIN = m1 + 8 * M1_BLK + (TYPE == 0 ? 0 : (size_t)NITEM * 4096);
  f32x4 S[8];
#pragma unroll
  for (int t = 0; t < 8; ++t) S[t] = (f32x4){0.f, 0.f, 0.f, 0.f};
  const float gvec = (TYPE == 0) ? dG[(ci0 + lane) * 8 + hh] : __expf(64.f * __logf(1.f - exp2f(-5.f - (float)hh)));
  int d128[2], d64[2];
#pragma unroll
  for (int k = 0; k < 2; ++k) { const int q = tid + 512 * k; { const int r = q >> 4, c = q & 15; d128[k] = (r * 16 + (c ^ (r & 15))) * 16; }
    { const int r = q >> 3, c = q & 7; d64[k] = (r * 8 + (c ^ ((r >> 1) & 7))) * 16; } }
  u32x4 st[2][7]; u32x4 uv[2][2];
#define SW_ISSUE(n_, X_) do { const size_t it_ = (size_t)((ci0 + (n_)) * 8 + hh); \
    if (TYPE == 0) { st[X_][0] = *(const u32x4*)(gW + it_ * 8192 + tid * 8); st[X_][1] = *(const u32x4*)(gW + it_ * 8192 + (tid + 512) * 8); } \
    st[X_][2] = *(const u32x4*)(gQ + it_ * 8192 + tid * 8); st[X_][3] = *(const u32x4*)(gQ + it_ * 8192 + (tid + 512) * 8); \
    st[X_][4] = *(const u32x4*)(gKT + it_ * 8192 + tid * 8); st[X_][5] = *(const u32x4*)(gKT + it_ * 8192 + (tid + 512) * 8); \
    st[X_][6] = *(const u32x4*)(gIN + it_ * 4096 + tid * 8); \
    if (TYPE == 0) { _Pragma("unroll") for (int mt = 0; mt < 4; ++mt) { const u32x2 u_ = *(const u32x2*)(gUT + it_ * 8192 + (e0 + fr) * 64 + 16 * mt + 4 * fq); uv[X_][mt >> 1][(mt & 1) * 2] = u_.x; uv[X_][mt >> 1][(mt & 1) * 2 + 1] = u_.y; } } \
    else { uv[X_][0] = *(const u32x4*)(gUT + it_ * 8192 + (e0 + fr) * 64 + 8 * fq); uv[X_][1] = *(const u32x4*)(gUT + it_ * 8192 + (e0 + fr) * 64 + 32 + 8 * fq); } } while (0)
#define SW_COMMIT(b_, X_) do { unsigned char* B_ = smem + (b_) * 57344; \
    if (TYPE == 0) { *(u32x4*)(B_ + d128[0]) = st[X_][0]; *(u32x4*)(B_ + d128[1]) = st[X_][1]; } \
    *(u32x4*)(B_ + 16384 + d128[0]) = st[X_][2]; *(u32x4*)(B_ + 16384 + d128[1]) = st[X_][3]; \
    *(u32x4*)(B_ + 32768 + d64[0]) = st[X_][4]; *(u32x4*)(B_ + 32768 + d64[1]) = st[X_][5]; *(u32x4*)(B_ + 49152 + d64[0]) = st[X_][6]; \
    ucur[0] = uv[X_][0]; ucur[1] = uv[X_][1]; } while (0)
  u32x4 ucur[2];
  bf16_t* obase = proj + (size_t)(ci0 * 64 + fr) * LDP + (TYPE == 0 ? C_OBRAW : C_OCRAW) + hh * 128 + e0 + 4 * fq;
  SW_ISSUE(0, 0);
  SW_COMMIT(0, 0);
  SW_ISSUE(1, 1);
  __syncthreads();
  for (int n = 0; n < 64; n += 2) {
    if (n + 2 < 64) SW_ISSUE(n + 2, 0);
    scan_step<TYPE>(smem, S, ucur, __shfl(gvec, n), obase + (size_t)(n * 64) * LDP, fr, fq);
    SW_COMMIT(1, 1);
    __syncthreads();
    if (n + 3 < 64) SW_ISSUE(n + 3, 1);
    scan_step<TYPE>(smem + 57344, S, ucur, __shfl(gvec, n + 1), obase + (size_t)((n + 1) * 64) * LDP, fr, fq);
    if (n + 2 < 64) SW_COMMIT(0, 0);
    __syncthreads();
  }
#undef SW_ISSUE
#undef SW_COMMIT
  { float* so = p.out + (TYPE == 0 ? O_PD : O_PR) + (((size_t)l * 4 + seq) * 8 + hh) * 16384 + e0 + fr;
#pragma unroll
    for (int t = 0; t < 8; ++t)
#pragma unroll
      for (int i = 0; i < 4; ++i) so[(16 * t + 4 * fq + i) * 128] = S[t][i]; }
}

template <int TYPE> DI void scan_step2(const unsigned char* B, f32x4 (&S)[2][8], const u32x4 (&uc)[2][2], float gb, bf16_t* orow, int fr, int fq) {
#define SW_A128(base_, row_, s_) (*(const bf16x8*)((base_) + (((row_) * 16 + ((4 * (s_) + fq) ^ fr)) * 16)))
#define SW_A64(base_, row_, s_) (*(const bf16x8*)((base_) + (((row_) * 8 + ((4 * (s_) + fq) ^ (fr >> 1))) * 16)))
  bf16x8 Sf[2][4];
#pragma unroll
  for (int c = 0; c < 2; ++c)
#pragma unroll
    for (int s = 0; s < 4; ++s) Sf[c][s] = pack_frag(S[c][2 * s], S[c][2 * s + 1]);
  bf16x8 Vf[2][2];
  if (TYPE == 0) {
    f32x4 Vn[2][4];
#pragma unroll
    for (int c = 0; c < 2; ++c)
#pragma unroll
      for (int mt = 0; mt < 4; ++mt) { const unsigned ux = uc[c][mt >> 1][(mt & 1) * 2], uy = uc[c][mt >> 1][(mt & 1) * 2 + 1]; Vn[c][mt] = (f32x4){bflo(ux), bfhi(ux), bflo(uy), bfhi(uy)}; }
#pragma unroll
    for (int s = 0; s < 4; ++s)
#pragma unroll
      for (int mt = 0; mt < 4; ++mt) { const bf16x8 a = SW_A128(B, 16 * mt + fr, s); Vn[0][mt] = MFMA16(a, Sf[0][s], Vn[0][mt]); Vn[1][mt] = MFMA16(a, Sf[1][s], Vn[1][mt]); }
#pragma unroll
    for (int c = 0; c < 2; ++c) { Vf[c][0] = pack_frag(Vn[c][0], Vn[c][1]); Vf[c][1] = pack_frag(Vn[c][2], Vn[c][3]); }
  } else {
#pragma unroll
    for (int c = 0; c < 2; ++c) { Vf[c][0] = __builtin_bit_cast(bf16x8, uc[c][0]); Vf[c][1] = __builtin_bit_cast(bf16x8, uc[c][1]); }
  }
  f32x4 O[2][4];
#pragma unroll
  for (int c = 0; c < 2; ++c)
#pragma unroll
    for (int nt = 0; nt < 4; ++nt) O[c][nt] = (f32x4){0.f, 0.f, 0.f, 0.f};
#pragma unroll
  for (int s = 0; s < 4; ++s)
#pragma unroll
    for (int nt = 0; nt < 4; ++nt) { const bf16x8 b = SW_A128(B + 16384, 16 * nt + fr, s); O[0][nt] = MFMA16(Sf[0][s], b, O[0][nt]); O[1][nt] = MFMA16(Sf[1][s], b, O[1][nt]); }
#pragma unroll
  for (int s2 = 0; s2 < 2; ++s2)
#pragma unroll
    for (int nt = 0; nt < 4; ++nt) { const bf16x8 b = SW_A64(B + 49152, 16 * nt + fr, s2); O[0][nt] = MFMA16(Vf[0][s2], b, O[0][nt]); O[1][nt] = MFMA16(Vf[1][s2], b, O[1][nt]); }
#pragma unroll
  for (int c = 0; c < 2; ++c)
#pragma unroll
    for (int nt = 0; nt < 4; ++nt) { u32x2 w; w.x = pk2(O[c][nt][0], O[c][nt][1]); w.y = pk2(O[c][nt][2], O[c][nt][3]); *(u32x2*)(orow + (size_t)(16 * nt) * LDP + 16 * c) = w; }
#pragma unroll
  for (int dt = 0; dt < 8; ++dt) { S[0][dt] = S[0][dt] * gb; S[1][dt] = S[1][dt] * gb;
#pragma unroll
    for (int s2 = 0; s2 < 2; ++s2) { const bf16x8 a = SW_A64(B + 32768, 16 * dt + fr, s2); S[0][dt] = MFMA16(a, Vf[0][s2], S[0][dt]); S[1][dt] = MFMA16(a, Vf[1][s2], S[1][dt]); } }
#undef SW_A128
#undef SW_A64
}
template <int TYPE> DI void scan_wg2(const Params& p, int l, int seq, int hh, unsigned char* smem) {
  const int tid = otid(), lane = tid & 63, wv = tid >> 6, fr = lane & 15, fq = lane >> 4;
  const int ci0 = seq * 64;
  const bf16_t* m1 = (const bf16_t*)(p.ws + OFF_M1);
  const bf16_t* gW = m1 + 0 * M1_BLK; const bf16_t* gQ = m1 + (TYPE == 0 ? 1 : 4) * M1_BLK; const bf16_t* gKT = m1 + (TYPE == 0 ? 2 : 5) * M1_BLK;
  const bf16_t* gUT = m1 + (TYPE == 0 ? 3 : 6) * M1_BLK; const bf16_t* gIN = m1 + 8 * M1_BLK + (TYPE == 0 ? 0 : (size_t)NITEM * 4096);
  if (wv >= 4) {
    const int lt = tid - 256;
    const int b128 = ((lt >> 4) * 16 + ((lt & 15) ^ ((lt >> 4) & 15))) * 16, b64 = ((lt >> 3) * 8 + ((lt & 7) ^ ((lt >> 4) & 7))) * 16;
    u32x4 st[2][14];
#define LW_ISSUE(n_, X_) do { const size_t it_ = (size_t)((ci0 + (n_)) * 8 + hh); \
      _Pragma("unroll") for (int k = 0; k < 4; ++k) { if (TYPE == 0) st[X_][k] = *(const u32x4*)(gW + it_ * 8192 + (lt + 256 * k) * 8); \
        st[X_][4 + k] = *(const u32x4*)(gQ + it_ * 8192 + (lt + 256 * k) * 8); st[X_][8 + k] = *(const u32x4*)(gKT + it_ * 8192 + (lt + 256 * k) * 8); } \
      st[X_][12] = *(const u32x4*)(gIN + it_ * 4096 + lt * 8); st[X_][13] = *(const u32x4*)(gIN + it_ * 4096 + (lt + 256) * 8); } while (0)
#define LW_COMMIT(b_, X_) do { unsigned char* B_ = smem + (b_) * 57344; \
      _Pragma("unroll") for (int k = 0; k < 4; ++k) { if (TYPE == 0) *(u32x4*)(B_ + b128 + k * 4096) = st[X_][k]; \
        *(u32x4*)(B_ + 16384 + b128 + k * 4096) = st[X_][4 + k]; *(u32x4*)(B_ + 32768 + b64 + k * 4096) = st[X_][8 + k]; } \
      *(u32x4*)(B_ + 49152 + b64) = st[X_][12]; *(u32x4*)(B_ + 49152 + b64 + 4096) = st[X_][13]; } while (0)
    LW_ISSUE(0, 0); LW_COMMIT(0, 0); LW_ISSUE(1, 1);
    __syncthreads();
    for (int n = 0; n < 64; n += 2) {
      if (n + 2 < 64) LW_ISSUE(n + 2, 0);
      LW_COMMIT(1, 1);
      __syncthreads();
      if (n + 3 < 64) LW_ISSUE(n + 3, 1);
      if (n + 2 < 64) LW_COMMIT(0, 0);
      __syncthreads();
    }
#undef LW_ISSUE
#undef LW_COMMIT
  } else {
    const int e0 = 32 * wv;
    bf16_t* proj = (bf16_t*)(p.ws + OFF_PROJ);
    const float* dG = (const float*)(p.ws + OFF_DG);
    f32x4 S[2][8];
#pragma unroll
    for (int c = 0; c < 2; ++c)
#pragma unroll
      for (int t = 0; t < 8; ++t) S[c][t] = (f32x4){0.f, 0.f, 0.f, 0.f};
    const float gvec = (TYPE == 0) ? dG[(ci0 + lane) * 8 + hh] : __expf(64.f * __logf(1.f - exp2f(-5.f - (float)hh)));
    u32x4 ucur[2][2], unext[2][2];
#define CW_ULOAD(n_, dst_) do { const size_t it_ = (size_t)((ci0 + (n_)) * 8 + hh); _Pragma("unroll") for (int c = 0; c < 2; ++c) { \
      if (TYPE == 0) { _Pragma("unroll") for (int mt = 0; mt < 4; ++mt) { const u32x2 u_ = *(const u32x2*)(gUT + it_ * 8192 + (e0 + 16 * c + fr) * 64 + 16 * mt + 4 * fq); dst_[c][mt >> 1][(mt & 1) * 2] = u_.x; dst_[c][mt >> 1][(mt & 1) * 2 + 1] = u_.y; } } \
      else { dst_[c][0] = *(const u32x4*)(gUT + it_ * 8192 + (e0 + 16 * c + fr) * 64 + 8 * fq); dst_[c][1] = *(const u32x4*)(gUT + it_ * 8192 + (e0 + 16 * c + fr) * 64 + 32 + 8 * fq); } } } while (0)
    bf16_t* obase = proj + (size_t)(ci0 * 64 + fr) * LDP + (TYPE == 0 ? C_OBRAW : C_OCRAW) + hh * 128 + e0 + 4 * fq;
    CW_ULOAD(0, ucur);
    __syncthreads();
    for (int n = 0; n < 64; ++n) {
      if (n + 1 < 64) CW_ULOAD(n + 1, unext);
      scan_step2<TYPE>(smem + (n & 1) * 57344, S, ucur, __shfl(gvec, n), obase + (size_t)(n * 64) * LDP, fr, fq);
#pragma unroll
      for (int c = 0; c < 2; ++c) { ucur[c][0] = unext[c][0]; ucur[c][1] = unext[c][1]; }
      __syncthreads();
    }
#undef CW_ULOAD
    { float* so = p.out + (TYPE == 0 ? O_PD : O_PR) + (((size_t)l * 4 + seq) * 8 + hh) * 16384 + e0 + fr;
#pragma unroll
      for (int c = 0; c < 2; ++c)
#pragma unroll
        for (int t = 0; t < 8; ++t)
#pragma unroll
          for (int i = 0; i < 4; ++i) so[(16 * t + 4 * fq + i) * 128 + 16 * c] = S[c][t][i]; }
  }
}

DI void attn_item(const Params& p, int l, int ai) {
  const int qt = ai & 3, hh = (ai >> 2) & 7, ci = ai >> 5;
  const int lane = otid() & 63, fr = lane & 15, fq = lane >> 4;
  bf16_t* proj = (bf16_t*)(p.ws + OFF_PROJ);
  const bf16_t* aVT = (const bf16_t*)(p.ws + OFF_M1) + 7 * M1_BLK;
  const bf16_t* kcb = (const bf16_t*)(p.ws + OFF_KC); const bf16_t* cvt = (const bf16_t*)(p.ws + OFF_CVT);
  const float* rb = p.rel_bias + ((size_t)l * 8 + hh) * 257;
  const int qrow = ci * 64 + 16 * qt + fr;
  bf16x8 Qf[4];
#pragma unroll
  for (int s = 0; s < 4; ++s) Qf[s] = *(const bf16x8*)(proj + (size_t)qrow * LDP + hh * 128 + 32 * s + 8 * fq);
  const int jmin = (ci < 256) ? ((ci & 63) >= 8 ? 0 : 8 - (ci & 63)) : 0;
  const float bfar = rb[256]; const int iq = 16 * qt + fr;
  float m = -1e30f, lsum = 0.f;
  f32x4 O[8];
#pragma unroll
  for (int et = 0; et < 8; ++et) O[et] = (f32x4){0.f, 0.f, 0.f, 0.f};
#pragma unroll 1
  for (int grp = 0; grp < 3; ++grp) {
    if (3 * grp + 2 < jmin) continue;
    f32x4 sc[12]; float gmx = -1e30f;
#pragma unroll
    for (int jj = 0; jj < 3; ++jj) { const int j = 3 * grp + jj;
      if (j >= jmin) {
        const bf16_t* Kp; int ks;
        if (ci < 256 || j == 8) { Kp = proj + (size_t)((ci < 256 ? ci - 8 + j : ci) * 64) * LDP + 1024 + hh * 128; ks = LDP; }
        else { Kp = kcb + (size_t)(((ci - 256) * 8 + j) * 8 + hh) * 8192; ks = 128; }
#pragma unroll
        for (int kt = 0; kt < 4; ++kt) {
          f32x4 c = {0.f, 0.f, 0.f, 0.f};
#pragma unroll
          for (int s = 0; s < 4; ++s) { const bf16x8 a = *(const bf16x8*)(Kp + (size_t)(16 * kt + fr) * ks + 32 * s + 8 * fq); c = MFMA16(a, Qf[s], c); }
#pragma unroll
          for (int i = 0; i < 4; ++i) { float bias = bfar;
            if (grp == 2) { const int r = 64 * j + 16 * kt + 4 * fq + i; int dist = 512 + iq - r; dist = dist < -128 ? -128 : (dist > 128 ? 128 : dist); bias = rb[dist + 128]; }
            c[i] = c[i] * 0.08838834764831845f + bias; gmx = fmaxf(gmx, c[i]); }
          sc[4 * jj + kt] = c;
        }
      } else {
#pragma unroll
        for (int kt = 0; kt < 4; ++kt) sc[4 * jj + kt] = (f32x4){-1e30f, -1e30f, -1e30f, -1e30f};
      }
    }
    gmx = fmaxf(gmx, __shfl_xor(gmx, 16)); gmx = fmaxf(gmx, __shfl_xor(gmx, 32));
    const float mnew = fmaxf(m, gmx), alpha = __expf(m - mnew); m = mnew;
    lsum *= alpha;
#pragma unroll
    for (int et = 0; et < 8; ++et) O[et] = O[et] * alpha;
#pragma unroll
    for (int t = 0; t < 12; ++t)
#pragma unroll
      for (int i = 0; i < 4; ++i) { const float e = __expf(sc[t][i] - m); sc[t][i] = e; lsum += e; }
#pragma unroll
    for (int jj = 0; jj < 3; ++jj) { const int j = 3 * grp + jj;
      if (j >= jmin) {
        const bf16_t* Vp;
        if (ci < 256 || j == 8) Vp = aVT + (size_t)((ci < 256 ? ci - 8 + j : ci) * 8 + hh) * 8192;
        else Vp = cvt + (size_t)(((ci - 256) * 8 + j) * 8 + hh) * 8192;
#pragma unroll
        for (int s2 = 0; s2 < 2; ++s2) { const bf16x8 pf = pack_frag(sc[4 * jj + 2 * s2], sc[4 * jj + 2 * s2 + 1]);
#pragma unroll
          for (int et = 0; et < 8; ++et) { const bf16x8 a = *(const bf16x8*)(Vp + (16 * et + fr) * 64 + 32 * s2 + 8 * fq); O[et] = MFMA16(a, pf, O[et]); } }
      }
    }
  }
  lsum += __shfl_xor(lsum, 16); lsum += __shfl_xor(lsum, 32);
  const float inv = 1.f / lsum;
#pragma unroll
  for (int et = 0; et < 8; ++et) { const u32x2 z = *(const u32x2*)(proj + (size_t)qrow * LDP + 3072 + hh * 128 + 16 * et + 4 * fq);
    u32x2 w; w.x = pk2(O[et][0] * inv * siluf_(bflo(z.x)), O[et][1] * inv * siluf_(bfhi(z.x))); w.y = pk2(O[et][2] * inv * siluf_(bflo(z.y)), O[et][3] * inv * siluf_(bfhi(z.y)));
    *(u32x2*)(proj + (size_t)qrow * LDP + C_ACAT + hh * 128 + 16 * et + 4 * fq) = w; }
}

DI void attn_stage(const unsigned char* Kl, const float* sB, int j, int iq, float bfar, const bf16x8 (&Qf)[4], f32x4 (&O)[8], float& m, float& lsum, int fr, int fq) {
#define AW_A128(base_, row_, s_) (*(const bf16x8*)((base_) + (((row_) * 16 + ((4 * (s_) + fq) ^ fr)) * 16)))
#define AW_A64(base_, row_, s_) (*(const bf16x8*)((base_) + (((row_) * 8 + ((4 * (s_) + fq) ^ (fr >> 1))) * 16)))
  const unsigned char* Vl = Kl + 32768;
  f32x4 sc[4]; float gmx = -1e30f;
#pragma unroll
  for (int kt = 0; kt < 4; ++kt) {
    f32x4 c = {0.f, 0.f, 0.f, 0.f};
#pragma unroll
    for (int s = 0; s < 4; ++s) c = MFMA16(AW_A128(Kl, 16 * kt + fr, s), Qf[s], c);
#pragma unroll
    for (int i = 0; i < 4; ++i) { float bias = bfar;
      if (j >= 6) { const int r = 64 * j + 16 * kt + 4 * fq + i; int dist = 512 + iq - r; dist = dist < -128 ? -128 : (dist > 128 ? 128 : dist); bias = sB[dist + 128]; }
      c[i] = c[i] * 0.08838834764831845f + bias; gmx = fmaxf(gmx, c[i]); }
    sc[kt] = c;
  }
  gmx = fmaxf(gmx, __shfl_xor(gmx, 16)); gmx = fmaxf(gmx, __shfl_xor(gmx, 32));
  const float mnew = fmaxf(m, gmx), alpha = __expf(m - mnew); m = mnew;
  lsum *= alpha;
#pragma unroll
  for (int et = 0; et < 8; ++et) O[et] = O[et] * alpha;
#pragma unroll
  for (int kt = 0; kt < 4; ++kt)
#pragma unroll
    for (int i = 0; i < 4; ++i) { const float e = __expf(sc[kt][i] - m); sc[kt][i] = e; lsum += e; }
#pragma unroll
  for (int s2 = 0; s2 < 2; ++s2) { const bf16x8 pf = pack_frag(sc[2 * s2], sc[2 * s2 + 1]);
#pragma unroll
    for (int et = 0; et < 8; ++et) O[et] = MFMA16(AW_A64(Vl, 16 * et + fr, s2), pf, O[et]); }
#undef AW_A128
#undef AW_A64
}
DI void attn_wg(const Params& p, int l, int wi, unsigned char* smem) {
  const int tid = otid(), lane = tid & 63, wv = tid >> 6, fr = lane & 15, fq = lane >> 4;
  const int ci = wi >> 2, hp = wi & 3, hsel = wv >> 2, hh = 2 * hp + hsel, qt = wv & 3;
  bf16_t* proj = (bf16_t*)(p.ws + OFF_PROJ);
  const bf16_t* aVT = (const bf16_t*)(p.ws + OFF_M1) + 7 * M1_BLK;
  const bf16_t* kcb = (const bf16_t*)(p.ws + OFF_KC); const bf16_t* cvt = (const bf16_t*)(p.ws + OFF_CVT);
  const float* rb = p.rel_bias + ((size_t)l * 8 + 2 * hp) * 257;
  float* sBias = (float*)(smem + 131072 + 256);
  const int qrow = ci * 64 + 16 * qt + fr;
  bf16x8 Qf[4];
#pragma unroll
  for (int s = 0; s < 4; ++s) Qf[s] = *(const bf16x8*)(proj + (size_t)qrow * LDP + hh * 128 + 32 * s + 8 * fq);
  const int jmin = (ci < 256) ? ((ci & 63) >= 8 ? 0 : 8 - (ci & 63)) : 0;
  const float bfar = rb[hsel * 257 + 256]; const int iq = 16 * qt + fr;
  const int row0 = tid >> 4, kcol = tid & 15;
  const int dKb = (row0 * 16 + (kcol ^ (row0 & 15))) * 16, dVb = 32768 + ((tid >> 3) * 8 + ((tid & 7) ^ ((tid >> 4) & 7))) * 16;
  u32x4 st[2][8];
#define AW_ISSUE(j_, X_) do { const bf16_t* Kb_; const bf16_t* Vb_; int ks_; size_t khs_; \
    if (ci < 256 || (j_) == 8) { const int cj_ = (ci < 256) ? ci - 8 + (j_) : ci; Kb_ = proj + (size_t)(cj_ * 64) * LDP + 1024 + 2 * hp * 128; ks_ = LDP; khs_ = 128; Vb_ = aVT + (size_t)(cj_ * 8 + 2 * hp) * 8192; } \
    else { const size_t o_ = (size_t)(((ci - 256) * 8 + (j_)) * 8 + 2 * hp) * 8192; Kb_ = kcb + o_; ks_ = 128; khs_ = 8192; Vb_ = cvt + o_; } \
    const bf16_t* kp_ = Kb_ + (size_t)row0 * ks_ + kcol * 8; \
    _Pragma("unroll") for (int k = 0; k < 4; ++k) { st[X_][k] = *(const u32x4*)(kp_ + (k >> 1) * khs_ + (size_t)(32 * (k & 1)) * ks_); st[X_][4 + k] = *(const u32x4*)(Vb_ + (size_t)(tid + 512 * k) * 8); } } while (0)
#define AW_COMMIT(b_, X_) do { unsigned char* B_ = smem + (b_) * 65536; _Pragma("unroll") for (int k = 0; k < 4; ++k) { \
    *(u32x4*)(B_ + dKb + (k >> 1) * 16384 + (k & 1) * 8192) = st[X_][k]; *(u32x4*)(B_ + dVb + (k >> 1) * 16384 + (k & 1) * 8192) = st[X_][4 + k]; } } while (0)
  float m = -1e30f, lsum = 0.f;
  f32x4 O[8];
#pragma unroll
  for (int et = 0; et < 8; ++et) O[et] = (f32x4){0.f, 0.f, 0.f, 0.f};
  AW_ISSUE(jmin, 0);
  if (tid < 257) { sBias[tid] = rb[tid]; sBias[260 + tid] = rb[257 + tid]; }
  AW_COMMIT(0, 0);
  if (jmin + 1 < 9) AW_ISSUE(jmin + 1, 1);
  __syncthreads();
  const float* sB = sBias + hsel * 260;
  for (int j = jmin; j < 9; j += 2) {
    if (j + 2 < 9) AW_ISSUE(j + 2, 0);
    attn_stage(smem + hsel * 16384, sB, j, iq, bfar, Qf, O, m, lsum, fr, fq);
    if (j + 1 < 9) AW_COMMIT(1, 1);
    __syncthreads();
    if (j + 1 >= 9) break;
    if (j + 3 < 9) AW_ISSUE(j + 3, 1);
    attn_stage(smem + 65536 + hsel * 16384, sB, j + 1, iq, bfar, Qf, O, m, lsum, fr, fq);
    if (j + 2 < 9) AW_COMMIT(0, 0);
    __syncthreads();
  }
#undef AW_ISSUE
#undef AW_COMMIT
  lsum += __shfl_xor(lsum, 16); lsum += __shfl_xor(lsum, 32);
  const float inv = 1.f / lsum;
#pragma unroll
  for (int et = 0; et < 8; ++et) { const u32x2 z = *(const u32x2*)(proj + (size_t)qrow * LDP + 3072 + hh * 128 + 16 * et + 4 * fq);
    u32x2 w; w.x = pk2(O[et][0] * inv * siluf_(bflo(z.x)), O[et][1] * inv * siluf_(bfhi(z.x))); w.y = pk2(O[et][2] * inv * siluf_(bflo(z.y)), O[et][3] * inv * siluf_(bfhi(z.y)));
    *(u32x2*)(proj + (size_t)qrow * LDP + C_ACAT + hh * 128 + 16 * et + 4 * fq) = w; }
}

DI void m2_phase(const Params& p, int l, int rep, unsigned char* smem) {
  const int tid_ = otid(); const int wv = tid_ >> 6;
  if (oblk() < 64) {
    const int chain = oblk(), ty = chain >> 5, sq = (chain & 31) >> 3, hh = chain & 7;
    for (int r3 = 0; r3 < R_SW; ++r3) { if (ty == 0) scan_wg2<0>(p, l, sq, hh, smem); else scan_wg2<1>(p, l, sq, hh, smem); }
  } else {
    for (int idx = (oblk() - 64) * 8 + wv; idx < 1024; idx += (gridDim.x - 64) * 8) {
      const int ty = idx >> 9, r = idx & 511, sq = 4 + (r >> 6), hh = (r >> 3) & 7, sl = r & 7;
      if (ty == 0) scan_item<0>(p, l, sq, hh, sl); else scan_item<1>(p, l, sq, hh, sl); }
  }
  unsigned* cnt = (unsigned*)(p.ws + OFF_CNT) + 64 * (l * 2 + rep);
  for (;;) {
    __syncthreads();
    if (tid_ == 0) *(volatile unsigned*)(smem + 131072) = atomicAdd(cnt, 1u);
    __syncthreads();
    const unsigned idx = *(volatile unsigned*)(smem + 131072);
    if (idx >= 1056u) break;
    for (int r2 = 0; r2 < R_AT; ++r2) attn_wg(p, l, (int)idx, smem);
  }
}

DI void m3_phase(const Params& p, int l) {
  bf16_t* proj = (bf16_t*)(p.ws + OFF_PROJ);
  const int tid_ = otid(); const int lane = tid_ & 63, gw = oblk() * 8 + (tid_ >> 6), nw = gridDim.x * 8;
  for (int wi = gw; wi < 2 * MROWS; wi += nw) {
    const int r = wi >> 1, br = wi & 1; bf16_t* rp = proj + (size_t)r * LDP;
    float v[16], z[16];
    unpack8(*(const u32x4*)(rp + (br ? C_OCRAW : C_OBRAW) + 16 * lane), v); unpack8(*(const u32x4*)(rp + (br ? C_OCRAW : C_OBRAW) + 16 * lane + 8), v + 8);
    unpack8(*(const u32x4*)(rp + (br ? 11264 : 7168) + 16 * lane), z); unpack8(*(const u32x4*)(rp + (br ? 11264 : 7168) + 16 * lane + 8), z + 8);
    const float* nw_ = br ? p.ret_norm + (size_t)l * 1024 + 16 * lane : p.delta_norm + (size_t)l * 128 + 16 * (lane & 7);
    float mu = 0.f;
    if (br) {
#pragma unroll
      for (int c = 0; c < 16; ++c) mu += v[c];
      mu += __shfl_xor(mu, 1); mu += __shfl_xor(mu, 2); mu += __shfl_xor(mu, 4); mu *= (1.f / 128.f); }
    float ss = 0.f;
#pragma unroll
    for (int c = 0; c < 16; ++c) { v[c] -= mu; ss += v[c] * v[c]; }
    ss += __shfl_xor(ss, 1); ss += __shfl_xor(ss, 2); ss += __shfl_xor(ss, 4);
    const float rn = rsqrtf(ss * (1.f / 128.f) + 1e-6f);
#pragma unroll
    for (int c = 0; c < 16; ++c) v[c] = v[c] * rn * nw_[c] * siluf_(z[c]);
    *(u32x4*)(rp + C_ACAT + 1024 + br * 1024 + 16 * lane) = pack8(v); *(u32x4*)(rp + C_ACAT + 1024 + br * 1024 + 16 * lane + 8) = pack8(v + 8);
  }
}

DI void merge_phase(const Params& p) {
  const bf16_t* proj = (const bf16_t*)(p.ws + OFF_PROJ); const bf16_t* P = (const bf16_t*)(p.ws + OFF_M1); bf16_t* mg = (bf16_t*)(p.ws + OFF_H);
  const int tid_ = otid(); const int lane = tid_ & 63, gw = oblk() * 8 + (tid_ >> 6), nw = gridDim.x * 8;
  for (int r = gw; r < MROWS; r += nw) {
    const bf16_t* pr = P + (size_t)r * (3 * DM); const bf16_t* gr = proj + (size_t)r * LDP + 12288;
#pragma unroll
    for (int q = 0; q < 4; ++q) { const int c = q * 512 + lane * 8; float acc[8];
#pragma unroll
      for (int j = 0; j < 8; ++j) acc[j] = 0.f;
#pragma unroll
      for (int br = 0; br < 3; ++br) { float pv[8], gv[8]; unpack8(*(const u32x4*)(pr + br * DM + c), pv); unpack8(*(const u32x4*)(gr + br * DM + c), gv);
#pragma unroll
        for (int j = 0; j < 8; ++j) acc[j] += pv[j] * sigmoidf_(gv[j]); }
      *(u32x4*)(mg + (size_t)r * DM + c) = pack8(acc); }
  }
}

#define XB_TMO      128
#define XB_XCNT(j)  (256  + 64 * (j))
#define XB_XSUB(j)  (1280 + 64 * (j))
#define XB_XGEN(j)  (2304 + 64 * (j))
#define XB_TOP      3328
#define XB_TOPGEN   3392
#define XCD_BAR_WORDS 3456
#define XB_SPIN_CAP (1u << 18)
DI unsigned xb_ld(unsigned* p) { return __hip_atomic_load(p, __ATOMIC_RELAXED, __HIP_MEMORY_SCOPE_AGENT); }
DI unsigned xb_add(unsigned* p, unsigned v) { return __hip_atomic_fetch_add(p, v, __ATOMIC_RELAXED, __HIP_MEMORY_SCOPE_AGENT); }
DI unsigned xb_xcc_id() { return (unsigned)__builtin_amdgcn_s_getreg((3 << 11) | 20) & 0xFu; }
#define XB_SPIN(cond, bar) do { unsigned _sp = 0; while (cond) { __builtin_amdgcn_s_sleep(1); \
    if ((++_sp & 255u) == 0u) { if (xb_ld(&(bar)[XB_TMO])) break; if (_sp > XB_SPIN_CAP) { atomicAdd(&(bar)[XB_TMO], 1u); break; } } } } while (0)
struct XcdBarrier { unsigned* bar; unsigned x; volatile LAS unsigned* st; };
DI XcdBarrier xcd_barrier_post(unsigned* bar, volatile LAS unsigned* st) {
  XcdBarrier b; b.bar = bar; b.x = xb_xcc_id(); b.st = st;
  if (threadIdx.x == 0) (void)xb_add(&bar[XB_XCNT(b.x)], 1u);
  return b;
}
DI void xcd_barrier_complete(unsigned* bar, unsigned x, unsigned& nloc, unsigned& nx) {
  const unsigned G = gridDim.x * gridDim.y * gridDim.z;
  unsigned sum, cnt, mine, sp = 0u;
  for (;;) {
    sum = 0u; cnt = 0u; mine = 0u;
#pragma unroll
    for (unsigned j = 0; j < 16; ++j) { const unsigned c = xb_ld(&bar[XB_XCNT(j)]); sum += c; cnt += (c > 0u) ? 1u : 0u; mine = (j == x) ? c : mine; }
    if (sum == G) break;
    __builtin_amdgcn_s_sleep(1);
    if ((++sp & 255u) == 0u) { if (xb_ld(&bar[XB_TMO])) break; if (sp > XB_SPIN_CAP) { atomicAdd(&bar[XB_TMO], 1u); break; } }
  }
  nloc = mine > 0u ? mine : 1u; nx = cnt > 0u ? cnt : 1u;
}
DI void xcd_barrier(const XcdBarrier& b) {
  asm volatile("s_waitcnt vmcnt(0)" ::: "memory");
  __syncthreads();
  if (threadIdx.x == 0) {
    unsigned* bar = b.bar;
    __builtin_amdgcn_s_waitcnt(0);
    unsigned nloc = b.st[0], nx = b.st[1];
    if (nloc == 0u) { xcd_barrier_complete(bar, b.x, nloc, nx); b.st[0] = nloc; b.st[1] = nx; }
    const unsigned old = xb_add(&bar[XB_XSUB(b.x)], 1u);
    const unsigned gen = old / nloc;
    if (old + 1u == (gen + 1u) * nloc) {
      __builtin_amdgcn_fence(__ATOMIC_RELEASE, "agent");
      asm volatile("s_waitcnt vmcnt(0)" ::: "memory");
      const unsigned og = xb_add(&bar[XB_TOP], 1u);
      const unsigned tg = og / nx;
      if (og + 1u == (tg + 1u) * nx) xb_add(&bar[XB_TOPGEN], 1u);
      else XB_SPIN(xb_ld(&bar[XB_TOPGEN]) == tg, bar);
      __builtin_amdgcn_fence(__ATOMIC_ACQUIRE, "agent");
      xb_add(&bar[XB_XGEN(b.x)], 1u);
      asm volatile("s_waitcnt vmcnt(0)" ::: "memory");
    } else {
      XB_SPIN(xb_ld(&bar[XB_XGEN(b.x)]) == gen, bar);
      __builtin_amdgcn_fence(__ATOMIC_ACQUIRE, "agent");
      asm volatile("s_waitcnt vmcnt(0)" ::: "memory");
    }
  }
  __syncthreads();
}

__global__ void __launch_bounds__(512, 2) mega(Params p) {
  extern __shared__ __attribute__((aligned(16))) unsigned char smem[];
  cg::grid_group grid = cg::this_grid();
  const int G = gridDim.x;
  if (threadIdx.x == 0) { ((volatile LAS unsigned*)(LAS unsigned char*)smem)[(131072 + 16) / 4] = 0u; ((volatile LAS unsigned*)(LAS unsigned char*)smem)[(131072 + 20) / 4] = 0u; }
  __syncthreads();
  XcdBarrier xb = xcd_barrier_post((unsigned*)(p.ws + OFF_BAR), (volatile LAS unsigned*)((LAS unsigned char*)smem + 131072 + 16));
  if (oblk() == 0 && threadIdx.x < 4) ((unsigned*)(p.ws + OFF_CNT))[64 * threadIdx.x] = 0u;
  if (T_ROW) { convert_weights(p, 0, (float*)smem, 2, oblk(), gridDim.x);
  prenorm_phase(p, 0); }
  grid.sync();
  for (int l = 0; l < 2; ++l) {
    { pg8::Gemm g{(const bf16_t*)(p.ws + OFF_H), (const bf16_t*)(p.ws + OFF_WIN), MROWS, NW1, DM, DM, DM, 1 << 20, 0};
      pg8::StaticOrder S; S.init(MROWS, NW1, G, oblk());
      EpiProj E{(bf16_t*)(p.ws + OFF_PROJ), (float*)(p.ws + OFF_SIDE), LDP, 72};
      for (int rep = 0; rep < R_G1; ++rep) pg8::gemm_phase(( LAS unsigned char*)smem, g, S, E); }
    xcd_barrier(xb);
    { float* sCW = (float*)(smem + 122880); const int hh0 = oblk() & 7;
      for (int idx = threadIdx.x; idx < 1536; idx += 512) { const int mat = idx / 512, tap = (idx >> 7) & 3, col = idx & 127;
        sCW[idx] = p.conv_w[((size_t)l * 4 + tap) * 3072 + mat * 1024 + hh0 * 128 + col]; }
      __syncthreads(); }
    for (int rep = 0; rep < R_M1; ++rep)
    for (int t = oblk(); t < 3 * NITEM + 512; t += G) {
      if (t < NITEM) { for (int r2 = 0; r2 < R_DP; ++r2) delta_pre(p, l, t, smem); }
      else if (t < 2 * NITEM) { if (T_RP) ret_pre(p, l, t - NITEM, smem); }
      else if (t < 3 * NITEM) { if (T_MI) misc_item(p, l, t - 2 * NITEM, smem); }
      else { if (T_MI) cache_item(p, l, t - 3 * NITEM, smem); }
    }
    xcd_barrier(xb);
    for (int rep = 0; rep < R_M2; ++rep) m2_phase(p, l, rep, smem);
    xcd_barrier(xb);
    for (int rep = 0; rep < R_M3; ++rep) m3_phase(p, l);
    xcd_barrier(xb);
    for (int rep = 0; rep < R_G2; ++rep) {
      pg8::Gemm g{(const bf16_t*)(p.ws + OFF_PROJ) + C_ACAT, (const bf16_t*)(p.ws + OFF_WBR), MROWS, 3 * DM, 1024, LDP, 1024, 8, 2048};
      pg8::StaticOrder S; S.init(MROWS, 3 * DM, G, oblk());
      EpiProj E{(bf16_t*)(p.ws + OFF_M1), nullptr, 3 * DM, 1 << 20};
      pg8::gemm_phase((LAS unsigned char*)smem, g, S, E); }
    xcd_barrier(xb);
    merge_phase(p);
    xcd_barrier(xb);
    if (l == 0) {
      { pg8::Gemm g{(const bf16_t*)(p.ws + OFF_H), (const bf16_t*)(p.ws + OFF_WOUT), MROWS, DM, DM, DM, DM, 1 << 20, 0};
        pg8::StaticOrder S; S.init(MROWS, DM, G, oblk());
        EpiF32 E{(float*)(p.ws + OFF_M1 + 69206016)};
        pg8::gemm_phase((LAS unsigned char*)smem, g, S, E); }
      { const int c0 = 528 - ((528 + G - 1) / G - 1) * G;
        if (c0 < G && oblk() >= c0) convert_weights(p, 1, (float*)smem, 0, oblk() - c0, G - c0);
        else if (c0 >= G) convert_weights(p, 1, (float*)smem, 0, oblk(), G); }
      xcd_barrier(xb);
      postnorm_phase(p, l, 0, MROWS, 0, G);
    } else {
      { pg8::Gemm g{(const bf16_t*)(p.ws + OFF_H), (const bf16_t*)(p.ws + OFF_WOUT), 16384, DM, DM, DM, DM, 1 << 20, 0};
        pg8::StaticOrder S; S.init(16384, DM, G, oblk());
        EpiF32 E{(float*)(p.ws + OFF_M1 + 69206016)};
        pg8::gemm_phase((LAS unsigned char*)smem, g, S, E); }
      xcd_barrier(xb);
      if (oblk() < 16 && G > 16) {
        pg8::Gemm g{(const bf16_t*)(p.ws + OFF_H) + (size_t)16384 * DM, (const bf16_t*)(p.ws + OFF_WOUT), 512, DM, DM, DM, DM, 1 << 20, 0};
        pg8::StaticOrder S; S.init(512, DM, 16, oblk());
        EpiF32 E{(float*)(p.ws + OFF_M1 + 69206016) + (size_t)16384 * DM};
        pg8::gemm_phase((LAS unsigned char*)smem, g, S, E);
      } else if (G > 16) postnorm_phase(p, l, 0, 16384, 16, G - 16);
      xcd_barrier(xb);
      postnorm_phase(p, l, 16384, MROWS, 0, G);
    }
    if (l == 0) { if (T_ROW) convert_weights(p, 1, (float*)smem, 1, oblk(), gridDim.x); xcd_barrier(xb); }
  }
}

extern "C" void kernel_launch(void* const* d_in, const int* in_sizes, int n_in, void* d_out, int out_size,
                              void* d_ws, size_t ws_size, hipStream_t stream) {
  constexpr size_t kLds = 131072 + 256 + 4096;
  static int grid_blocks = 0;
  if (!grid_blocks) {
    (void)hipFuncSetAttribute((const void*)mega, hipFuncAttributeMaxDynamicSharedMemorySize, (int)kLds);
    int dev = 0, cus = 0, per_cu = 0;
    (void)hipGetDevice(&dev);
    (void)hipDeviceGetAttribute(&cus, hipDeviceAttributeMultiprocessorCount, dev);
    (void)hipOccupancyMaxActiveBlocksPerMultiprocessor(&per_cu, mega, 512, kLds);
    if (per_cu > 1) per_cu = 1;
    grid_blocks = cus * per_cu;
    if (grid_blocks > 256) grid_blocks = 256;
  }
  if (ws_size < WS_NEED) { fprintf(stderr, "workspace too small: %zu < %zu\n", ws_size, (size_t)WS_NEED); return; }
  (void)hipMemsetAsync((unsigned char*)d_ws + OFF_BAR, 0, 16384, stream);
  Params p{};
  const float** pp = (const float**)&p;
  for (int i = 0; i < 20; ++i) pp[i] = (const float*)d_in[i];
  p.out = (float*)d_out; p.ws = (unsigned char*)d_ws;
  void* args[] = {&p};
  hipError_t e = hipLaunchCooperativeKernel((void*)mega, dim3(grid_blocks), dim3(512), args, kLds, stream);
  if (e != hipSuccess) fprintf(stderr, "cooperative launch failed: %s (grid %d)\n", hipGetErrorString(e), grid_blocks);
}
```

```cpp
#include <hip/hip_runtime.h>
#include <hip/hip_cooperative_groups.h>
#include <cstdio>
namespace cg = cooperative_groups;
#ifndef R_DP
#define R_DP 1
#endif
#ifndef R_SW
#define R_SW 1
#endif
#ifndef R_AT
#define R_AT 1
#endif
#ifndef R_G1
#define R_G1 1
#endif
#ifndef R_M1
#define R_M1 1
#endif
#ifndef R_M2
#define R_M2 1
#endif
#ifndef R_M3
#define R_M3 1
#endif
#ifndef R_G2
#define R_G2 1
#endif
#ifndef R_G3
#define R_G3 1
#endif
#ifndef T_ROW
#define T_ROW 1
#endif
#ifndef T_G1
#define T_G1 1
#endif
#ifndef T_DP
#define T_DP 1
#endif
#ifndef T_RP
#define T_RP 1
#endif
#ifndef T_MI
#define T_MI 1
#endif
#ifndef T_M2
#define T_M2 1
#endif
#ifndef T_M3
#define T_M3 1
#endif
#ifndef T_G2
#define T_G2 1
#endif
#ifndef T_G3
#define T_G3 1
#endif
#ifndef T_AT
#define T_AT 1
#endif
#ifndef T_SC
#define T_SC 1
#endif

#define DI __device__ __forceinline__
#define LAS __attribute__((address_space(3)))
typedef unsigned short bf16_t;
typedef short bf16x8 __attribute__((ext_vector_type(8)));
typedef float f32x4 __attribute__((ext_vector_type(4)));
typedef float f32x2 __attribute__((ext_vector_type(2)));
typedef unsigned u32x4 __attribute__((ext_vector_type(4)));
typedef unsigned u32x2 __attribute__((ext_vector_type(2)));
typedef __bf16 bf2_t __attribute__((ext_vector_type(2)));

constexpr int DM = 2048, MROWS = 16896, LDP = 18432, NW1 = 18688, NIN = 18448, NITEM = 2112;
constexpr int C_ACAT = 4096, C_OBRAW = 8192, C_OCRAW = 9216;
constexpr size_t O_PK = 34603008, O_PV = 38797312, O_PC = 42991616, O_PD = 43065344, O_PR = 44113920, O_SK = 45162496, O_SV = 53551104, O_SC = 61939712, O_SD = 62087168, O_SR = 64184320;
constexpr size_t OFF_WIN = 0, OFF_WBR = 76546048, OFF_WOUT = 89128960, OFF_H = 97517568, OFF_PROJ = 166723584, OFF_SIDE = 789577728, OFF_DG = 790659072,
                 OFF_CNT = 790667520, OFF_KC = 790675456, OFF_CVT = 799064064, OFF_M1 = 807452672, OFF_BAR = 1118879744, WS_NEED = 1118879744 + 16384;
constexpr size_t M1_BLK = (size_t)NITEM * 8192;

struct Params {
  const float *x_prompt, *x_sample, *cache_k, *cache_v, *state_conv, *state_delta, *state_ret, *norm_pre, *norm_post, *w_in, *rel_bias, *conv_w, *a_log, *dt_bias,
      *delta_norm, *ret_norm, *w_ba, *w_bb, *w_bc, *w_out;
  float* out; unsigned char* ws;
};

DI unsigned pk2(float lo, float hi) { f32x2 v = {lo, hi}; bf2_t b = __builtin_convertvector(v, bf2_t); return __builtin_bit_cast(unsigned, b); }
DI bf16_t f2bf(float x) { return (bf16_t)(pk2(x, 0.f) & 0xffffu); }
DI float bflo(unsigned w) { return __uint_as_float(w << 16); }
DI float bfhi(unsigned w) { return __uint_as_float(w & 0xffff0000u); }
DI float bf2f(bf16_t b) { return __uint_as_float(((unsigned)b) << 16); }
DI float sigmoidf_(float x) { return 1.f / (1.f + __expf(-x)); }
DI float siluf_(float x) { return x / (1.f + __expf(-x)); }
DI int oblk() { int b = blockIdx.x; asm volatile("" : "+s"(b)); return __builtin_amdgcn_readfirstlane(b); }
DI int otid() { int t = threadIdx.x; asm volatile("" : "+v"(t)); return t; }
DI int kperm(int p) { return 16 * ((p >> 2) & 1) + 4 * (p >> 3) + (p & 3); }
DI int kinv(int x) { return 8 * ((x >> 2) & 3) + 4 * (x >> 4) + (x & 3); }
DI float wsum(float v) { for (int o = 32; o > 0; o >>= 1) v += __shfl_xor(v, o); return v; }
DI void unpack8(u32x4 a, float* o) { o[0] = bflo(a.x); o[1] = bfhi(a.x); o[2] = bflo(a.y); o[3] = bfhi(a.y); o[4] = bflo(a.z); o[5] = bfhi(a.z); o[6] = bflo(a.w); o[7] = bfhi(a.w); }
DI u32x4 pack8(const float* v) { u32x4 w; w.x = pk2(v[0], v[1]); w.y = pk2(v[2], v[3]); w.z = pk2(v[4], v[5]); w.w = pk2(v[6], v[7]); return w; }
DI bf16x8 pack_frag(f32x4 a, f32x4 b) { u32x4 w; w.x = pk2(a[0], a[1]); w.y = pk2(a[2], a[3]); w.z = pk2(b[0], b[1]); w.w = pk2(b[2], b[3]); return __builtin_bit_cast(bf16x8, w); }
#define MFMA16(a, b, c) __builtin_amdgcn_mfma_f32_16x16x32_bf16((a), (b), (c), 0, 0, 0)

namespace pg8 {
constexpr int BM = 256, BK = 64, HALF = 128, HTB = HALF * BK * 2, STAGE_BYTES = 8 * HTB, NXCD = 8, WGM = 8;
DI int lds_byte(int r, int c) { const int st = (r >> 4) * 2 + (c >> 5), rr = r & 15, cc = c & 31, ob = rr * 64 + cc * 2; return st * 1024 + (ob ^ (((ob >> 9) & 1) << 5)); }
DI void stage_rc(int b, int& R, int& C) { const int st = b / 1024, sb = b % 1024, swz = sb ^ (((sb >> 9) & 1) << 5); R = (st >> 1) * 16 + swz / 64; C = (st & 1) * 32 + (swz % 64) / 2; }
DI int perm32(int rho) { const int n = rho >> 4, i = rho & 15; return 8 * (i >> 2) + 4 * n + (i & 3); }
struct Unit { int pm, pn; };
struct Gemm { const bf16_t* A; const bf16_t* Bt; int M, N, K, lda, ldb, a_div, a_step; };
struct StaticOrder {
  int nM, nN, nwg, G, c;
  DI void init(int M, int N, int G_, int c_) { nM = M / BM; nN = N / BM; nwg = nM * nN; G = G_; c = c_; }
  DI bool next(int i, Unit& u) const {
    const long L = (long)i * G + c; if (L >= nwg) return false;
    int wgid = (int)L; { const int q = nwg / NXCD, r = nwg % NXCD, xcd = wgid % NXCD, off = wgid / NXCD; wgid = (xcd < r ? xcd * (q + 1) : r * (q + 1) + (xcd - r) * q) + off; }
    const int nig = WGM * nN, gid = wgid / nig, fm = gid * WGM, gsz = (nM - fm) < WGM ? (nM - fm) : WGM;
    u.pm = fm + ((wgid % nig) % gsz); u.pn = (wgid % nig) / gsz; return true;
  }
};

template <class Epi>
DI void gemm_phase(LAS unsigned char* lds, const Gemm g, const StaticOrder& S, const Epi& E) {
  const int tid = otid(), wid = __builtin_amdgcn_readfirstlane(tid >> 6), lane = tid & 63, wr = wid >> 2, wc = wid & 3, fr = lane & 15, fq = lane >> 4;
  const int K = g.K, nt = K / BK;
  unsigned voffA[2], voffB[2];
#pragma unroll
  for (int i = 0; i < 2; ++i) { int R, C; stage_rc(tid * 16 + i * 8192, R, C); const int Rb = Epi::PERM ? ((R & ~31) + perm32(R & 31)) : R;
    voffA[i] = (unsigned)(R * g.lda + C) * 2u; voffB[i] = (unsigned)(Rb * g.ldb + C) * 2u; }
  const size_t kstep = (size_t)(BK * 2);
  const size_t hstepA = (size_t)HALF * g.lda * 2, hstepB = (size_t)HALF * g.ldb * 2;
  const size_t tstepA = 2 * hstepA, tstepB = 2 * hstepB;
  const unsigned ldsw = (unsigned)wid * 1024u;
  const int aoff = lds_byte(wr * 64 + fr, fq * 8), boff = lds_byte(wc * 32 + fr, fq * 8);
#define PG8_SA(b, h) (((b) * 2 + (h)) * HTB)
#define PG8_SB(b, h) ((4 + (b) * 2 + (h)) * HTB)
#define PG8_STAGE(bufoff, gbase, voff) do { const char* _gb = (const char*)(gbase); asm volatile("" : "+s"(_gb)); _Pragma("unroll") for (int _i = 0; _i < 2; ++_i) \
    __builtin_amdgcn_global_load_lds((const unsigned*)(_gb + (voff)[_i]), (LAS unsigned*)(lds + (bufoff) + ldsw + _i * 8192), 16, 0, 0); } while (0)
#define PG8_LDA(dst, b, h) do { _Pragma("unroll") for (int m = 0; m < 4; ++m) _Pragma("unroll") for (int k = 0; k < 2; ++k) dst[m][k] = *(const LAS bf16x8*)(lds + PG8_SA(b, h) + aoff + m * 2048 + k * 1024); } while (0)
#define PG8_LDB(dst, b, h) do { _Pragma("unroll") for (int n = 0; n < 2; ++n) _Pragma("unroll") for (int k = 0; k < 2; ++k) dst[n][k] = *(const LAS bf16x8*)(lds + PG8_SB(b, h) + boff + n * 2048 + k * 1024); } while (0)
#define PG8_MMA(ai, bj, At, Bt) do { __builtin_amdgcn_s_setprio(1); _Pragma("unroll") for (int m = 0; m < 4; ++m) _Pragma("unroll") for (int n = 0; n < 2; ++n) _Pragma("unroll") for (int k = 0; k < 2; ++k) \
    acc[ai][bj][m][n] = __builtin_amdgcn_mfma_f32_16x16x32_bf16(Bt[n][k], At[m][k], acc[ai][bj][m][n], 0, 0, 0); __builtin_amdgcn_s_setprio(0); } while (0)
#define PG8_WAIT_V(n) asm volatile("s_waitcnt vmcnt(" #n ")" ::: "memory")
#define PG8_WAIT_L(n) asm volatile("s_waitcnt lgkmcnt(" #n ")" ::: "memory")
#define PG8_BAR __builtin_amdgcn_s_barrier()
#define PG8_SCHED __builtin_amdgcn_sched_barrier(0)
  Unit cur, nxt; int ui = 0;
  if (!S.next(0, cur)) return;
  f32x4 acc[2][2][4][2];
#pragma unroll
  for (int a = 0; a < 2; ++a)
#pragma unroll
    for (int b = 0; b < 2; ++b)
#pragma unroll
      for (int m = 0; m < 4; ++m)
#pragma unroll
        for (int n = 0; n < 2; ++n) acc[a][b][m][n] = (f32x4){0.f, 0.f, 0.f, 0.f};
  bf16x8 At[4][2], B0[2][2], B1[2][2];
  const char* cA = (const char*)g.A + (size_t)cur.pm * tstepA + (size_t)((cur.pn / g.a_div) * g.a_step); const char* cB = (const char*)g.Bt + (size_t)cur.pn * tstepB;
  PG8_STAGE(PG8_SB(0, 0), cB, voffB); PG8_STAGE(PG8_SA(0, 0), cA, voffA); PG8_STAGE(PG8_SB(0, 1), cB + hstepB, voffB); PG8_STAGE(PG8_SA(0, 1), cA + hstepA, voffA);
  if (wr == 1) PG8_BAR;
  PG8_WAIT_V(4); PG8_BAR;
  PG8_STAGE(PG8_SB(1, 0), cB + kstep, voffB); PG8_STAGE(PG8_SA(1, 0), cA + kstep, voffA); PG8_STAGE(PG8_SB(1, 1), cB + hstepB + kstep, voffB);
  PG8_WAIT_V(6); PG8_BAR;
  for (;;) {
    const bool has_next = S.next(ui + 1, nxt);
    const char* nA = has_next ? (const char*)g.A + (size_t)nxt.pm * tstepA + (size_t)((nxt.pn / g.a_div) * g.a_step) : cA; const char* nB = has_next ? (const char*)g.Bt + (size_t)nxt.pn * tstepB : cB;
    for (int t = 0; t < nt; t += 2) {
      const bool last = (t == nt - 2);
      const char* a1 = cA + (size_t)(t + 1) * kstep;
      const char* a2 = last ? nA : cA + (size_t)(t + 2) * kstep; const char* b2 = last ? nB : cB + (size_t)(t + 2) * kstep;
      const char* a3 = a2 + kstep; const char* b3 = b2 + kstep;
      PG8_LDB(B0, 0, 0); PG8_SCHED; PG8_LDA(At, 0, 0); PG8_STAGE(PG8_SA(1, 1), a1 + hstepA, voffA);
      PG8_WAIT_L(8); PG8_BAR; PG8_WAIT_L(0); PG8_MMA(0, 0, At, B0); PG8_BAR; PG8_SCHED;
      PG8_LDB(B1, 0, 1); PG8_STAGE(PG8_SB(0, 0), b2, voffB);
      PG8_BAR; PG8_WAIT_L(0); PG8_MMA(0, 1, At, B1); PG8_BAR;
      PG8_LDA(At, 0, 1); PG8_STAGE(PG8_SA(0, 0), a2, voffA);
      PG8_BAR; PG8_WAIT_L(0); PG8_MMA(1, 0, At, B0); PG8_BAR; PG8_SCHED;
      PG8_STAGE(PG8_SB(0, 1), b2 + hstepB, voffB);
      PG8_WAIT_V(6); PG8_BAR; PG8_MMA(1, 1, At, B1); PG8_BAR;
      PG8_LDB(B0, 1, 0); PG8_SCHED; PG8_LDA(At, 1, 0); PG8_STAGE(PG8_SA(0, 1), a2 + hstepA, voffA);
      PG8_WAIT_L(8); PG8_BAR; PG8_WAIT_L(0); PG8_MMA(0, 0, At, B0); PG8_BAR; PG8_SCHED;
      PG8_LDB(B1, 1, 1); PG8_STAGE(PG8_SB(1, 0), b3, voffB);
      PG8_BAR; PG8_WAIT_L(0); PG8_MMA(0, 1, At, B1); PG8_BAR;
      PG8_LDA(At, 1, 1); PG8_STAGE(PG8_SA(1, 0), a3, voffA);
      PG8_BAR; PG8_WAIT_L(0); PG8_MMA(1, 0, At, B0); PG8_BAR; PG8_SCHED;
      PG8_STAGE(PG8_SB(1, 1), b3 + hstepB, voffB);
      PG8_WAIT_V(6); PG8_BAR; PG8_MMA(1, 1, At, B1); PG8_BAR;
    }
    E(acc, cur, wr, wc, fr, fq);
    if (!has_next) break;
#pragma unroll
    for (int a = 0; a < 2; ++a)
#pragma unroll
      for (int b = 0; b < 2; ++b)
#pragma unroll
        for (int m = 0; m < 4; ++m)
#pragma unroll
          for (int n = 0; n < 2; ++n) acc[a][b][m][n] = (f32x4){0.f, 0.f, 0.f, 0.f};
    cur = nxt; cA = nA; cB = nB; ++ui;
  }
  PG8_WAIT_V(0);
  if (wr == 0) PG8_BAR;
  PG8_BAR;
#undef PG8_SA
#undef PG8_SB
#undef PG8_STAGE
#undef PG8_LDA
#undef PG8_LDB
#undef PG8_MMA
#undef PG8_WAIT_V
#undef PG8_WAIT_L
#undef PG8_BAR
#undef PG8_SCHED
}
}

struct EpiProj {
  static constexpr bool PERM = true;
  bf16_t* O; float* side; int ldc, nmain;
  DI void operator()(const f32x4 (&acc)[2][2][4][2], const pg8::Unit& u, int wr, int wc, int fr, int fq) const {
    const int row0 = u.pm * 256 + wr * 64 + fr;
    if (u.pn < nmain) {
      const int col0 = u.pn * 256 + wc * 32 + 8 * fq;
#pragma unroll
      for (int ai = 0; ai < 2; ++ai)
#pragma unroll
        for (int m = 0; m < 4; ++m) { bf16_t* rowp = O + (size_t)(row0 + ai * 128 + m * 16) * ldc + col0;
#pragma unroll
          for (int bj = 0; bj < 2; ++bj) { const f32x4 v0 = acc[ai][bj][m][0], v1 = acc[ai][bj][m][1];
            u32x4 w; w.x = pk2(v0[0], v0[1]); w.y = pk2(v0[2], v0[3]); w.z = pk2(v1[0], v1[1]); w.w = pk2(v1[2], v1[3]);
            *(u32x4*)(rowp + bj * 128) = w; } }
    } else if (wc == 0 && fq < 2) {
#pragma unroll
      for (int ai = 0; ai < 2; ++ai)
#pragma unroll
        for (int m = 0; m < 4; ++m) { float* sp = side + (size_t)(row0 + ai * 128 + m * 16) * 16 + 8 * fq;
          *(f32x4*)sp = acc[ai][0][m][0]; *(f32x4*)(sp + 4) = acc[ai][0][m][1]; }
    }
  }
};
struct EpiGate {
  static constexpr bool PERM = true;
  bf16_t* O; const bf16_t* proj; int br;
  DI void operator()(const f32x4 (&acc)[2][2][4][2], const pg8::Unit& u, int wr, int wc, int fr, int fq) const {
    const int row0 = u.pm * 256 + wr * 64 + fr, col0 = u.pn * 256 + wc * 32 + 8 * fq;
#pragma unroll
    for (int ai = 0; ai < 2; ++ai)
#pragma unroll
      for (int m = 0; m < 4; ++m) { const int row = row0 + ai * 128 + m * 16;
        bf16_t* rowp = O + (size_t)row * DM + col0; const bf16_t* gp = proj + (size_t)row * LDP + 12288 + br * 2048 + col0;
#pragma unroll
        for (int bj = 0; bj < 2; ++bj) { const f32x4 v0 = acc[ai][bj][m][0], v1 = acc[ai][bj][m][1];
          float gt[8], v[8]; unpack8(*(const u32x4*)(gp + bj * 128), gt);
#pragma unroll
          for (int j = 0; j < 4; ++j) { v[j] = v0[j] * sigmoidf_(gt[j]); v[4 + j] = v1[j] * sigmoidf_(gt[4 + j]); }
          if (br > 0) { float pv[8]; unpack8(*(const u32x4*)(rowp + bj * 128), pv);
#pragma unroll
            for (int j = 0; j < 8; ++j) v[j] += pv[j]; }
          *(u32x4*)(rowp + bj * 128) = pack8(v); } }
  }
};
struct EpiF32 {
  static constexpr bool PERM = false;
  float* C;
  DI void operator()(const f32x4 (&acc)[2][2][4][2], const pg8::Unit& u, int wr, int wc, int fr, int fq) const {
    const int row0 = u.pm * 256 + wr * 64 + fr, col0 = u.pn * 256 + wc * 32 + 4 * fq;
#pragma unroll
    for (int ai = 0; ai < 2; ++ai)
#pragma unroll
      for (int m = 0; m < 4; ++m) { float* rowp = C + (size_t)(row0 + ai * 128 + m * 16) * DM + col0;
#pragma unroll
        for (int bj = 0; bj < 2; ++bj)
#pragma unroll
          for (int n = 0; n < 2; ++n) *(f32x4*)(rowp + bj * 128 + n * 16) = acc[ai][bj][m][n]; }
  }
};

DI void conv_tile(float* T, const float* src, int ldsrc, int n0, int nvalid, int k0, bf16_t* dst, int K) {
  const int tid = otid();
  f32x4 v[8];
#pragma unroll
  for (int ps = 0; ps < 8; ++ps) { const int k = ps * 8 + (tid >> 6), c4 = (tid & 63) * 4;
    v[ps] = (f32x4){0.f, 0.f, 0.f, 0.f};
    if (c4 < nvalid) v[ps] = *(const f32x4*)(src + (size_t)(k0 + k) * ldsrc + n0 + c4); }
#pragma unroll
  for (int ps = 0; ps < 8; ++ps) { const int k = ps * 8 + (tid >> 6), c4 = (tid & 63) * 4;
    T[k * 257 + c4] = v[ps][0]; T[k * 257 + c4 + 1] = v[ps][1]; T[k * 257 + c4 + 2] = v[ps][2]; T[k * 257 + c4 + 3] = v[ps][3]; }
  __syncthreads();
#pragma unroll
  for (int i = 0; i < 4; ++i) { const int n = (tid >> 3) + 64 * i, kg = tid & 7; float w[8];
#pragma unroll
    for (int j = 0; j < 8; ++j) w[j] = T[(8 * kg + j) * 257 + n];
    *(u32x4*)(dst + (size_t)n * K + k0 + 8 * kg) = pack8(w); }
  __syncthreads();
}
DI void convert_weights(const Params& p, int l, float* T, int part, int first, int stride) {
  bf16_t* win = (bf16_t*)(p.ws + OFF_WIN); bf16_t* wbr = (bf16_t*)(p.ws + OFF_WBR); bf16_t* wout = (bf16_t*)(p.ws + OFF_WOUT);
  const int n_in = 73 * 32, n_br = 3 * 8 * 16, n_out = 8 * 32;
  const int t_lo = (part == 1) ? n_in + n_br : 0, t_hi = (part == 0) ? n_in + n_br : n_in + n_br + n_out;
  for (int t = t_lo + first; t < t_hi; t += stride) {
    if (t < n_in) { const int ntile = t >> 5, kt = t & 31, np0 = ntile * 256; int n0 = 0, nv = 256;
      if (np0 < 8192) n0 = np0; else if (np0 < 18432) n0 = np0 + 16; else { n0 = 8192; nv = 16; }
      conv_tile(T, p.w_in + (size_t)l * DM * NIN, NIN, n0, nv, kt * 64, win + (size_t)np0 * DM, DM);
    } else if (t < n_in + n_br) { const int u = t - n_in, br = u >> 7, r = u & 127, ntile = r >> 4, kt = r & 15;
      const float* src = (br == 0 ? p.w_ba : br == 1 ? p.w_bb : p.w_bc) + (size_t)l * 1024 * DM;
      conv_tile(T, src, DM, ntile * 256, 256, kt * 64, wbr + (size_t)br * DM * 1024 + (size_t)ntile * 256 * 1024, 1024);
    } else { const int u = t - n_in - n_br, ntile = u >> 5, kt = u & 31;
      conv_tile(T, p.w_out + (size_t)l * DM * DM, DM, ntile * 256, 256, kt * 64, wout + (size_t)ntile * 256 * DM, DM); }
  }
}

DI void prenorm_phase(const Params& p, int l) {
  bf16_t* h = (bf16_t*)(p.ws + OFF_H); const float* g = p.norm_pre + (size_t)l * DM;
  const int tid_ = otid(); const int lane = tid_ & 63, gw = oblk() * 8 + (tid_ >> 6), nw = gridDim.x * 8;
  for (int r = gw; r < MROWS; r += nw) {
    const float* xr = (r < 16384) ? p.x_prompt + (size_t)r * DM : p.x_sample + (size_t)(r - 16384) * DM;
    f32x4 v[8]; float ss = 0.f;
#pragma unroll
    for (int i = 0; i < 8; ++i) { v[i] = *(const f32x4*)(xr + i * 256 + lane * 4); ss += v[i][0] * v[i][0] + v[i][1] * v[i][1] + v[i][2] * v[i][2] + v[i][3] * v[i][3]; }
    ss = wsum(ss); const float rn = rsqrtf(ss * (1.f / DM) + 1e-6f);
#pragma unroll
    for (int i = 0; i < 8; ++i) { const f32x4 gg = *(const f32x4*)(g + i * 256 + lane * 4);
      u32x2 w; w.x = pk2(v[i][0] * rn * gg[0], v[i][1] * rn * gg[1]); w.y = pk2(v[i][2] * rn * gg[2], v[i][3] * rn * gg[3]);
      *(u32x2*)(h + (size_t)r * DM + i * 256 + lane * 4) = w; }
  }
}
DI void postnorm_phase(const Params& p, int l, int row_lo, int row_hi, int wg_first, int wg_count) {
  bf16_t* h = (bf16_t*)(p.ws + OFF_H); const float* ypre = (const float*)(p.ws + OFF_M1 + 69206016);
  const float* gpost = p.norm_post + (size_t)l * DM; const float* gpre = p.norm_pre + (size_t)(l + 1) * DM;
  const int tid_ = otid(); const int lane = tid_ & 63, gw = (oblk() - wg_first) * 8 + (tid_ >> 6), nw = wg_count * 8;
  for (int r = row_lo + gw; r < row_hi; r += nw) {
    const float* xr = (l > 0) ? p.out + (size_t)r * DM : ((r < 16384) ? p.x_prompt + (size_t)r * DM : p.x_sample + (size_t)(r - 16384) * DM);
    const float* yr = ypre + (size_t)r * DM;
    f32x4 v[8]; float ss = 0.f;
#pragma unroll
    for (int i = 0; i < 8; ++i) { v[i] = *(const f32x4*)(yr + i * 256 + lane * 4); ss += v[i][0] * v[i][0] + v[i][1] * v[i][1] + v[i][2] * v[i][2] + v[i][3] * v[i][3]; }
    ss = wsum(ss); const float rn = rsqrtf(ss * (1.f / DM) + 1e-6f); float s2 = 0.f;
#pragma unroll
    for (int i = 0; i < 8; ++i) { const f32x4 gg = *(const f32x4*)(gpost + i * 256 + lane * 4); const f32x4 xx = *(const f32x4*)(xr + i * 256 + lane * 4);
#pragma unroll
      for (int j = 0; j < 4; ++j) { v[i][j] = xx[j] + v[i][j] * rn * gg[j]; s2 += v[i][j] * v[i][j]; }
      *(f32x4*)(p.out + (size_t)r * DM + i * 256 + lane * 4) = v[i]; }
    if (l == 0) { s2 = wsum(s2); const float r2 = rsqrtf(s2 * (1.f / DM) + 1e-6f);
#pragma unroll
      for (int i = 0; i < 8; ++i) { const f32x4 gg = *(const f32x4*)(gpre + i * 256 + lane * 4);
        u32x2 w; w.x = pk2(v[i][0] * r2 * gg[0], v[i][1] * r2 * gg[1]); w.y = pk2(v[i][2] * r2 * gg[2], v[i][3] * r2 * gg[3]);
        *(u32x2*)(h + (size_t)r * DM + i * 256 + lane * 4) = w; } }
  }
}

template <class F> DI void write_T_perm(bf16_t* dst, F&& val) {
  const int t = otid(), r = t >> 2, q4 = t & 3, tb = q4 >> 1, p0 = 16 * (q4 & 1);
  float v[16];
#pragma unroll
  for (int j = 0; j < 16; ++j) v[j] = val(32 * tb + kperm(p0 + j), r);
  *(u32x4*)(dst + r * 64 + 32 * tb + p0) = pack8(v); *(u32x4*)(dst + r * 64 + 32 * tb + p0 + 8) = pack8(v + 8);
}
template <class F> DI void write_perm(bf16_t* dst, F&& val) {
  const int t = otid(), tok = t >> 3, cgp = t & 7, db = cgp >> 1, p0 = 16 * (cgp & 1);
  float v[16];
#pragma unroll
  for (int j = 0; j < 16; ++j) v[j] = val(tok, 32 * db + kperm(p0 + j));
  *(u32x4*)(dst + tok * 128 + 32 * db + p0) = pack8(v); *(u32x4*)(dst + tok * 128 + 32 * db + p0 + 8) = pack8(v + 8);
}

DI void conv16(const Params& p, const bf16_t* proj, int l, int ci, int ch0, int tok, float (&y)[16]) {
  const float* cw = p.conv_w + (size_t)l * 4 * 3072 + ch0;
#pragma unroll
  for (int c = 0; c < 16; ++c) y[c] = 0.f;
#pragma unroll
  for (int o = 0; o < 4; ++o) {
    const int t = tok - 3 + o; float xv[16];
    if (t >= 0 || (ci < 256 && (ci & 63) != 0)) {
      const bf16_t* src = proj + (size_t)(ci * 64 + t) * LDP + 4096 + ch0;
      unpack8(*(const u32x4*)src, xv); unpack8(*(const u32x4*)(src + 8), xv + 8);
    } else if (ci >= 256) {
      const float* sc = p.state_conv + ((size_t)(l * 8 + (ci - 256)) * 3 + (3 + t)) * 3072 + ch0;
#pragma unroll
      for (int q = 0; q < 4; ++q) { const f32x4 a = *(const f32x4*)(sc + 4 * q); xv[4 * q] = a[0]; xv[4 * q + 1] = a[1]; xv[4 * q + 2] = a[2]; xv[4 * q + 3] = a[3]; }
    } else {
#pragma unroll
      for (int c = 0; c < 16; ++c) xv[c] = 0.f;
    }
#pragma unroll
    for (int q = 0; q < 4; ++q) { const f32x4 w = *(const f32x4*)(cw + o * 3072 + 4 * q);
      y[4 * q] += w[0] * xv[4 * q]; y[4 * q + 1] += w[1] * xv[4 * q + 1]; y[4 * q + 2] += w[2] * xv[4 * q + 2]; y[4 * q + 3] += w[3] * xv[4 * q + 3]; }
  }
#pragma unroll
  for (int c = 0; c < 16; ++c) y[c] = siluf_(y[c]);
}

DI void conv_fetch(const Params& p, const bf16_t* proj, int l, int ci, int hh, int cgp, int tok, u32x4 (&raw)[3][4][2]) {
#pragma unroll
  for (int o = 0; o < 4; ++o) {
    const int t = tok - 3 + o;
#pragma unroll
    for (int mat = 0; mat < 3; ++mat) {
      const int ch0 = mat * 1024 + hh * 128 + 16 * cgp;
      if (t >= 0 || (ci < 256 && (ci & 63) != 0)) {
        const bf16_t* src = proj + (size_t)(ci * 64 + t) * LDP + 4096 + ch0;
        raw[mat][o][0] = *(const u32x4*)src; raw[mat][o][1] = *(const u32x4*)(src + 8);
      } else if (ci >= 256) {
        const float* sc = p.state_conv + ((size_t)(l * 8 + (ci - 256)) * 3 + (3 + t)) * 3072 + ch0; float f[16];
#pragma unroll
        for (int q = 0; q < 4; ++q) { const f32x4 a = *(const f32x4*)(sc + 4 * q); f[4 * q] = a[0]; f[4 * q + 1] = a[1]; f[4 * q + 2] = a[2]; f[4 * q + 3] = a[3]; }
        raw[mat][o][0] = pack8(f); raw[mat][o][1] = pack8(f + 8);
      } else { raw[mat][o][0] = (u32x4){0u, 0u, 0u, 0u}; raw[mat][o][1] = (u32x4){0u, 0u, 0u, 0u}; }
    }
  }
}
DI void conv_apply(const float* sCW, int mat, int cgp, const u32x4 (&raw)[3][4][2], float (&y)[16]) {
#pragma unroll
  for (int c = 0; c < 16; ++c) y[c] = 0.f;
#pragma unroll
  for (int o = 0; o < 4; ++o) { float xv[16]; unpack8(raw[mat][o][0], xv); unpack8(raw[mat][o][1], xv + 8);
#pragma unroll
    for (int q = 0; q < 4; ++q) { const f32x4 w = *(const f32x4*)(sCW + (mat * 4 + o) * 128 + 16 * cgp + 4 * q);
      y[4 * q] += w[0] * xv[4 * q]; y[4 * q + 1] += w[1] * xv[4 * q + 1]; y[4 * q + 2] += w[2] * xv[4 * q + 2]; y[4 * q + 3] += w[3] * xv[4 * q + 3]; } }
#pragma unroll
  for (int c = 0; c < 16; ++c) y[c] = siluf_(y[c]);
}

DI void delta_pre(const Params& p, int l, int it, unsigned char* smem) {
  const int ci = it >> 3, hh = it & 7, tid = otid(), wid = tid >> 6, lane = tid & 63, fr = lane & 15, fq = lane >> 4;
  bf16_t* sKB = (bf16_t*)smem; bf16_t* sQB = (bf16_t*)(smem + 17408); float* sKF = (float*)(smem + 34816); float* sVF = (float*)(smem + 68608);
  float* sA = (float*)(smem + 102400); float* sGC = (float*)(smem + 118784); float* sBT = sGC + 64; float* sEG = sGC + 128; float* sR1 = sGC + 192;
  const bf16_t* proj = (const bf16_t*)(p.ws + OFF_PROJ); const float* side = (const float*)(p.ws + OFF_SIDE);
  bf16_t* m1 = (bf16_t*)(p.ws + OFF_M1);
  bf16_t* dW = m1 + 0 * M1_BLK + (size_t)it * 8192; bf16_t* dQ = m1 + 1 * M1_BLK + (size_t)it * 8192; bf16_t* dKT = m1 + 2 * M1_BLK + (size_t)it * 8192;
  bf16_t* dUT = m1 + 3 * M1_BLK + (size_t)it * 8192; bf16_t* dIN = m1 + 8 * M1_BLK + (size_t)it * 4096;
  if (wid == 0) {
    const int row = ci * 64 + lane;
    const float bl = side[(size_t)row * 16 + hh], al = side[(size_t)row * 16 + 8 + hh] + p.dt_bias[l * 8 + hh];
    const float sp = al > 20.f ? al : log1pf(__expf(al));
    float g = -__expf(p.a_log[l * 8 + hh]) * sp;
#pragma unroll
    for (int o = 1; o < 64; o <<= 1) { const float t = __shfl_up(g, o); if (lane >= o) g += t; }
    const float bt = sigmoidf_(bl), eg = __expf(g);
    sGC[lane] = g; sBT[lane] = bt; sEG[lane] = eg; sR1[lane] = bt * eg;
    if (lane == 63) ((float*)(p.ws + OFF_DG))[it] = eg;
  }
  { const int tok = tid >> 3, cgp = tid & 7; float y[16]; const float* sCW = (const float*)(smem + 122880);
    u32x4 raw[3][4][2]; conv_fetch(p, proj, l, ci, hh, cgp, tok, raw);
    conv_apply(sCW, 0, cgp, raw, y);
    { float ss = 0.f;
#pragma unroll
      for (int c = 0; c < 16; ++c) ss += y[c] * y[c];
      ss += __shfl_xor(ss, 1); ss += __shfl_xor(ss, 2); ss += __shfl_xor(ss, 4);
      const float rn = rsqrtf(ss + 1e-6f) * 0.08838834764831845f;
#pragma unroll
      for (int c = 0; c < 16; ++c) y[c] *= rn;
      *(u32x4*)(sQB + tok * 136 + 16 * cgp) = pack8(y); *(u32x4*)(sQB + tok * 136 + 16 * cgp + 8) = pack8(y + 8); }
    conv_apply(sCW, 1, cgp, raw, y);
    { float ss = 0.f;
#pragma unroll
      for (int c = 0; c < 16; ++c) ss += y[c] * y[c];
      ss += __shfl_xor(ss, 1); ss += __shfl_xor(ss, 2); ss += __shfl_xor(ss, 4);
      const float rn = rsqrtf(ss + 1e-6f);
#pragma unroll
      for (int c = 0; c < 16; ++c) { y[c] *= rn; sKF[tok * 132 + 16 * cgp + c] = y[c]; }
      *(u32x4*)(sKB + tok * 136 + 16 * cgp) = pack8(y); *(u32x4*)(sKB + tok * 136 + 16 * cgp + 8) = pack8(y + 8); }
    conv_apply(sCW, 2, cgp, raw, y);
#pragma unroll
    for (int c = 0; c < 16; ++c) sVF[tok * 132 + 16 * cgp + c] = y[c];
  }
  __syncthreads();
  {
    const int mt = wid & 3; const bf16_t* Asrc = (wid < 4) ? sKB : sQB;
    bf16x8 a[4];
#pragma unroll
    for (int s = 0; s < 4; ++s) a[s] = *(const bf16x8*)(Asrc + (16 * mt + fr) * 136 + 32 * s + 8 * fq);
#pragma unroll
    for (int nt = 0; nt < 4; ++nt) {
      f32x4 c = {0.f, 0.f, 0.f, 0.f};
#pragma unroll
      for (int s = 0; s < 4; ++s) { const bf16x8 b = *(const bf16x8*)(sKB + (16 * nt + fr) * 136 + 32 * s + 8 * fq); c = MFMA16(a[s], b, c); }
      const int j = 16 * nt + fr; const float gj = sGC[j];
#pragma unroll
      for (int r = 0; r < 4; ++r) { const int i = 16 * mt + 4 * fq + r; const float gi = sGC[i]; const float dec = __expf(fminf(gi - gj, 0.f));
        if (wid < 4) sA[i * 64 + j] = (i > j) ? sBT[i] * c[r] * dec : 0.f;
        else dIN[i * 64 + (j & 32) + kinv(j & 31)] = f2bf((i >= j) ? c[r] * dec : 0.f); }
    }
  }
  __syncthreads();
  if (wid < 4) {
    int zv = 0; asm volatile("" : "+v"(zv));
    const int c = tid; const float* src = (c < 128) ? sVF + c : sKF + (c - 128); const float* scl = ((c < 128) ? sBT : sR1) + zv; const float* sAz = sA + zv;
    f32x2 sp[32];
#pragma unroll
    for (int i = 0; i < 32; ++i) sp[i] = (f32x2){0.f, 0.f};
    f32x4 Ab[16];
#pragma unroll
    for (int i = 0; i < 64; ++i) {
#pragma unroll
      for (int j4 = 0; j4 < (i + 3) / 4; ++j4) Ab[j4] = *(const f32x4*)(sAz + i * 64 + 4 * j4);
      const float rs = src[i * 132], rc = scl[i];
      __builtin_amdgcn_sched_barrier(0);
      f32x2 a0 = {rs * rc, 0.f}, a1 = {0.f, 0.f};
#pragma unroll
      for (int j4 = 0; j4 < (i + 3) / 4; ++j4) { const f32x4 a = Ab[j4];
        a0 -= (f32x2){a[0], a[1]} * sp[2 * j4]; a1 -= (f32x2){a[2], a[3]} * sp[2 * j4 + 1]; }
      const f32x2 t = a0 + a1; const float r = t[0] + t[1];
      sp[i >> 1][i & 1] = r;
      __builtin_amdgcn_sched_barrier(0);
    }
    float sol[64];
#pragma unroll
    for (int i = 0; i < 64; ++i) sol[i] = sp[i >> 1][i & 1];
    if (c < 128) {
#pragma unroll
      for (int q = 0; q < 8; ++q) *(u32x4*)(dUT + c * 64 + 8 * q) = pack8(sol + 8 * q);
    } else { const int d = c - 128, pos = (d & ~31) + kinv(d & 31);
#pragma unroll
      for (int i = 0; i < 64; ++i) dW[i * 128 + pos] = f2bf(-sol[i]); }
  } else {
    const int t = tid - 256; const float gl = sGC[63];
    { const int tok = t >> 2, db = t & 3; const float eg = sEG[tok]; float v[32];
#pragma unroll
      for (int pp = 0; pp < 32; ++pp) v[pp] = bf2f(sQB[tok * 136 + 32 * db + kperm(pp)]) * eg;
#pragma unroll
      for (int q = 0; q < 4; ++q) *(u32x4*)(dQ + tok * 128 + 32 * db + 8 * q) = pack8(v + 8 * q); }
    { const int d = t >> 1, tb = t & 1; float v[32];
#pragma unroll
      for (int pp = 0; pp < 32; ++pp) { const int tok = 32 * tb + kperm(pp); v[pp] = sKF[tok * 132 + d] * __expf(gl - sGC[tok]); }
#pragma unroll
      for (int q = 0; q < 4; ++q) *(u32x4*)(dKT + d * 64 + 32 * tb + 8 * q) = pack8(v + 8 * q); }
  }
  __syncthreads();
}

DI void ret_pre(const Params& p, int l, int it, unsigned char* smem) {
  const int ci = it >> 3, hh = it & 7, tid = otid(), wid = tid >> 6, lane = tid & 63, fr = lane & 15, fq = lane >> 4;
  bf16_t* sQB = (bf16_t*)smem; bf16_t* sKB = (bf16_t*)(smem + 17408); float* sKZ = (float*)(smem + 34816); float* sVF = (float*)(smem + 68608);
  const bf16_t* proj = (const bf16_t*)(p.ws + OFF_PROJ);
  bf16_t* m1 = (bf16_t*)(p.ws + OFF_M1);
  bf16_t* rQ = m1 + 4 * M1_BLK + (size_t)it * 8192; bf16_t* rKT = m1 + 5 * M1_BLK + (size_t)it * 8192; bf16_t* rVT = m1 + 6 * M1_BLK + (size_t)it * 8192;
  bf16_t* rIN = m1 + 8 * M1_BLK + (size_t)NITEM * 4096 + (size_t)it * 4096;
  const float lg = __logf(1.f - exp2f(-5.f - (float)hh));
  { const int tok = tid >> 3, cgp = tid & 7; const bf16_t* rp = proj + (size_t)(ci * 64 + tok) * LDP;
    const int pos = (ci >= 256) ? 2048 + tok : (ci & 63) * 64 + tok;
    float q1[8], q2[8], k1[8], k2[8], vv[16];
    unpack8(*(const u32x4*)(rp + 8192 + hh * 128 + 8 * cgp), q1); unpack8(*(const u32x4*)(rp + 8192 + hh * 128 + 64 + 8 * cgp), q2);
    unpack8(*(const u32x4*)(rp + 9216 + hh * 128 + 8 * cgp), k1); unpack8(*(const u32x4*)(rp + 9216 + hh * 128 + 64 + 8 * cgp), k2);
    unpack8(*(const u32x4*)(rp + 10240 + hh * 128 + 16 * cgp), vv); unpack8(*(const u32x4*)(rp + 10240 + hh * 128 + 16 * cgp + 8), vv + 8);
    const float zeta = __expf(lg * (float)(63 - tok)) * 0.08838834764831845f;
    float qa[8], qb[8], ka[8], kb[8];
#pragma unroll
    for (int j = 0; j < 8; ++j) { const int i = 8 * cgp + j;
      const float inv = exp2f(-(float)i * (13.287712379549449f / 64.f)); const float ang = (float)pos * inv;
      float rv = ang * 0.15915494309189535f; rv = rv - floorf(rv);
      const float sn = __builtin_amdgcn_sinf(rv), cs = __builtin_amdgcn_cosf(rv);
      qa[j] = q1[j] * cs - q2[j] * sn; qb[j] = q1[j] * sn + q2[j] * cs;
      ka[j] = (k1[j] * cs - k2[j] * sn); kb[j] = (k1[j] * sn + k2[j] * cs);
      sKZ[tok * 132 + i] = ka[j] * zeta; sKZ[tok * 132 + 64 + i] = kb[j] * zeta;
      ka[j] *= 0.08838834764831845f; kb[j] *= 0.08838834764831845f; }
    *(u32x4*)(sQB + tok * 136 + 8 * cgp) = pack8(qa); *(u32x4*)(sQB + tok * 136 + 64 + 8 * cgp) = pack8(qb);
    *(u32x4*)(sKB + tok * 136 + 8 * cgp) = pack8(ka); *(u32x4*)(sKB + tok * 136 + 64 + 8 * cgp) = pack8(kb);
#pragma unroll
    for (int c = 0; c < 16; ++c) sVF[tok * 132 + 16 * cgp + c] = vv[c];
  }
  __syncthreads();
  { const int mt = wid >> 1;
    bf16x8 a[4];
#pragma unroll
    for (int s = 0; s < 4; ++s) a[s] = *(const bf16x8*)(sQB + (16 * mt + fr) * 136 + 32 * s + 8 * fq);
#pragma unroll
    for (int n2 = 0; n2 < 2; ++n2) { const int nt = 2 * (wid & 1) + n2;
      f32x4 c = {0.f, 0.f, 0.f, 0.f};
#pragma unroll
      for (int s = 0; s < 4; ++s) { const bf16x8 b = *(const bf16x8*)(sKB + (16 * nt + fr) * 136 + 32 * s + 8 * fq); c = MFMA16(a[s], b, c); }
      const int j = 16 * nt + fr;
#pragma unroll
      for (int r = 0; r < 4; ++r) { const int i = 16 * mt + 4 * fq + r;
        rIN[i * 64 + (j & 32) + kinv(j & 31)] = f2bf((i >= j) ? c[r] * __expf(lg * (float)(i - j)) : 0.f); }
    }
  }
  write_perm(rQ, [&](int tok, int d) { return bf2f(sQB[tok * 136 + d]) * __expf(lg * (float)(tok + 1)); });
  write_T_perm(rKT, [&](int tok, int d) { return sKZ[tok * 132 + d]; });
  write_T_perm(rVT, [&](int tok, int e) { return sVF[tok * 132 + e]; });
  __syncthreads();
}

DI void misc_item(const Params& p, int l, int it, unsigned char* smem) {
  const int ci = it >> 3, hh = it & 7, tid = otid();
  bf16_t* sVB = (bf16_t*)smem;
  const bf16_t* proj = (const bf16_t*)(p.ws + OFF_PROJ);
  bf16_t* aVT = (bf16_t*)(p.ws + OFF_M1) + 7 * M1_BLK + (size_t)it * 8192;
  { const int tok = tid >> 3, cgp = tid & 7; const bf16_t* rp = proj + (size_t)(ci * 64 + tok) * LDP;
    const u32x4 v0 = *(const u32x4*)(rp + 2048 + hh * 128 + 16 * cgp), v1 = *(const u32x4*)(rp + 2048 + hh * 128 + 16 * cgp + 8);
    *(u32x4*)(sVB + tok * 136 + 16 * cgp) = v0; *(u32x4*)(sVB + tok * 136 + 16 * cgp + 8) = v1;
    float* ok = nullptr; float* ov = nullptr;
    if (ci < 256) { const int b = ci >> 6, c = ci & 63;
      if (c >= 56) { const size_t o = ((((size_t)l * 4 + b) * 512 + (c - 56) * 64 + tok) * 8 + hh) * 128 + 16 * cgp; ok = p.out + O_PK + o; ov = p.out + O_PV + o; }
    } else { const size_t o = ((((size_t)l * 8 + (ci - 256)) * 512 + 448 + tok) * 8 + hh) * 128 + 16 * cgp; ok = p.out + O_SK + o; ov = p.out + O_SV + o; }
    if (ok) { float f[16]; unpack8(v0, f); unpack8(v1, f + 8);
#pragma unroll
      for (int q = 0; q < 4; ++q) *(f32x4*)(ov + 4 * q) = (f32x4){f[4 * q], f[4 * q + 1], f[4 * q + 2], f[4 * q + 3]};
      unpack8(*(const u32x4*)(rp + 1024 + hh * 128 + 16 * cgp), f); unpack8(*(const u32x4*)(rp + 1024 + hh * 128 + 16 * cgp + 8), f + 8);
#pragma unroll
      for (int q = 0; q < 4; ++q) *(f32x4*)(ok + 4 * q) = (f32x4){f[4 * q], f[4 * q + 1], f[4 * q + 2], f[4 * q + 3]}; }
  }
  if (ci >= 256 || (ci & 63) == 63) {
    float* oc = (ci < 256) ? p.out + O_PC + ((size_t)l * 4 + (ci >> 6)) * 3 * 3072 : p.out + O_SC + ((size_t)l * 8 + (ci - 256)) * 3 * 3072;
    for (int idx = tid; idx < 3 * 384; idx += 512) { const int rr = idx / 384, ch = hh * 384 + idx % 384;
      oc[rr * 3072 + ch] = bf2f(proj[(size_t)(ci * 64 + 61 + rr) * LDP + 4096 + ch]); }
  }
  __syncthreads();
  write_T_perm(aVT, [&](int tok, int e) { return bf2f(sVB[tok * 136 + e]); });
  __syncthreads();
}
DI void cache_item(const Params& p, int l, int cit, unsigned char* smem) {
  const int hh = cit & 7, j = (cit >> 3) & 7, sb = cit >> 6, tid = otid();
  float* sVF = (float*)smem;
  bf16_t* kc = (bf16_t*)(p.ws + OFF_KC) + (size_t)cit * 8192; bf16_t* cvt = (bf16_t*)(p.ws + OFF_CVT) + (size_t)cit * 8192;
  { const int key = tid >> 3, cgp = tid & 7;
    const size_t so = ((((size_t)l * 8 + sb) * 512 + 64 * j + key) * 8 + hh) * 128 + 16 * cgp;
    float fk[16], fv[16];
#pragma unroll
    for (int q = 0; q < 4; ++q) { const f32x4 a = *(const f32x4*)(p.cache_k + so + 4 * q); const f32x4 b = *(const f32x4*)(p.cache_v + so + 4 * q);
#pragma unroll
      for (int e = 0; e < 4; ++e) { fk[4 * q + e] = a[e]; fv[4 * q + e] = b[e]; } }
    *(u32x4*)(kc + key * 128 + 16 * cgp) = pack8(fk); *(u32x4*)(kc + key * 128 + 16 * cgp + 8) = pack8(fk + 8);
#pragma unroll
    for (int c = 0; c < 16; ++c) sVF[key * 132 + 16 * cgp + c] = fv[c];
    if (j >= 1) { const size_t oo = ((((size_t)l * 8 + sb) * 512 + 64 * (j - 1) + key) * 8 + hh) * 128 + 16 * cgp;
#pragma unroll
      for (int q = 0; q < 4; ++q) { *(f32x4*)(p.out + O_SK + oo + 4 * q) = (f32x4){fk[4 * q], fk[4 * q + 1], fk[4 * q + 2], fk[4 * q + 3]};
        *(f32x4*)(p.out + O_SV + oo + 4 * q) = (f32x4){fv[4 * q], fv[4 * q + 1], fv[4 * q + 2], fv[4 * q + 3]}; } }
  }
  __syncthreads();
  write_T_perm(cvt, [&](int tok, int e) { return sVF[tok * 132 + e]; });
  __syncthreads();
}

template <int TYPE> DI void scan_item(const Params& p, int l, int seq, int hh, int sl) {
  const int lane = otid() & 63, fr = lane & 15, fq = lane >> 4, e0 = 16 * sl;
  const int nsteps = seq < 4 ? 64 : 1, ci0 = seq < 4 ? seq * 64 : 256 + (seq - 4);
  const bf16_t* m1 = (const bf16_t*)(p.ws + OFF_M1);
  bf16_t* proj = (bf16_t*)(p.ws + OFF_PROJ);
  const float* dG = (const float*)(p.ws + OFF_DG);
  f32x4 S[8];
  if (seq < 4) {
#pragma unroll
    for (int t = 0; t < 8; ++t) S[t] = (f32x4){0.f, 0.f, 0.f, 0.f};
  } else { const float* st = (TYPE == 0 ? p.state_delta : p.state_ret) + (((size_t)l * 8 + (seq - 4)) * 8 + hh) * 16384 + e0 + fr;
#pragma unroll
    for (int t = 0; t < 8; ++t)
#pragma unroll
      for (int i = 0; i < 4; ++i) S[t][i] = st[(16 * t + 4 * fq + i) * 128]; }
  const float gret = __expf(64.f * __logf(1.f - exp2f(-5.f - (float)hh)));
  for (int n = 0; n < nsteps; ++n) {
    const int it = (ci0 + n) * 8 + hh;
    const bf16_t* W = m1 + 0 * M1_BLK + (size_t)it * 8192;
    const bf16_t* Q = m1 + (TYPE == 0 ? 1 : 4) * M1_BLK + (size_t)it * 8192;
    const bf16_t* KT = m1 + (TYPE == 0 ? 2 : 5) * M1_BLK + (size_t)it * 8192;
    const bf16_t* UT = m1 + (TYPE == 0 ? 3 : 6) * M1_BLK + (size_t)it * 8192;
    const bf16_t* IN = m1 + 8 * M1_BLK + (TYPE == 0 ? 0 : (size_t)NITEM * 4096) + (size_t)it * 4096;
    bf16x8 Sf[4];
#pragma unroll
    for (int s = 0; s < 4; ++s) Sf[s] = pack_frag(S[2 * s], S[2 * s + 1]);
    bf16x8 Vf[2];
    if (TYPE == 0) {
      f32x4 Vn[4];
#pragma unroll
      for (int mt = 0; mt < 4; ++mt) { const u32x2 u = *(const u32x2*)(UT + (e0 + fr) * 64 + 16 * mt + 4 * fq); Vn[mt] = (f32x4){bflo(u.x), bfhi(u.x), bflo(u.y), bfhi(u.y)}; }
#pragma unroll
      for (int s = 0; s < 4; ++s)
#pragma unroll
        for (int mt = 0; mt < 4; ++mt) { const bf16x8 a = *(const bf16x8*)(W + (16 * mt + fr) * 128 + 32 * s + 8 * fq); Vn[mt] = MFMA16(a, Sf[s], Vn[mt]); }
      Vf[0] = pack_frag(Vn[0], Vn[1]); Vf[1] = pack_frag(Vn[2], Vn[3]);
    } else {
      Vf[0] = *(const bf16x8*)(UT + (e0 + fr) * 64 + 8 * fq); Vf[1] = *(const bf16x8*)(UT + (e0 + fr) * 64 + 32 + 8 * fq);
    }
    f32x4 O[4];
#pragma unroll
    for (int nt = 0; nt < 4; ++nt) O[nt] = (f32x4){0.f, 0.f, 0.f, 0.f};
#pragma unroll
    for (int s = 0; s < 4; ++s)
#pragma unroll
      for (int nt = 0; nt < 4; ++nt) { const bf16x8 b = *(const bf16x8*)(Q + (16 * nt + fr) * 128 + 32 * s + 8 * fq); O[nt] = MFMA16(Sf[s], b, O[nt]); }
#pragma unroll
    for (int s2 = 0; s2 < 2; ++s2)
#pragma unroll
      for (int nt = 0; nt < 4; ++nt) { const bf16x8 b = *(const bf16x8*)(IN + (16 * nt + fr) * 64 + 32 * s2 + 8 * fq); O[nt] = MFMA16(Vf[s2], b, O[nt]); }
#pragma unroll
    for (int nt = 0; nt < 4; ++nt) { u32x2 w; w.x = pk2(O[nt][0], O[nt][1]); w.y = pk2(O[nt][2], O[nt][3]);
      *(u32x2*)(proj + (size_t)((ci0 + n) * 64 + 16 * nt + fr) * LDP + (TYPE == 0 ? C_OBRAW : C_OCRAW) + hh * 128 + e0 + 4 * fq) = w; }
    const float gb = (TYPE == 0) ? dG[it] : gret;
#pragma unroll
    for (int dt = 0; dt < 8; ++dt) { S[dt] = S[dt] * gb;
#pragma unroll
      for (int s2 = 0; s2 < 2; ++s2) { const bf16x8 a = *(const bf16x8*)(KT + (16 * dt + fr) * 64 + 32 * s2 + 8 * fq); S[dt] = MFMA16(a, Vf[s2], S[dt]); } }
  }
  { float* so = p.out + (seq < 4 ? (TYPE == 0 ? O_PD : O_PR) + (((size_t)l * 4 + seq) * 8 + hh) * 16384 : (TYPE == 0 ? O_SD : O_SR) + (((size_t)l * 8 + (seq - 4)) * 8 + hh) * 16384) + e0 + fr;
#pragma unroll
    for (int t = 0; t < 8; ++t)
#pragma unroll
      for (int i = 0; i < 4; ++i) so[(16 * t + 4 * fq + i) * 128] = S[t][i]; }
}

template <int TYPE> DI void scan_step(const unsigned char* B, f32x4 (&S)[8], const u32x4 (&uc)[2], float gb, bf16_t* orow, int fr, int fq) {
#define SW_A128(base_, row_, s_) (*(const bf16x8*)((base_) + (((row_) * 16 + ((4 * (s_) + fq) ^ fr)) * 16)))
#define SW_A64(base_, row_, s_) (*(const bf16x8*)((base_) + (((row_) * 8 + ((4 * (s_) + fq) ^ (fr >> 1))) * 16)))
  bf16x8 Sf[4];
#pragma unroll
  for (int s = 0; s < 4; ++s) Sf[s] = pack_frag(S[2 * s], S[2 * s + 1]);
  bf16x8 Vf[2];
  if (TYPE == 0) {
    f32x4 Vn[4];
#pragma unroll
    for (int mt = 0; mt < 4; ++mt) { const unsigned ux = uc[mt >> 1][(mt & 1) * 2], uy = uc[mt >> 1][(mt & 1) * 2 + 1]; Vn[mt] = (f32x4){bflo(ux), bfhi(ux), bflo(uy), bfhi(uy)}; }
#pragma unroll
    for (int s = 0; s < 4; ++s)
#pragma unroll
      for (int mt = 0; mt < 4; ++mt) Vn[mt] = MFMA16(SW_A128(B, 16 * mt + fr, s), Sf[s], Vn[mt]);
    Vf[0] = pack_frag(Vn[0], Vn[1]); Vf[1] = pack_frag(Vn[2], Vn[3]);
  } else { Vf[0] = __builtin_bit_cast(bf16x8, uc[0]); Vf[1] = __builtin_bit_cast(bf16x8, uc[1]); }
  f32x4 O[4];
#pragma unroll
  for (int nt = 0; nt < 4; ++nt) O[nt] = (f32x4){0.f, 0.f, 0.f, 0.f};
#pragma unroll
  for (int s = 0; s < 4; ++s)
#pragma unroll
    for (int nt = 0; nt < 4; ++nt) O[nt] = MFMA16(Sf[s], SW_A128(B + 16384, 16 * nt + fr, s), O[nt]);
#pragma unroll
  for (int s2 = 0; s2 < 2; ++s2)
#pragma unroll
    for (int nt = 0; nt < 4; ++nt) O[nt] = MFMA16(Vf[s2], SW_A64(B + 49152, 16 * nt + fr, s2), O[nt]);
#pragma unroll
  for (int nt = 0; nt < 4; ++nt) { u32x2 w; w.x = pk2(O[nt][0], O[nt][1]); w.y = pk2(O[nt][2], O[nt][3]); *(u32x2*)(orow + (size_t)(16 * nt) * LDP) = w; }
#pragma unroll
  for (int dt = 0; dt < 8; ++dt) { S[dt] = S[dt] * gb;
#pragma unroll
    for (int s2 = 0; s2 < 2; ++s2) S[dt] = MFMA16(SW_A64(B + 32768, 16 * dt + fr, s2), Vf[s2], S[dt]); }
#undef SW_A128
#undef SW_A64
}
template <int TYPE> DI void scan_wg(const Params& p, int l, int seq, int hh, unsigned char* smem) {
  const int tid = otid(), lane = tid & 63, wv = tid >> 6, fr = lane & 15, fq = lane >> 4, e0 = 16 * wv;
  const int ci0 = seq * 64;
  const bf16_t* m1 = (const bf16_t*)(p.ws + OFF_M1);
  bf16_t* proj = (bf16_t*)(p.ws + OFF_PROJ);
  const float* dG = (const float*)(p.ws + OFF_DG);
  const bf16_t* gW = m1 + 0 * M1_BLK; const bf16_t* gQ = m1 + (TYPE == 0 ? 1 : 4) * M1_BLK; const bf16_t* gKT = m1 + (TYPE == 0 ? 2 : 5) * M1_BLK;
  const bf16_t* gUT = m1 + (TYPE == 0 ? 3 : 6) * M1_BLK; const bf16_t* gIN = m1 + 8 * M1_BLK + (TYPE == 0 ? 0 : (size_t)NITEM * 4096);
  f32x4 S[8];
#pragma unroll
  for (int t = 0; t < 8; ++t) S[t] = (f32x4){0.f, 0.f, 0.f, 0.f};
  const float gvec = (TYPE == 0) ? dG[(ci0 + lane) * 8 + hh] : __expf(64.f * __logf(1.f - exp2f(-5.f - (float)hh)));
  int d128[2], d64[2];
#pragma unroll
  for (int k = 0; k < 2; ++k) { const int q = tid + 512 * k; { const int r = q >> 4, c = q & 15; d128[k] = (r * 16 + (c ^ (r & 15))) * 16; }
    { const int r = q >> 3, c = q & 7; d64[k] = (r * 8 + (c ^ ((r >> 1) & 7))) * 16; } }
  u32x4 st[2][7]; u32x4 uv[2][2];
#define SW_ISSUE(n_, X_) do { const size_t it_ = (size_t)((ci0 + (n_)) * 8 + hh); \
    if (TYPE == 0) { st[X_][0] = *(const u32x4*)(gW + it_ * 8192 + tid * 8); st[X_][1] = *(const u32x4*)(gW + it_ * 8192 + (tid + 512) * 8); } \
    st[X_][2] = *(const u32x4*)(gQ + it_ * 8192 + tid * 8); st[X_][3] = *(const u32x4*)(gQ + it_ * 8192 + (tid + 512) * 8); \
    st[X_][4] = *(const u32x4*)(gKT + it_ * 8192 + tid * 8); st[X_][5] = *(const u32x4*)(gKT + it_ * 8192 + (tid + 512) * 8); \
    st[X_][6] = *(const u32x4*)(gIN + it_ * 4096 + tid * 8); \
    if (TYPE == 0) { _Pragma("unroll") for (int mt = 0; mt < 4; ++mt) { const u32x2 u_ = *(const u32x2*)(gUT + it_ * 8192 + (e0 + fr) * 64 + 16 * mt + 4 * fq); uv[X_][mt >> 1][(mt & 1) * 2] = u_.x; uv[X_][mt >> 1][(mt & 1) * 2 + 1] = u_.y; } } \
    else { uv[X_][0] = *(const u32x4*)(gUT + it_ * 8192 + (e0 + fr) * 64 + 8 * fq); uv[X_][1] = *(const u32x4*)(gUT + it_ * 8192 + (e0 + fr) * 64 + 32 + 8 * fq); } } while (0)
#define SW_COMMIT(b_, X_) do { unsigned char* B_ = smem + (b_) * 57344; \
    if (TYPE == 0) { *(u32x4*)(B_ + d128[0]) = st[X_][0]; *(u32x4*)(B_ + d128[1]) = st[X_][1]; } \
    *(u32x4*)(B_ + 16384 + d128[0]) = st[X_][2]; *(u32x4*)(B_ + 16384 + d128[1]) = st[X_][3]; \
    *(u32x4*)(B_ + 32768 + d64[0]) = st[X_][4]; *(u32x4*)(B_ + 32768 + d64[1]) = st[X_][5]; *(u32x4*)(B_ + 49152 + d64[0]) = st[X_][6]; \
    ucur[0] = uv[X_][0]; ucur[1] = uv[X_][1]; } while (0)
  u32x4 ucur[2];
  bf16_t* obase = proj + (size_t)(ci0 * 64 + fr) * LDP + (TYPE == 0 ? C_OBRAW : C_OCRAW) + hh * 128 + e0 + 4 * fq;
  SW_ISSUE(0, 0);
  SW_COMMIT(0, 0);
  SW_ISSUE(1, 1);
  __syncthreads();
  for (int n = 0; n < 64; n += 2) {
    if (n + 2 < 64) SW_ISSUE(n + 2, 0);
    scan_step<TYPE>(smem, S, ucur, __shfl(gvec, n), obase + (size_t)(n * 64) * LDP, fr, fq);
    SW_COMMIT(1, 1);
    __syncthreads();
    if (n + 3 < 64) SW_ISSUE(n + 3, 1);
    scan_step<TYPE>(smem + 57344, S, ucur, __shfl(gvec, n + 1), obase + (size_t)((n + 1) * 64) * LDP, fr, fq);
    if (n + 2 < 64) SW_COMMIT(0, 0);
    __syncthreads();
  }
#undef SW_ISSUE
#undef SW_COMMIT
  { float* so = p.out + (TYPE == 0 ? O_PD : O_PR) + (((size_t)l * 4 + seq) * 8 + hh) * 16384 + e0 + fr;
#pragma unroll
    for (int t = 0; t < 8; ++t)
#pragma unroll
      for (int i = 0; i < 4; ++i) so[(16 * t + 4 * fq + i) * 128] = S[t][i]; }
}

template <int TYPE> DI void scan_step2(const unsigned char* B, f32x4 (&S)[2][8], const u32x4 (&uc)[2][2], float gb, bf16_t* orow, int fr, int fq) {
#define SW_A128(base_, row_, s_) (*(const bf16x8*)((base_) + (((row_) * 16 + ((4 * (s_) + fq) ^ fr)) * 16)))
#define SW_A64(base_, row_, s_) (*(const bf16x8*)((base_) + (((row_) * 8 + ((4 * (s_) + fq) ^ (fr >> 1))) * 16)))
  bf16x8 Sf[2][4];
#pragma unroll
  for (int c = 0; c < 2; ++c)
#pragma unroll
    for (int s = 0; s < 4; ++s) Sf[c][s] = pack_frag(S[c][2 * s], S[c][2 * s + 1]);
  bf16x8 Vf[2][2];
  if (TYPE == 0) {
    f32x4 Vn[2][4];
#pragma unroll
    for (int c = 0; c < 2; ++c)
#pragma unroll
      for (int mt = 0; mt < 4; ++mt) { const unsigned ux = uc[c][mt >> 1][(mt & 1) * 2], uy = uc[c][mt >> 1][(mt & 1) * 2 + 1]; Vn[c][mt] = (f32x4){bflo(ux), bfhi(ux), bflo(uy), bfhi(uy)}; }
#pragma unroll
    for (int s = 0; s < 4; ++s)
#pragma unroll
      for (int mt = 0; mt < 4; ++mt) { const bf16x8 a = SW_A128(B, 16 * mt + fr, s); Vn[0][mt] = MFMA16(a, Sf[0][s], Vn[0][mt]); Vn[1][mt] = MFMA16(a, Sf[1][s], Vn[1][mt]); }
#pragma unroll
    for (int c = 0; c < 2; ++c) { Vf[c][0] = pack_frag(Vn[c][0], Vn[c][1]); Vf[c][1] = pack_frag(Vn[c][2], Vn[c][3]); }
  } else {
#pragma unroll
    for (int c = 0; c < 2; ++c) { Vf[c][0] = __builtin_bit_cast(bf16x8, uc[c][0]); Vf[c][1] = __builtin_bit_cast(bf16x8, uc[c][1]); }
  }
  f32x4 O[2][4];
#pragma unroll
  for (int c = 0; c < 2; ++c)
#pragma unroll
    for (int nt = 0; nt < 4; ++nt) O[c][nt] = (f32x4){0.f, 0.f, 0.f, 0.f};
#pragma unroll
  for (int s = 0; s < 4; ++s)
#pragma unroll
    for (int nt = 0; nt < 4; ++nt) { const bf16x8 b = SW_A128(B + 16384, 16 * nt + fr, s); O[0][nt] = MFMA16(Sf[0][s], b, O[0][nt]); O[1][nt] = MFMA16(Sf[1][s], b, O[1][nt]); }
#pragma unroll
  for (int s2 = 0; s2 < 2; ++s2)
#pragma unroll
    for (int nt = 0; nt < 4; ++nt) { const bf16x8 b = SW_A64(B + 49152, 16 * nt + fr, s2); O[0][nt] = MFMA16(Vf[0][s2], b, O[0][nt]); O[1][nt] = MFMA16(Vf[1][s2], b, O[1][nt]); }
#pragma unroll
  for (int c = 0; c < 2; ++c)
#pragma unroll
    for (int nt = 0; nt < 4; ++nt) { u32x2 w; w.x = pk2(O[c][nt][0], O[c][nt][1]); w.y = pk2(O[c][nt][2], O[c][nt][3]); *(u32x2*)(orow + (size_t)(16 * nt) * LDP + 16 * c) = w; }
#pragma unroll
  for (int dt = 0; dt < 8; ++dt) { S[0][dt] = S[0][dt] * gb; S[1][dt] = S[1][dt] * gb;
#pragma unroll
    for (int s2 = 0; s2 < 2; ++s2) { const bf16x8 a = SW_A64(B + 32768, 16 * dt + fr, s2); S[0][dt] = MFMA16(a, Vf[0][s2], S[0][dt]); S[1][dt] = MFMA16(a, Vf[1][s2], S[1][dt]); } }
#undef SW_A128
#undef SW_A64
}
template <int TYPE> DI void scan_wg2(const Params& p, int l, int seq, int hh, unsigned char* smem) {
  const int tid = otid(), lane = tid & 63, wv = tid >> 6, fr = lane & 15, fq = lane >> 4;
  const int ci0 = seq * 64;
  const bf16_t* m1 = (const bf16_t*)(p.ws + OFF_M1);
  const bf16_t* gW = m1 + 0 * M1_BLK; const bf16_t* gQ = m1 + (TYPE == 0 ? 1 : 4) * M1_BLK; const bf16_t* gKT = m1 + (TYPE == 0 ? 2 : 5) * M1_BLK;
  const bf16_t* gUT = m1 + (TYPE == 0 ? 3 : 6) * M1_BLK; const bf16_t* gIN = m1 + 8 * M1_BLK + (TYPE == 0 ? 0 : (size_t)NITEM * 4096);
  if (wv >= 4) {
    const int lt = tid - 256;
    const int b128 = ((lt >> 4) * 16 + ((lt & 15) ^ ((lt >> 4) & 15))) * 16, b64 = ((lt >> 3) * 8 + ((lt & 7) ^ ((lt >> 4) & 7))) * 16;
    u32x4 st[2][14];
#define LW_ISSUE(n_, X_) do { const size_t it_ = (size_t)((ci0 + (n_)) * 8 + hh); \
      _Pragma("unroll") for (int k = 0; k < 4; ++k) { if (TYPE == 0) st[X_][k] = *(const u32x4*)(gW + it_ * 8192 + (lt + 256 * k) * 8); \
        st[X_][4 + k] = *(const u32x4*)(gQ + it_ * 8192 + (lt + 256 * k) * 8); st[X_][8 + k] = *(const u32x4*)(gKT + it_ * 8192 + (lt + 256 * k) * 8); } \
      st[X_][12] = *(const u32x4*)(gIN + it_ * 4096 + lt * 8); st[X_][13] = *(const u32x4*)(gIN + it_ * 4096 + (lt + 256) * 8); } while (0)
#define LW_COMMIT(b_, X_) do { unsigned char* B_ = smem + (b_) * 57344; \
      _Pragma("unroll") for (int k = 0; k < 4; ++k) { if (TYPE == 0) *(u32x4*)(B_ + b128 + k * 4096) = st[X_][k]; \
        *(u32x4*)(B_ + 16384 + b128 + k * 4096) = st[X_][4 + k]; *(u32x4*)(B_ + 32768 + b64 + k * 4096) = st[X_][8 + k]; } \
      *(u32x4*)(B_ + 49152 + b64) = st[X_][12]; *(u32x4*)(B_ + 49152 + b64 + 4096) = st[X_][13]; } while (0)
    LW_ISSUE(0, 0); LW_COMMIT(0, 0); LW_ISSUE(1, 1);
    __syncthreads();
    for (int n = 0; n < 64; n += 2) {
      if (n + 2 < 64) LW_ISSUE(n + 2, 0);
      LW_COMMIT(1, 1);
      __syncthreads();
      if (n + 3 < 64) LW_ISSUE(n + 3, 1);
      if (n + 2 < 64) LW_COMMIT(0, 0);
      __syncthreads();
    }
#undef LW_ISSUE
#undef LW_COMMIT
  } else {
    const int e0 = 32 * wv;
    bf16_t* proj = (bf16_t*)(p.ws + OFF_PROJ);
    const float* dG = (const float*)(p.ws + OFF_DG);
    f32x4 S[2][8];
#pragma unroll
    for (int c = 0; c < 2; ++c)
#pragma unroll
      for (int t = 0; t < 8; ++t) S[c][t] = (f32x4){0.f, 0.f, 0.f, 0.f};
    const float gvec = (TYPE == 0) ? dG[(ci0 + lane) * 8 + hh] : __expf(64.f * __logf(1.f - exp2f(-5.f - (float)hh)));
    u32x4 ucur[2][2], unext[2][2];
#define CW_ULOAD(n_, dst_) do { const size_t it_ = (size_t)((ci0 + (n_)) * 8 + hh); _Pragma("unroll") for (int c = 0; c < 2; ++c) { \
      if (TYPE == 0) { _Pragma("unroll") for (int mt = 0; mt < 4; ++mt) { const u32x2 u_ = *(const u32x2*)(gUT + it_ * 8192 + (e0 + 16 * c + fr) * 64 + 16 * mt + 4 * fq); dst_[c][mt >> 1][(mt & 1) * 2] = u_.x; dst_[c][mt >> 1][(mt & 1) * 2 + 1] = u_.y; } } \
      else { dst_[c][0] = *(const u32x4*)(gUT + it_ * 8192 + (e0 + 16 * c + fr) * 64 + 8 * fq); dst_[c][1] = *(const u32x4*)(gUT + it_ * 8192 + (e0 + 16 * c + fr) * 64 + 32 + 8 * fq); } } } while (0)
    bf16_t* obase = proj + (size_t)(ci0 * 64 + fr) * LDP + (TYPE == 0 ? C_OBRAW : C_OCRAW) + hh * 128 + e0 + 4 * fq;
    CW_ULOAD(0, ucur);
    __syncthreads();
    for (int n = 0; n < 64; ++n) {
      if (n + 1 < 64) CW_ULOAD(n + 1, unext);
      scan_step2<TYPE>(smem + (n & 1) * 57344, S, ucur, __shfl(gvec, n), obase + (size_t)(n * 64) * LDP, fr, fq);
#pragma unroll
      for (int c = 0; c < 2; ++c) { ucur[c][0] = unext[c][0]; ucur[c][1] = unext[c][1]; }
      __syncthreads();
    }
#undef CW_ULOAD
    { float* so = p.out + (TYPE == 0 ? O_PD : O_PR) + (((size_t)l * 4 + seq) * 8 + hh) * 16384 + e0 + fr;
#pragma unroll
      for (int c = 0; c < 2; ++c)
#pragma unroll
        for (int t = 0; t < 8; ++t)
#pragma unroll
          for (int i = 0; i < 4; ++i) so[(16 * t + 4 * fq + i) * 128 + 16 * c] = S[c][t][i]; }
  }
}

DI void attn_item(const Params& p, int l, int ai) {
  const int qt = ai & 3, hh = (ai >> 2) & 7, ci = ai >> 5;
  const int lane = otid() & 63, fr = lane & 15, fq = lane >> 4;
  bf16_t* proj = (bf16_t*)(p.ws + OFF_PROJ);
  const bf16_t* aVT = (const bf16_t*)(p.ws + OFF_M1) + 7 * M1_BLK;
  const bf16_t* kcb = (const bf16_t*)(p.ws + OFF_KC); const bf16_t* cvt = (const bf16_t*)(p.ws + OFF_CVT);
  const float* rb = p.rel_bias + ((size_t)l * 8 + hh) * 257;
  const int qrow = ci * 64 + 16 * qt + fr;
  bf16x8 Qf[4];
#pragma unroll
  for (int s = 0; s < 4; ++s) Qf[s] = *(const bf16x8*)(proj + (size_t)qrow * LDP + hh * 128 + 32 * s + 8 * fq);
  const int jmin = (ci < 256) ? ((ci & 63) >= 8 ? 0 : 8 - (ci & 63)) : 0;
  const float bfar = rb[256]; const int iq = 16 * qt + fr;
  float m = -1e30f, lsum = 0.f;
  f32x4 O[8];
#pragma unroll
  for (int et = 0; et < 8; ++et) O[et] = (f32x4){0.f, 0.f, 0.f, 0.f};
#pragma unroll 1
  for (int grp = 0; grp < 3; ++grp) {
    if (3 * grp + 2 < jmin) continue;
    f32x4 sc[12]; float gmx = -1e30f;
#pragma unroll
    for (int jj = 0; jj < 3; ++jj) { const int j = 3 * grp + jj;
      if (j >= jmin) {
        const bf16_t* Kp; int ks;
        if (ci < 256 || j == 8) { Kp = proj + (size_t)((ci < 256 ? ci - 8 + j : ci) * 64) * LDP + 1024 + hh * 128; ks = LDP; }
        else { Kp = kcb + (size_t)(((ci - 256) * 8 + j) * 8 + hh) * 8192; ks = 128; }
#pragma unroll
        for (int kt = 0; kt < 4; ++kt) {
          f32x4 c = {0.f, 0.f, 0.f, 0.f};
#pragma unroll
          for (int s = 0; s < 4; ++s) { const bf16x8 a = *(const bf16x8*)(Kp + (size_t)(16 * kt + fr) * ks + 32 * s + 8 * fq); c = MFMA16(a, Qf[s], c); }
#pragma unroll
          for (int i = 0; i < 4; ++i) { float bias = bfar;
            if (grp == 2) { const int r = 64 * j + 16 * kt + 4 * fq + i; int dist = 512 + iq - r; dist = dist < -128 ? -128 : (dist > 128 ? 128 : dist); bias = rb[dist + 128]; }
            c[i] = c[i] * 0.08838834764831845f + bias; gmx = fmaxf(gmx, c[i]); }
          sc[4 * jj + kt] = c;
        }
      } else {
#pragma unroll
        for (int kt = 0; kt < 4; ++kt) sc[4 * jj + kt] = (f32x4){-1e30f, -1e30f, -1e30f, -1e30f};
      }
    }
    gmx = fmaxf(gmx, __shfl_xor(gmx, 16)); gmx = fmaxf(gmx, __shfl_xor(gmx, 32));
    const float mnew = fmaxf(m, gmx), alpha = __expf(m - mnew); m = mnew;
    lsum *= alpha;
#pragma unroll
    for (int et = 0; et < 8; ++et) O[et] = O[et] * alpha;
#pragma unroll
    for (int t = 0; t < 12; ++t)
#pragma unroll
      for (int i = 0; i < 4; ++i) { const float e = __expf(sc[t][i] - m); sc[t][i] = e; lsum += e; }
#pragma unroll
    for (int jj = 0; jj < 3; ++jj) { const int j = 3 * grp + jj;
      if (j >= jmin) {
        const bf16_t* Vp;
        if (ci < 256 || j == 8) Vp = aVT + (size_t)((ci < 256 ? ci - 8 + j : ci) * 8 + hh) * 8192;
        else Vp = cvt + (size_t)(((ci - 256) * 8 + j) * 8 + hh) * 8192;
#pragma unroll
        for (int s2 = 0; s2 < 2; ++s2) { const bf16x8 pf = pack_frag(sc[4 * jj + 2 * s2], sc[4 * jj + 2 * s2 + 1]);
#pragma unroll
          for (int et = 0; et < 8; ++et) { const bf16x8 a = *(const bf16x8*)(Vp + (16 * et + fr) * 64 + 32 * s2 + 8 * fq); O[et] = MFMA16(a, pf, O[et]); } }
      }
    }
  }
  lsum += __shfl_xor(lsum, 16); lsum += __shfl_xor(lsum, 32);
  const float inv = 1.f / lsum;
#pragma unroll
  for (int et = 0; et < 8; ++et) { const u32x2 z = *(const u32x2*)(proj + (size_t)qrow * LDP + 3072 + hh * 128 + 16 * et + 4 * fq);
    u32x2 w; w.x = pk2(O[et][0] * inv * siluf_(bflo(z.x)), O[et][1] * inv * siluf_(bfhi(z.x))); w.y = pk2(O[et][2] * inv * siluf_(bflo(z.y)), O[et][3] * inv * siluf_(bfhi(z.y)));
    *(u32x2*)(proj + (size_t)qrow * LDP + C_ACAT + hh * 128 + 16 * et + 4 * fq) = w; }
}

DI void attn_stage(const unsigned char* Kl, const float* sB, int j, int iq, float bfar, const bf16x8 (&Qf)[4], f32x4 (&O)[8], float& m, float& lsum, int fr, int fq) {
#define AW_A128(base_, row_, s_) (*(const bf16x8*)((base_) + (((row_) * 16 + ((4 * (s_) + fq) ^ fr)) * 16)))
#define AW_A64(base_, row_, s_) (*(const bf16x8*)((base_) + (((row_) * 8 + ((4 * (s_) + fq) ^ (fr >> 1))) * 16)))
  const unsigned char* Vl = Kl + 32768;
  f32x4 sc[4]; float gmx = -1e30f;
#pragma unroll
  for (int kt = 0; kt < 4; ++kt) {
    f32x4 c = {0.f, 0.f, 0.f, 0.f};
#pragma unroll
    for (int s = 0; s < 4; ++s) c = MFMA16(AW_A128(Kl, 16 * kt + fr, s), Qf[s], c);
#pragma unroll
    for (int i = 0; i < 4; ++i) { float bias = bfar;
      if (j >= 6) { const int r = 64 * j + 16 * kt + 4 * fq + i; int dist = 512 + iq - r; dist = dist < -128 ? -128 : (dist > 128 ? 128 : dist); bias = sB[dist + 128]; }
      c[i] = c[i] * 0.08838834764831845f + bias; gmx = fmaxf(gmx, c[i]); }
    sc[kt] = c;
  }
  gmx = fmaxf(gmx, __shfl_xor(gmx, 16)); gmx = fmaxf(gmx, __shfl_xor(gmx, 32));
  const float mnew = fmaxf(m, gmx), alpha = __expf(m - mnew); m = mnew;
  lsum *= alpha;
#pragma unroll
  for (int et = 0; et < 8; ++et) O[et] = O[et] * alpha;
#pragma unroll
  for (int kt = 0; kt < 4; ++kt)
#pragma unroll
    for (int i = 0; i < 4; ++i) { const float e = __expf(sc[kt][i] - m); sc[kt][i] = e; lsum += e; }
#pragma unroll
  for (int s2 = 0; s2 < 2; ++s2) { const bf16x8 pf = pack_frag(sc[2 * s2], sc[2 * s2 + 1]);
#pragma unroll
    for (int et = 0; et < 8; ++et) O[et] = MFMA16(AW_A64(Vl, 16 * et + fr, s2), pf, O[et]); }
#undef AW_A128
#undef AW_A64
}
DI void attn_wg(const Params& p, int l, int wi, unsigned char* smem) {
  const int tid = otid(), lane = tid & 63, wv = tid >> 6, fr = lane & 15, fq = lane >> 4;
  const int ci = wi >> 2, hp = wi & 3, hsel = wv >> 2, hh = 2 * hp + hsel, qt = wv & 3;
  bf16_t* proj = (bf16_t*)(p.ws + OFF_PROJ);
  const bf16_t* aVT = (const bf16_t*)(p.ws + OFF_M1) + 7 * M1_BLK;
  const bf16_t* kcb = (const bf16_t*)(p.ws + OFF_KC); const bf16_t* cvt = (const bf16_t*)(p.ws + OFF_CVT);
  const float* rb = p.rel_bias + ((size_t)l * 8 + 2 * hp) * 257;
  float* sBias = (float*)(smem + 131072 + 256);
  const int qrow = ci * 64 + 16 * qt + fr;
  bf16x8 Qf[4];
#pragma unroll
  for (int s = 0; s < 4; ++s) Qf[s] = *(const bf16x8*)(proj + (size_t)qrow * LDP + hh * 128 + 32 * s + 8 * fq);
  const int jmin = (ci < 256) ? ((ci & 63) >= 8 ? 0 : 8 - (ci & 63)) : 0;
  const float bfar = rb[hsel * 257 + 256]; const int iq = 16 * qt + fr;
  const int row0 = tid >> 4, kcol = tid & 15;
  const int dKb = (row0 * 16 + (kcol ^ (row0 & 15))) * 16, dVb = 32768 + ((tid >> 3) * 8 + ((tid & 7) ^ ((tid >> 4) & 7))) * 16;
  u32x4 st[2][8];
#define AW_ISSUE(j_, X_) do { const bf16_t* Kb_; const bf16_t* Vb_; int ks_; size_t khs_; \
    if (ci < 256 || (j_) == 8) { const int cj_ = (ci < 256) ? ci - 8 + (j_) : ci; Kb_ = proj + (size_t)(cj_ * 64) * LDP + 1024 + 2 * hp * 128; ks_ = LDP; khs_ = 128; Vb_ = aVT + (size_t)(cj_ * 8 + 2 * hp) * 8192; } \
    else { const size_t o_ = (size_t)(((ci - 256) * 8 + (j_)) * 8 + 2 * hp) * 8192; Kb_ = kcb + o_; ks_ = 128; khs_ = 8192; Vb_ = cvt + o_; } \
    const bf16_t* kp_ = Kb_ + (size_t)row0 * ks_ + kcol * 8; \
    _Pragma("unroll") for (int k = 0; k < 4; ++k) { st[X_][k] = *(const u32x4*)(kp_ + (k >> 1) * khs_ + (size_t)(32 * (k & 1)) * ks_); st[X_][4 + k] = *(const u32x4*)(Vb_ + (size_t)(tid + 512 * k) * 8); } } while (0)
#define AW_COMMIT(b_, X_) do { unsigned char* B_ = smem + (b_) * 65536; _Pragma("unroll") for (int k = 0; k < 4; ++k) { \
    *(u32x4*)(B_ + dKb + (k >> 1) * 16384 + (k & 1) * 8192) = st[X_][k]; *(u32x4*)(B_ + dVb + (k >> 1) * 16384 + (k & 1) * 8192) = st[X_][4 + k]; } } while (0)
  float m = -1e30f, lsum = 0.f;
  f32x4 O[8];
#pragma unroll
  for (int et = 0; et < 8; ++et) O[et] = (f32x4){0.f, 0.f, 0.f, 0.f};
  AW_ISSUE(jmin, 0);
  if (tid < 257) { sBias[tid] = rb[tid]; sBias[260 + tid] = rb[257 + tid]; }
  AW_COMMIT(0, 0);
  if (jmin + 1 < 9) AW_ISSUE(jmin + 1, 1);
  __syncthreads();
  const float* sB = sBias + hsel * 260;
  for (int j = jmin; j < 9; j += 2) {
    if (j + 2 < 9) AW_ISSUE(j + 2, 0);
    attn_stage(smem + hsel * 16384, sB, j, iq, bfar, Qf, O, m, lsum, fr, fq);
    if (j + 1 < 9) AW_COMMIT(1, 1);
    __syncthreads();
    if (j + 1 >= 9) break;
    if (j + 3 < 9) AW_ISSUE(j + 3, 1);
    attn_stage(smem + 65536 + hsel * 16384, sB, j + 1, iq, bfar, Qf, O, m, lsum, fr, fq);
    if (j + 2 < 9) AW_COMMIT(0, 0);
    __syncthreads();
  }
#undef AW_ISSUE
#undef AW_COMMIT
  lsum += __shfl_xor(lsum, 16); lsum += __shfl_xor(lsum, 32);
  const float inv = 1.f / lsum;
#pragma unroll
  for (int et = 0; et < 8; ++et) { const u32x2 z = *(const u32x2*)(proj + (size_t)qrow * LDP + 3072 + hh * 128 + 16 * et + 4 * fq);
    u32x2 w; w.x = pk2(O[et][0] * inv * siluf_(bflo(z.x)), O[et][1] * inv * siluf_(bfhi(z.x))); w.y = pk2(O[et][2] * inv * siluf_(bflo(z.y)), O[et][3] * inv * siluf_(bfhi(z.y)));
    *(u32x2*)(proj + (size_t)qrow * LDP + C_ACAT + hh * 128 + 16 * et + 4 * fq) = w; }
}

DI void m2_phase(const Params& p, int l, int rep, unsigned char* smem) {
  const int tid_ = otid(); const int wv = tid_ >> 6;
  if (oblk() < 64) {
    const int chain = oblk(), ty = chain >> 5, sq = (chain & 31) >> 3, hh = chain & 7;
    for (int r3 = 0; r3 < R_SW; ++r3) { if (ty == 0) scan_wg2<0>(p, l, sq, hh, smem); else scan_wg2<1>(p, l, sq, hh, smem); }
  } else {
    for (int idx = (oblk() - 64) * 8 + wv; idx < 1024; idx += (gridDim.x - 64) * 8) {
      const int ty = idx >> 9, r = idx & 511, sq = 4 + (r >> 6), hh = (r >> 3) & 7, sl = r & 7;
      if (ty == 0) scan_item<0>(p, l, sq, hh, sl); else scan_item<1>(p, l, sq, hh, sl); }
  }
  unsigned* cnt = (unsigned*)(p.ws + OFF_CNT) + 64 * (l * 2 + rep);
  for (;;) {
    __syncthreads();
    if (tid_ == 0) *(volatile unsigned*)(smem + 131072) = atomicAdd(cnt, 1u);
    __syncthreads();
    const unsigned idx = *(volatile unsigned*)(smem + 131072);
    if (idx >= 1056u) break;
    for (int r2 = 0; r2 < R_AT; ++r2) attn_wg(p, l, (int)idx, smem);
  }
}

DI void m3_phase(const Params& p, int l) {
  bf16_t* proj = (bf16_t*)(p.ws + OFF_PROJ);
  const int tid_ = otid(); const int lane = tid_ & 63, gw = oblk() * 8 + (tid_ >> 6), nw = gridDim.x * 8;
  for (int wi = gw; wi < 2 * MROWS; wi += nw) {
    const int r = wi >> 1, br = wi & 1; bf16_t* rp = proj + (size_t)r * LDP;
    float v[16], z[16];
    unpack8(*(const u32x4*)(rp + (br ? C_OCRAW : C_OBRAW) + 16 * lane), v); unpack8(*(const u32x4*)(rp + (br ? C_OCRAW : C_OBRAW) + 16 * lane + 8), v + 8);
    unpack8(*(const u32x4*)(rp + (br ? 11264 : 7168) + 16 * lane), z); unpack8(*(const u32x4*)(rp + (br ? 11264 : 7168) + 16 * lane + 8), z + 8);
    const float* nw_ = br ? p.ret_norm + (size_t)l * 1024 + 16 * lane : p.delta_norm + (size_t)l * 128 + 16 * (lane & 7);
    float mu = 0.f;
    if (br) {
#pragma unroll
      for (int c = 0; c < 16; ++c) mu += v[c];
      mu += __shfl_xor(mu, 1); mu += __shfl_xor(mu, 2); mu += __shfl_xor(mu, 4); mu *= (1.f / 128.f); }
    float ss = 0.f;
#pragma unroll
    for (int c = 0; c < 16; ++c) { v[c] -= mu; ss += v[c] * v[c]; }
    ss += __shfl_xor(ss, 1); ss += __shfl_xor(ss, 2); ss += __shfl_xor(ss, 4);
    const float rn = rsqrtf(ss * (1.f / 128.f) + 1e-6f);
#pragma unroll
    for (int c = 0; c < 16; ++c) v[c] = v[c] * rn * nw_[c] * siluf_(z[c]);
    *(u32x4*)(rp + C_ACAT + 1024 + br * 1024 + 16 * lane) = pack8(v); *(u32x4*)(rp + C_ACAT + 1024 + br * 1024 + 16 * lane + 8) = pack8(v + 8);
  }
}

DI void merge_phase(const Params& p) {
  const bf16_t* proj = (const bf16_t*)(p.ws + OFF_PROJ); const bf16_t* P = (const bf16_t*)(p.ws + OFF_M1); bf16_t* mg = (bf16_t*)(p.ws + OFF_H);
  const int tid_ = otid(); const int lane = tid_ & 63, gw = oblk() * 8 + (tid_ >> 6), nw = gridDim.x * 8;
  for (int r = gw; r < MROWS; r += nw) {
    const bf16_t* pr = P + (size_t)r * (3 * DM); const bf16_t* gr = proj + (size_t)r * LDP + 12288;
#pragma unroll
    for (int q = 0; q < 4; ++q) { const int c = q * 512 + lane * 8; float acc[8];
#pragma unroll
      for (int j = 0; j < 8; ++j) acc[j] = 0.f;
#pragma unroll
      for (int br = 0; br < 3; ++br) { float pv[8], gv[8]; unpack8(*(const u32x4*)(pr + br * DM + c), pv); unpack8(*(const u32x4*)(gr + br * DM + c), gv);
#pragma unroll
        for (int j = 0; j < 8; ++j) acc[j] += pv[j] * sigmoidf_(gv[j]); }
      *(u32x4*)(mg + (size_t)r * DM + c) = pack8(acc); }
  }
}

#define XB_TMO      128
#define XB_XCNT(j)  (256  + 64 * (j))
#define XB_XSUB(j)  (1280 + 64 * (j))
#define XB_XGEN(j)  (2304 + 64 * (j))
#define XB_TOP      3328
#define XB_TOPGEN   3392
#define XCD_BAR_WORDS 3456
#define XB_SPIN_CAP (1u << 18)
DI unsigned xb_ld(unsigned* p) { return __hip_atomic_load(p, __ATOMIC_RELAXED, __HIP_MEMORY_SCOPE_AGENT); }
DI unsigned xb_add(unsigned* p, unsigned v) { return __hip_atomic_fetch_add(p, v, __ATOMIC_RELAXED, __HIP_MEMORY_SCOPE_AGENT); }
DI unsigned xb_xcc_id() { return (unsigned)__builtin_amdgcn_s_getreg((3 << 11) | 20) & 0xFu; }
#define XB_SPIN(cond, bar) do { unsigned _sp = 0; while (cond) { __builtin_amdgcn_s_sleep(1); \
    if ((++_sp & 255u) == 0u) { if (xb_ld(&(bar)[XB_TMO])) break; if (_sp > XB_SPIN_CAP) { atomicAdd(&(bar)[XB_TMO], 1u); break; } } } } while (0)
struct XcdBarrier { unsigned* bar; unsigned x; volatile LAS unsigned* st; };
DI XcdBarrier xcd_barrier_post(unsigned* bar, volatile LAS unsigned* st) {
  XcdBarrier b; b.bar = bar; b.x = xb_xcc_id(); b.st = st;
  if (threadIdx.x == 0) (void)xb_add(&bar[XB_XCNT(b.x)], 1u);
  return b;
}
DI void xcd_barrier_complete(unsigned* bar, unsigned x, unsigned& nloc, unsigned& nx) {
  const unsigned G = gridDim.x * gridDim.y * gridDim.z;
  unsigned sum, cnt, mine, sp = 0u;
  for (;;) {
    sum = 0u; cnt = 0u; mine = 0u;
#pragma unroll
    for (unsigned j = 0; j < 16; ++j) { const unsigned c = xb_ld(&bar[XB_XCNT(j)]); sum += c; cnt += (c > 0u) ? 1u : 0u; mine = (j == x) ? c : mine; }
    if (sum == G) break;
    __builtin_amdgcn_s_sleep(1);
    if ((++sp & 255u) == 0u) { if (xb_ld(&bar[XB_TMO])) break; if (sp > XB_SPIN_CAP) { atomicAdd(&bar[XB_TMO], 1u); break; } }
  }
  nloc = mine > 0u ? mine : 1u; nx = cnt > 0u ? cnt : 1u;
}
DI void xcd_barrier(const XcdBarrier& b) {
  asm volatile("s_waitcnt vmcnt(0)" ::: "memory");
  __syncthreads();
  if (threadIdx.x == 0) {
    unsigned* bar = b.bar;
    __builtin_amdgcn_s_waitcnt(0);
    unsigned nloc = b.st[0], nx = b.st[1];
    if (nloc == 0u) { xcd_barrier_complete(bar, b.x, nloc, nx); b.st[0] = nloc; b.st[1] = nx; }
    const unsigned old = xb_add(&bar[XB_XSUB(b.x)], 1u);
    const unsigned gen = old / nloc;
    if (old + 1u == (gen + 1u) * nloc) {
      __builtin_amdgcn_fence(__ATOMIC_RELEASE, "agent");
      asm volatile("s_waitcnt vmcnt(0)" ::: "memory");
      const unsigned og = xb_add(&bar[XB_TOP], 1u);
      const unsigned tg = og / nx;
      if (og + 1u == (tg + 1u) * nx) xb_add(&bar[XB_TOPGEN], 1u);
      else XB_SPIN(xb_ld(&bar[XB_TOPGEN]) == tg, bar);
      __builtin_amdgcn_fence(__ATOMIC_ACQUIRE, "agent");
      xb_add(&bar[XB_XGEN(b.x)], 1u);
      asm volatile("s_waitcnt vmcnt(0)" ::: "memory");
    } else {
      XB_SPIN(xb_ld(&bar[XB_XGEN(b.x)]) == gen, bar);
      __builtin_amdgcn_fence(__ATOMIC_ACQUIRE, "agent");
      asm volatile("s_waitcnt vmcnt(0)" ::: "memory");
    }
  }
  __syncthreads();
}

__global__ void __launch_bounds__(512, 2) mega(Params p) {
  extern __shared__ __attribute__((aligned(16))) unsigned char smem[];
  cg::grid_group grid = cg::this_grid();
  const int G = gridDim.x;
  if (threadIdx.x == 0) { ((volatile LAS unsigned*)(LAS unsigned char*)smem)[(131072 + 16) / 4] = 0u; ((volatile LAS unsigned*)(LAS unsigned char*)smem)[(131072 + 20) / 4] = 0u; }
  __syncthreads();
  XcdBarrier xb = xcd_barrier_post((unsigned*)(p.ws + OFF_BAR), (volatile LAS unsigned*)((LAS unsigned char*)smem + 131072 + 16));
  if (oblk() == 0 && threadIdx.x < 4) ((unsigned*)(p.ws + OFF_CNT))[64 * threadIdx.x] = 0u;
  if (T_ROW) { convert_weights(p, 0, (float*)smem, 2, oblk(), gridDim.x);
  prenorm_phase(p, 0); }
  grid.sync();
  for (int l = 0; l < 2; ++l) {
    { pg8::Gemm g{(const bf16_t*)(p.ws + OFF_H), (const bf16_t*)(p.ws + OFF_WIN), MROWS, NW1, DM, DM, DM, 1 << 20, 0};
      pg8::StaticOrder S; S.init(MROWS, NW1, G, oblk());
      EpiProj E{(bf16_t*)(p.ws + OFF_PROJ), (float*)(p.ws + OFF_SIDE), LDP, 72};
      for (int rep = 0; rep < R_G1; ++rep) pg8::gemm_phase(( LAS unsigned char*)smem, g, S, E); }
    xcd_barrier(xb);
    { float* sCW = (float*)(smem + 122880); const int hh0 = oblk() & 7;
      for (int idx = threadIdx.x; idx < 1536; idx += 512) { const int mat = idx / 512, tap = (idx >> 7) & 3, col = idx & 127;
        sCW[idx] = p.conv_w[((size_t)l * 4 + tap) * 3072 + mat * 1024 + hh0 * 128 + col]; }
      __syncthreads(); }
    for (int rep = 0; rep < R_M1; ++rep)
    for (int t = oblk(); t < 3 * NITEM + 512; t += G) {
      if (t < NITEM) { for (int r2 = 0; r2 < R_DP; ++r2) delta_pre(p, l, t, smem); }
      else if (t < 2 * NITEM) { if (T_RP) ret_pre(p, l, t - NITEM, smem); }
      else if (t < 3 * NITEM) { if (T_MI) misc_item(p, l, t - 2 * NITEM, smem); }
      else { if (T_MI) cache_item(p, l, t - 3 * NITEM, smem); }
    }
    xcd_barrier(xb);
    for (int rep = 0; rep < R_M2; ++rep) m2_phase(p, l, rep, smem);
    xcd_barrier(xb);
    for (int rep = 0; rep < R_M3; ++rep) m3_phase(p, l);
    xcd_barrier(xb);
    for (int rep = 0; rep < R_G2; ++rep) {
      pg8::Gemm g{(const bf16_t*)(p.ws + OFF_PROJ) + C_ACAT, (const bf16_t*)(p.ws + OFF_WBR), MROWS, 3 * DM, 1024, LDP, 1024, 8, 2048};
      pg8::StaticOrder S; S.init(MROWS, 3 * DM, G, oblk());
      EpiProj E{(bf16_t*)(p.ws + OFF_M1), nullptr, 3 * DM, 1 << 20};
      pg8::gemm_phase((LAS unsigned char*)smem, g, S, E); }
    xcd_barrier(xb);
    merge_phase(p);
    xcd_barrier(xb);
    if (l == 0) {
      { pg8::Gemm g{(const bf16_t*)(p.ws + OFF_H), (const bf16_t*)(p.ws + OFF_WOUT), MROWS, DM, DM, DM, DM, 1 << 20, 0};
        pg8::StaticOrder S; S.init(MROWS, DM, G, oblk());
        EpiF32 E{(float*)(p.ws + OFF_M1 + 69206016)};
        pg8::gemm_phase((LAS unsigned char*)smem, g, S, E); }
      { const int c0 = 528 - ((528 + G - 1) / G - 1) * G;
        if (c0 < G && oblk() >= c0) convert_weights(p, 1, (float*)smem, 0, oblk() - c0, G - c0);
        else if (c0 >= G) convert_weights(p, 1, (float*)smem, 0, oblk(), G); }
      xcd_barrier(xb);
      postnorm_phase(p, l, 0, MROWS, 0, G);
    } else {
      { pg8::Gemm g{(const bf16_t*)(p.ws + OFF_H), (const bf16_t*)(p.ws + OFF_WOUT), 16384, DM, DM, DM, DM, 1 << 20, 0};
        pg8::StaticOrder S; S.init(16384, DM, G, oblk());
        EpiF32 E{(float*)(p.ws + OFF_M1 + 69206016)};
        pg8::gemm_phase((LAS unsigned char*)smem, g, S, E); }
      xcd_barrier(xb);
      if (oblk() < 16 && G > 16) {
        pg8::Gemm g{(const bf16_t*)(p.ws + OFF_H) + (size_t)16384 * DM, (const bf16_t*)(p.ws + OFF_WOUT), 512, DM, DM, DM, DM, 1 << 20, 0};
        pg8::StaticOrder S; S.init(512, DM, 16, oblk());
        EpiF32 E{(float*)(p.ws + OFF_M1 + 69206016) + (size_t)16384 * DM};
        pg8::gemm_phase((LAS unsigned char*)smem, g, S, E);
      } else if (G > 16) postnorm_phase(p, l, 0, 16384, 16, G - 16);
      xcd_barrier(xb);
      postnorm_phase(p, l, 16384, MROWS, 0, G);
    }
    if (l == 0) { if (T_ROW) convert_weights(p, 1, (float*)smem, 1, oblk(), gridDim.x); xcd_barrier(xb); }
  }
}

extern "C" void kernel_launch(void* const* d_in, const int* in_sizes, int n_in, void* d_out, int out_size,
                              void* d_ws, size_t ws_size, hipStream_t stream) {
  constexpr size_t kLds = 131072 + 256 + 4096;
  static int grid_blocks = 0;
  if (!grid_blocks) {
    (void)hipFuncSetAttribute((const void*)mega, hipFuncAttributeMaxDynamicSharedMemorySize, (int)kLds);
    int dev = 0, cus = 0, per_cu = 0;
    (void)hipGetDevice(&dev);
    (void)hipDeviceGetAttribute(&cus, hipDeviceAttributeMultiprocessorCount, dev);
    (void)hipOccupancyMaxActiveBlocksPerMultiprocessor(&per_cu, mega, 512, kLds);
    if (per_cu > 1) per_cu = 1;
    grid_blocks = cus * per_cu;
    if (grid_blocks > 256) grid_blocks = 256;
  }
  if (ws_size < WS_NEED) { fprintf(stderr, "workspace too small: %zu < %zu\n", ws_size, (size_t)WS_NEED); return; }
  (void)hipMemsetAsync((unsigned char*)d_ws + OFF_BAR, 0, 16384, stream);
  Params p{};
  const float** pp = (const float**)&p;
  for (int i = 0; i < 20; ++i) pp[i] = (const float*)d_in[i];
  p.out = (float*)d_out; p.ws = (unsigned char*)d_ws;
  void* args[] = {&p};
  hipError_t e = hipLaunchCooperativeKernel((void*)mega, dim3(grid_blocks), dim3(512), args, kLds, stream);
  if (e != hipSuccess) fprintf(stderr, "cooperative launch failed: %s (grid %d)\n", hipGetErrorString(e), grid_blocks);
}
```

```cpp
#include <hip/hip_runtime.h>
#include <hip/hip_cooperative_groups.h>
#include <cstdio>
namespace cg = cooperative_groups;
#ifndef R_DP
#define R_DP 1
#endif
#ifndef R_SW
#define R_SW 1
#endif
#ifndef R_AT
#define R_AT 1
#endif
#ifndef R_G1
#define R_G1 1
#endif
#ifndef R_M1
#define R_M1 1
#endif
#ifndef R_M2
#define R_M2 1
#endif
#ifndef R_M3
#define R_M3 1
#endif
#ifndef R_G2
#define R_G2 1
#endif
#ifndef R_G3
#define R_G3 1
#endif
#ifndef T_ROW
#define T_ROW 1
#endif
#ifndef T_G1
#define T_G1 1
#endif
#ifndef T_DP
#define T_DP 1
#endif
#ifndef T_RP
#define T_RP 1
#endif
#ifndef T_MI
#define T_MI 1
#endif
#ifndef T_M2
#define T_M2 1
#endif
#ifndef T_M3
#define T_M3 1
#endif
#ifndef T_G2
#define T_G2 1
#endif
#ifndef T_G3
#define T_G3 1
#endif
#ifndef T_AT
#define T_AT 1
#endif
#ifndef T_SC
#define T_SC 1
#endif

#define DI __device__ __forceinline__
#define LAS __attribute__((address_space(3)))
typedef unsigned short bf16_t;
typedef short bf16x8 __attribute__((ext_vector_type(8)));
typedef float f32x4 __attribute__((ext_vector_type(4)));
typedef float f32x2 __attribute__((ext_vector_type(2)));
typedef unsigned u32x4 __attribute__((ext_vector_type(4)));
typedef unsigned u32x2 __attribute__((ext_vector_type(2)));
typedef __bf16 bf2_t __attribute__((ext_vector_type(2)));

constexpr int DM = 2048, MROWS = 16896, LDP = 18432, NW1 = 18688, NIN = 18448, NITEM = 2112;
constexpr int C_ACAT = 4096, C_OBRAW = 8192, C_OCRAW = 9216;
constexpr size_t O_PK = 34603008, O_PV = 38797312, O_PC = 42991616, O_PD = 43065344, O_PR = 44113920, O_SK = 45162496, O_SV = 53551104, O_SC = 61939712, O_SD = 62087168, O_SR = 64184320;
constexpr size_t OFF_WIN = 0, OFF_WBR = 76546048, OFF_WOUT = 89128960, OFF_H = 97517568, OFF_PROJ = 166723584, OFF_SIDE = 789577728, OFF_DG = 790659072,
                 OFF_CNT = 790667520, OFF_KC = 790675456, OFF_CVT = 799064064, OFF_M1 = 807452672, OFF_BAR = 1118879744, WS_NEED = 1118879744 + 16384;
constexpr size_t M1_BLK = (size_t)NITEM * 8192;

struct Params {
  const float *x_prompt, *x_sample, *cache_k, *cache_v, *state_conv, *state_delta, *state_ret, *norm_pre, *norm_post, *w_in, *rel_bias, *conv_w, *a_log, *dt_bias,
      *delta_norm, *ret_norm, *w_ba, *w_bb, *w_bc, *w_out;
  float* out; unsigned char* ws;
};

DI unsigned pk2(float lo, float hi) { f32x2 v = {lo, hi}; bf2_t b = __builtin_convertvector(v, bf2_t); return __builtin_bit_cast(unsigned, b); }
DI bf16_t f2bf(float x) { return (bf16_t)(pk2(x, 0.f) & 0xffffu); }
DI float bflo(unsigned w) { return __uint_as_float(w << 16); }
DI float bfhi(unsigned w) { return __uint_as_float(w & 0xffff0000u); }
DI float bf2f(bf16_t b) { return __uint_as_float(((unsigned)b) << 16); }
DI float sigmoidf_(float x) { return 1.f / (1.f + __expf(-x)); }
DI float siluf_(float x) { return x / (1.f + __expf(-x)); }
DI int oblk() { int b = blockIdx.x; asm volatile("" : "+s"(b)); return __builtin_amdgcn_readfirstlane(b); }
DI int otid() { int t = threadIdx.x; asm volatile("" : "+v"(t)); return t; }
DI int kperm(int p) { return 16 * ((p >> 2) & 1) + 4 * (p >> 3) + (p & 3); }
DI int kinv(int x) { return 8 * ((x >> 2) & 3) + 4 * (x >> 4) + (x & 3); }
DI float wsum(float v) { for (int o = 32; o > 0; o >>= 1) v += __shfl_xor(v, o); return v; }
DI void unpack8(u32x4 a, float* o) { o[0] = bflo(a.x); o[1] = bfhi(a.x); o[2] = bflo(a.y); o[3] = bfhi(a.y); o[4] = bflo(a.z); o[5] = bfhi(a.z); o[6] = bflo(a.w); o[7] = bfhi(a.w); }
DI u32x4 pack8(const float* v) { u32x4 w; w.x = pk2(v[0], v[1]); w.y = pk2(v[2], v[3]); w.z = pk2(v[4], v[5]); w.w = pk2(v[6], v[7]); return w; }
DI bf16x8 pack_frag(f32x4 a, f32x4 b) { u32x4 w; w.x = pk2(a[0], a[1]); w.y = pk2(a[2], a[3]); w.z = pk2(b[0], b[1]); w.w = pk2(b[2], b[3]); return __builtin_bit_cast(bf16x8, w); }
#define MFMA16(a, b, c) __builtin_amdgcn_mfma_f32_16x16x32_bf16((a), (b), (c), 0, 0, 0)

namespace pg8 {
constexpr int BM = 256, BK = 64, HALF = 128, HTB = HALF * BK * 2, STAGE_BYTES = 8 * HTB, NXCD = 8, WGM = 8;
DI int lds_byte(int r, int c) { const int st = (r >> 4) * 2 + (c >> 5), rr = r & 15, cc = c & 31, ob = rr * 64 + cc * 2; return st * 1024 + (ob ^ (((ob >> 9) & 1) << 5)); }
DI void stage_rc(int b, int& R, int& C) { const int st = b / 1024, sb = b % 1024, swz = sb ^ (((sb >> 9) & 1) << 5); R = (st >> 1) * 16 + swz / 64; C = (st & 1) * 32 + (swz % 64) / 2; }
DI int perm32(int rho) { const int n = rho >> 4, i = rho & 15; return 8 * (i >> 2) + 4 * n + (i & 3); }
struct Unit { int pm, pn; };
struct Gemm { const bf16_t* A; const bf16_t* Bt; int M, N, K, lda, ldb, a_div, a_step; };
struct StaticOrder {
  int nM, nN, nwg, G, c;
  DI void init(int M, int N, int G_, int c_) { nM = M / BM; nN = N / BM; nwg = nM * nN; G = G_; c = c_; }
  DI bool next(int i, Unit& u) const {
    const long L = (long)i * G + c; if (L >= nwg) return false;
    int wgid = (int)L; { const int q = nwg / NXCD, r = nwg % NXCD, xcd = wgid % NXCD, off = wgid / NXCD; wgid = (xcd < r ? xcd * (q + 1) : r * (q + 1) + (xcd - r) * q) + off; }
    const int nig = WGM * nN, gid = wgid / nig, fm = gid * WGM, gsz = (nM - fm) < WGM ? (nM - fm) : WGM;
    u.pm = fm + ((wgid % nig) % gsz); u.pn = (wgid % nig) / gsz; return true;
  }
};

template <class Epi>
DI void gemm_phase(LAS unsigned char* lds, const Gemm g, const StaticOrder& S, const Epi& E) {
  const int tid = otid(), wid = __builtin_amdgcn_readfirstlane(tid >> 6), lane = tid & 63, wr = wid >> 2, wc = wid & 3, fr = lane & 15, fq = lane >> 4;
  const int K = g.K, nt = K / BK;
  unsigned voffA[2], voffB[2];
#pragma unroll
  for (int i = 0; i < 2; ++i) { int R, C; stage_rc(tid * 16 + i * 8192, R, C); const int Rb = Epi::PERM ? ((R & ~31) + perm32(R & 31)) : R;
    voffA[i] = (unsigned)(R * g.lda + C) * 2u; voffB[i] = (unsigned)(Rb * g.ldb + C) * 2u; }
  const size_t kstep = (size_t)(BK * 2);
  const size_t hstepA = (size_t)HALF * g.lda * 2, hstepB = (size_t)HALF * g.ldb * 2;
  const size_t tstepA = 2 * hstepA, tstepB = 2 * hstepB;
  const unsigned ldsw = (unsigned)wid * 1024u;
  const int aoff = lds_byte(wr * 64 + fr, fq * 8), boff = lds_byte(wc * 32 + fr, fq * 8);
#define PG8_SA(b, h) (((b) * 2 + (h)) * HTB)
#define PG8_SB(b, h) ((4 + (b) * 2 + (h)) * HTB)
#define PG8_STAGE(bufoff, gbase, voff) do { const char* _gb = (const char*)(gbase); asm volatile("" : "+s"(_gb)); _Pragma("unroll") for (int _i = 0; _i < 2; ++_i) \
    __builtin_amdgcn_global_load_lds((const unsigned*)(_gb + (voff)[_i]), (LAS unsigned*)(lds + (bufoff) + ldsw + _i * 8192), 16, 0, 0); } while (0)
#define PG8_LDA(dst, b, h) do { _Pragma("unroll") for (int m = 0; m < 4; ++m) _Pragma("unroll") for (int k = 0; k < 2; ++k) dst[m][k] = *(const LAS bf16x8*)(lds + PG8_SA(b, h) + aoff + m * 2048 + k * 1024); } while (0)
#define PG8_LDB(dst, b, h) do { _Pragma("unroll") for (int n = 0; n < 2; ++n) _Pragma("unroll") for (int k = 0; k < 2; ++k) dst[n][k] = *(const LAS bf16x8*)(lds + PG8_SB(b, h) + boff + n * 2048 + k * 1024); } while (0)
#define PG8_MMA(ai, bj, At, Bt) do { __builtin_amdgcn_s_setprio(1); _Pragma("unroll") for (int m = 0; m < 4; ++m) _Pragma("unroll") for (int n = 0; n < 2; ++n) _Pragma("unroll") for (int k = 0; k < 2; ++k) \
    acc[ai][bj][m][n] = __builtin_amdgcn_mfma_f32_16x16x32_bf16(Bt[n][k], At[m][k], acc[ai][bj][m][n], 0, 0, 0); __builtin_amdgcn_s_setprio(0); } while (0)
#define PG8_WAIT_V(n) asm volatile("s_waitcnt vmcnt(" #n ")" ::: "memory")
#define PG8_WAIT_L(n) asm volatile("s_waitcnt lgkmcnt(" #n ")" ::: "memory")
#define PG8_BAR __builtin_amdgcn_s_barrier()
#define PG8_SCHED __builtin_amdgcn_sched_barrier(0)
  Unit cur, nxt; int ui = 0;
  if (!S.next(0, cur)) return;
  f32x4 acc[2][2][4][2];
#pragma unroll
  for (int a = 0; a < 2; ++a)
#pragma unroll
    for (int b = 0; b < 2; ++b)
#pragma unroll
      for (int m = 0; m < 4; ++m)
#pragma unroll
        for (int n = 0; n < 2; ++n) acc[a][b][m][n] = (f32x4){0.f, 0.f, 0.f, 0.f};
  bf16x8 At[4][2], B0[2][2], B1[2][2];
  const char* cA = (const char*)g.A + (size_t)cur.pm * tstepA + (size_t)((cur.pn / g.a_div) * g.a_step); const char* cB = (const char*)g.Bt + (size_t)cur.pn * tstepB;
  PG8_STAGE(PG8_SB(0, 0), cB, voffB); PG8_STAGE(PG8_SA(0, 0), cA, voffA); PG8_STAGE(PG8_SB(0, 1), cB + hstepB, voffB); PG8_STAGE(PG8_SA(0, 1), cA + hstepA, voffA);
  if (wr == 1) PG8_BAR;
  PG8_WAIT_V(4); PG8_BAR;
  PG8_STAGE(PG8_SB(1, 0), cB + kstep, voffB); PG8_STAGE(PG8_SA(1, 0), cA + kstep, voffA); PG8_STAGE(PG8_SB(1, 1), cB + hstepB + kstep, voffB);
  PG8_WAIT_V(6); PG8_BAR;
  for (;;) {
    const bool has_next = S.next(ui + 1, nxt);
    const char* nA = has_next ? (const char*)g.A + (size_t)nxt.pm * tstepA + (size_t)((nxt.pn / g.a_div) * g.a_step) : cA; const char* nB = has_next ? (const char*)g.Bt + (size_t)nxt.pn * tstepB : cB;
    for (int t = 0; t < nt; t += 2) {
      const bool last = (t == nt - 2);
      const char* a1 = cA + (size_t)(t + 1) * kstep;
      const char* a2 = last ? nA : cA + (size_t)(t + 2) * kstep; const char* b2 = last ? nB : cB + (size_t)(t + 2) * kstep;
      const char* a3 = a2 + kstep; const char* b3 = b2 + kstep;
      PG8_LDB(B0, 0, 0); PG8_SCHED; PG8_LDA(At, 0, 0); PG8_STAGE(PG8_SA(1, 1), a1 + hstepA, voffA);
      PG8_WAIT_L(8); PG8_BAR; PG8_WAIT_L(0); PG8_MMA(0, 0, At, B0); PG8_BAR; PG8_SCHED;
      PG8_LDB(B1, 0, 1); PG8_STAGE(PG8_SB(0, 0), b2, voffB);
      PG8_BAR; PG8_WAIT_L(0); PG8_MMA(0, 1, At, B1); PG8_BAR;
      PG8_LDA(At, 0, 1); PG8_STAGE(PG8_SA(0, 0), a2, voffA);
      PG8_BAR; PG8_WAIT_L(0); PG8_MMA(1, 0, At, B0); PG8_BAR; PG8_SCHED;
      PG8_STAGE(PG8_SB(0, 1), b2 + hstepB, voffB);
      PG8_WAIT_V(6); PG8_BAR; PG8_MMA(1, 1, At, B1); PG8_BAR;
      PG8_LDB(B0, 1, 0); PG8_SCHED; PG8_LDA(At, 1, 0); PG8_STAGE(PG8_SA(0, 1), a2 + hstepA, voffA);
      PG8_WAIT_L(8); PG8_BAR; PG8_WAIT_L(0); PG8_MMA(0, 0, At, B0); PG8_BAR; PG8_SCHED;
      PG8_LDB(B1, 1, 1); PG8_STAGE(PG8_SB(1, 0), b3, voffB);
      PG8_BAR; PG8_WAIT_L(0); PG8_MMA(0, 1, At, B1); PG8_BAR;
      PG8_LDA(At, 1, 1); PG8_STAGE(PG8_SA(1, 0), a3, voffA);
      PG8_BAR; PG8_WAIT_L(0); PG8_MMA(1, 0, At, B0); PG8_BAR; PG8_SCHED;
      PG8_STAGE(PG8_SB(1, 1), b3 + hstepB, voffB);
      PG8_WAIT_V(6); PG8_BAR; PG8_MMA(1, 1, At, B1); PG8_BAR;
    }
    E(acc, cur, wr, wc, fr, fq);
    if (!has_next) break;
#pragma unroll
    for (int a = 0; a < 2; ++a)
#pragma unroll
      for (int b = 0; b < 2; ++b)
#pragma unroll
        for (int m = 0; m < 4; ++m)
#pragma unroll
          for (int n = 0; n < 2; ++n) acc[a][b][m][n] = (f32x4){0.f, 0.f, 0.f, 0.f};
    cur = nxt; cA = nA; cB = nB; ++ui;
  }
  PG8_WAIT_V(0);
  if (wr == 0) PG8_BAR;
  PG8_BAR;
#undef PG8_SA
#undef PG8_SB
#undef PG8_STAGE
#undef PG8_LDA
#undef PG8_LDB
#undef PG8_MMA
#undef PG8_WAIT_V
#undef PG8_WAIT_L
#undef PG8_BAR
#undef PG8_SCHED
}
}

struct EpiProj {
  static constexpr bool PERM = true;
  bf16_t* O; float* side; int ldc, nmain;
  DI void operator()(const f32x4 (&acc)[2][2][4][2], const pg8::Unit& u, int wr, int wc, int fr, int fq) const {
    const int row0 = u.pm * 256 + wr * 64 + fr;
    if (u.pn < nmain) {
      const int col0 = u.pn * 256 + wc * 32 + 8 * fq;
#pragma unroll
      for (int ai = 0; ai < 2; ++ai)
#pragma unroll
        for (int m = 0; m < 4; ++m) { bf16_t* rowp = O + (size_t)(row0 + ai * 128 + m * 16) * ldc + col0;
#pragma unroll
          for (int bj = 0; bj < 2; ++bj) { const f32x4 v0 = acc[ai][bj][m][0], v1 = acc[ai][bj][m][1];
            u32x4 w; w.x = pk2(v0[0], v0[1]); w.y = pk2(v0[2], v0[3]); w.z = pk2(v1[0], v1[1]); w.w = pk2(v1[2], v1[3]);
            *(u32x4*)(rowp + bj * 128) = w; } }
    } else if (wc == 0 && fq < 2) {
#pragma unroll
      for (int ai = 0; ai < 2; ++ai)
#pragma unroll
        for (int m = 0; m < 4; ++m) { float* sp = side + (size_t)(row0 + ai * 128 + m * 16) * 16 + 8 * fq;
          *(f32x4*)sp = acc[ai][0][m][0]; *(f32x4*)(sp + 4) = acc[ai][0][m][1]; }
    }
  }
};
struct EpiGate {
  static constexpr bool PERM = true;
  bf16_t* O; const bf16_t* proj; int br;
  DI void operator()(const f32x4 (&acc)[2][2][4][2], const pg8::Unit& u, int wr, int wc, int fr, int fq) const {
    const int row0 = u.pm * 256 + wr * 64 + fr, col0 = u.pn * 256 + wc * 32 + 8 * fq;
#pragma unroll
    for (int ai = 0; ai < 2; ++ai)
#pragma unroll
      for (int m = 0; m < 4; ++m) { const int row = row0 + ai * 128 + m * 16;
        bf16_t* rowp = O + (size_t)row * DM + col0; const bf16_t* gp = proj + (size_t)row * LDP + 12288 + br * 2048 + col0;
#pragma unroll
        for (int bj = 0; bj < 2; ++bj) { const f32x4 v0 = acc[ai][bj][m][0], v1 = acc[ai][bj][m][1];
          float gt[8], v[8]; unpack8(*(const u32x4*)(gp + bj * 128), gt);
#pragma unroll
          for (int j = 0; j < 4; ++j) { v[j] = v0[j] * sigmoidf_(gt[j]); v[4 + j] = v1[j] * sigmoidf_(gt[4 + j]); }
          if (br > 0) { float pv[8]; unpack8(*(const u32x4*)(rowp + bj * 128), pv);
#pragma unroll
            for (int j = 0; j < 8; ++j) v[j] += pv[j]; }
          *(u32x4*)(rowp + bj * 128) = pack8(v); } }
  }
};
struct EpiF32 {
  static constexpr bool PERM = false;
  float* C;
  DI void operator()(const f32x4 (&acc)[2][2][4][2], const pg8::Unit& u, int wr, int wc, int fr, int fq) const {
    const int row0 = u.pm * 256 + wr * 64 + fr, col0 = u.pn * 256 + wc * 32 + 4 * fq;
#pragma unroll
    for (int ai = 0; ai < 2; ++ai)
#pragma unroll
      for (int m = 0; m < 4; ++m) { float* rowp = C + (size_t)(row0 + ai * 128 + m * 16) * DM + col0;
#pragma unroll
        for (int bj = 0; bj < 2; ++bj)
#pragma unroll
          for (int n = 0; n < 2; ++n) *(f32x4*)(rowp + bj * 128 + n * 16) = acc[ai][bj][m][n]; }
  }
};

DI void conv_tile(float* T, const float* src, int ldsrc, int n0, int nvalid, int k0, bf16_t* dst, int K) {
  const int tid = otid();
  f32x4 v[8];
#pragma unroll
  for (int ps = 0; ps < 8; ++ps) { const int k = ps * 8 + (tid >> 6), c4 = (tid & 63) * 4;
    v[ps] = (f32x4){0.f, 0.f, 0.f, 0.f};
    if (c4 < nvalid) v[ps] = *(const f32x4*)(src + (size_t)(k0 + k) * ldsrc + n0 + c4); }
#pragma unroll
  for (int ps = 0; ps < 8; ++ps) { const int k = ps * 8 + (tid >> 6), c4 = (tid & 63) * 4;
    T[k * 257 + c4] = v[ps][0]; T[k * 257 + c4 + 1] = v[ps][1]; T[k * 257 + c4 + 2] = v[ps][2]; T[k * 257 + c4 + 3] = v[ps][3]; }
  __syncthreads();
#pragma unroll
  for (int i = 0; i < 4; ++i) { const int n = (tid >> 3) + 64 * i, kg = tid & 7; float w[8];
#pragma unroll
    for (int j = 0; j < 8; ++j) w[j] = T[(8 * kg + j) * 257 + n];
    *(u32x4*)(dst + (size_t)n * K + k0 + 8 * kg) = pack8(w); }
  __syncthreads();
}
DI void convert_weights(const Params& p, int l, float* T, int part, int first, int stride) {
  bf16_t* win = (bf16_t*)(p.ws + OFF_WIN); bf16_t* wbr = (bf16_t*)(p.ws + OFF_WBR); bf16_t* wout = (bf16_t*)(p.ws + OFF_WOUT);
  const int n_in = 73 * 32, n_br = 3 * 8 * 16, n_out = 8 * 32;
  const int t_lo = (part == 1) ? n_in + n_br : 0, t_hi = (part == 0) ? n_in + n_br : n_in + n_br + n_out;
  for (int t = t_lo + first; t < t_hi; t += stride) {
    if (t < n_in) { const int ntile = t >> 5, kt = t & 31, np0 = ntile * 256; int n0 = 0, nv = 256;
      if (np0 < 8192) n0 = np0; else if (np0 < 18432) n0 = np0 + 16; else { n0 = 8192; nv = 16; }
      conv_tile(T, p.w_in + (size_t)l * DM * NIN, NIN, n0, nv, kt * 64, win + (size_t)np0 * DM, DM);
    } else if (t < n_in + n_br) { const int u = t - n_in, br = u >> 7, r = u & 127, ntile = r >> 4, kt = r & 15;
      const float* src = (br == 0 ? p.w_ba : br == 1 ? p.w_bb : p.w_bc) + (size_t)l * 1024 * DM;
      conv_tile(T, src, DM, ntile * 256, 256, kt * 64, wbr + (size_t)br * DM * 1024 + (size_t)ntile * 256 * 1024, 1024);
    } else { const int u = t - n_in - n_br, ntile = u >> 5, kt = u & 31;
      conv_tile(T, p.w_out + (size_t)l * DM * DM, DM, ntile * 256, 256, kt * 64, wout + (size_t)ntile * 256 * DM, DM); }
  }
}

DI void prenorm_phase(const Params& p, int l) {
  bf16_t* h = (bf16_t*)(p.ws + OFF_H); const float* g = p.norm_pre + (size_t)l * DM;
  const int tid_ = otid(); const int lane = tid_ & 63, gw = oblk() * 8 + (tid_ >> 6), nw = gridDim.x * 8;
  for (int r = gw; r < MROWS; r += nw) {
    const float* xr = (r < 16384) ? p.x_prompt + (size_t)r * DM : p.x_sample + (size_t)(r - 16384) * DM;
    f32x4 v[8]; float ss = 0.f;
#pragma unroll
    for (int i = 0; i < 8; ++i) { v[i] = *(const f32x4*)(xr + i * 256 + lane * 4); ss += v[i][0] * v[i][0] + v[i][1] * v[i][1] + v[i][2] * v[i][2] + v[i][3] * v[i][3]; }
    ss = wsum(ss); const float rn = rsqrtf(ss * (1.f / DM) + 1e-6f);
#pragma unroll
    for (int i = 0; i < 8; ++i) { const f32x4 gg = *(const f32x4*)(g + i * 256 + lane * 4);
      u32x2 w; w.x = pk2(v[i][0] * rn * gg[0], v[i][1] * rn * gg[1]); w.y = pk2(v[i][2] * rn * gg[2], v[i][3] * rn * gg[3]);
      *(u32x2*)(h + (size_t)r * DM + i * 256 + lane * 4) = w; }
  }
}
DI void postnorm_phase(const Params& p, int l, int row_lo, int row_hi, int wg_first, int wg_count) {
  bf16_t* h = (bf16_t*)(p.ws + OFF_H); const float* ypre = (const float*)(p.ws + OFF_M1 + 69206016);
  const float* gpost = p.norm_post + (size_t)l * DM; const float* gpre = p.norm_pre + (size_t)(l + 1) * DM;
  const int tid_ = otid(); const int lane = tid_ & 63, gw = (oblk() - wg_first) * 8 + (tid_ >> 6), nw = wg_count * 8;
  for (int r = row_lo + gw; r < row_hi; r += nw) {
    const float* xr = (l > 0) ? p.out + (size_t)r * DM : ((r < 16384) ? p.x_prompt + (size_t)r * DM : p.x_sample + (size_t)(r - 16384) * DM);
    const float* yr = ypre + (size_t)r * DM;
    f32x4 v[8]; float ss = 0.f;
#pragma unroll
    for (int i = 0; i < 8; ++i) { v[i] = *(const f32x4*)(yr + i * 256 + lane * 4); ss += v[i][0] * v[i][0] + v[i][1] * v[i][1] + v[i][2] * v[i][2] + v[i][3] * v[i][3]; }
    ss = wsum(ss); const float rn = rsqrtf(ss * (1.f / DM) + 1e-6f); float s2 = 0.f;
#pragma unroll
    for (int i = 0; i < 8; ++i) { const f32x4 gg = *(const f32x4*)(gpost + i * 256 + lane * 4); const f32x4 xx = *(const f32x4*)(xr + i * 256 + lane * 4);
#pragma unroll
      for (int j = 0; j < 4; ++j) { v[i][j] = xx[j] + v[i][j] * rn * gg[j]; s2 += v[i][j] * v[i][j]; }
      *(f32x4*)(p.out + (size_t)r * DM + i * 256 + lane * 4) = v[i]; }
    if (l == 0) { s2 = wsum(s2); const float r2 = rsqrtf(s2 * (1.f / DM) + 1e-6f);
#pragma unroll
      for (int i = 0; i < 8; ++i) { const f32x4 gg = *(const f32x4*)(gpre + i * 256 + lane * 4);
        u32x2 w; w.x = pk2(v[i][0] * r2 * gg[0], v[i][1] * r2 * gg[1]); w.y = pk2(v[i][2] * r2 * gg[2], v[i][3] * r2 * gg[3]);
        *(u32x2*)(h + (size_t)r * DM + i * 256 + lane * 4) = w; } }
  }
}

template <class F> DI void write_T_perm(bf16_t* dst, F&& val) {
  const int t = otid(), r = t >> 2, q4 = t & 3, tb = q4 >> 1, p0 = 16 * (q4 & 1);
  float v[16];
#pragma unroll
  for (int j = 0; j < 16; ++j) v[j] = val(32 * tb + kperm(p0 + j), r);
  *(u32x4*)(dst + r * 64 + 32 * tb + p0) = pack8(v); *(u32x4*)(dst + r * 64 + 32 * tb + p0 + 8) = pack8(v + 8);
}
template <class F> DI void write_perm(bf16_t* dst, F&& val) {
  const int t = otid(), tok = t >> 3, cgp = t & 7, db = cgp >> 1, p0 = 16 * (cgp & 1);
  float v[16];
#pragma unroll
  for (int j = 0; j < 16; ++j) v[j] = val(tok, 32 * db + kperm(p0 + j));
  *(u32x4*)(dst + tok * 128 + 32 * db + p0) = pack8(v); *(u32x4*)(dst + tok * 128 + 32 * db + p0 + 8) = pack8(v + 8);
}

DI void conv16(const Params& p, const bf16_t* proj, int l, int ci, int ch0, int tok, float (&y)[16]) {
  const float* cw = p.conv_w + (size_t)l * 4 * 3072 + ch0;
#pragma unroll
  for (int c = 0; c < 16; ++c) y[c] = 0.f;
#pragma unroll
  for (int o = 0; o < 4; ++o) {
    const int t = tok - 3 + o; float xv[16];
    if (t >= 0 || (ci < 256 && (ci & 63) != 0)) {
      const bf16_t* src = proj + (size_t)(ci * 64 + t) * LDP + 4096 + ch0;
      unpack8(*(const u32x4*)src, xv); unpack8(*(const u32x4*)(src + 8), xv + 8);
    } else if (ci >= 256) {
      const float* sc = p.state_conv + ((size_t)(l * 8 + (ci - 256)) * 3 + (3 + t)) * 3072 + ch0;
#pragma unroll
      for (int q = 0; q < 4; ++q) { const f32x4 a = *(const f32x4*)(sc + 4 * q); xv[4 * q] = a[0]; xv[4 * q + 1] = a[1]; xv[4 * q + 2] = a[2]; xv[4 * q + 3] = a[3]; }
    } else {
#pragma unroll
      for (int c = 0; c < 16; ++c) xv[c] = 0.f;
    }
#pragma unroll
    for (int q = 0; q < 4; ++q) { const f32x4 w = *(const f32x4*)(cw + o * 3072 + 4 * q);
      y[4 * q] += w[0] * xv[4 * q]; y[4 * q + 1] += w[1] * xv[4 * q + 1]; y[4 * q + 2] += w[2] * xv[4 * q + 2]; y[4 * q + 3] += w[3] * xv[4 * q + 3]; }
  }
#pragma unroll
  for (int c = 0; c < 16; ++c) y[c] = siluf_(y[c]);
}

DI void conv_fetch(const Params& p, const bf16_t* proj, int l, int ci, int hh, int cgp, int tok, u32x4 (&raw)[3][4][2]) {
#pragma unroll
  for (int o = 0; o < 4; ++o) {
    const int t = tok - 3 + o;
#pragma unroll
    for (int mat = 0; mat < 3; ++mat) {
      const int ch0 = mat * 1024 + hh * 128 + 16 * cgp;
      if (t >= 0 || (ci < 256 && (ci & 63) != 0)) {
        const bf16_t* src = proj + (size_t)(ci * 64 + t) * LDP + 4096 + ch0;
        raw[mat][o][0] = *(const u32x4*)src; raw[mat][o][1] = *(const u32x4*)(src + 8);
      } else if (ci >= 256) {
        const float* sc = p.state_conv + ((size_t)(l * 8 + (ci - 256)) * 3 + (3 + t)) * 3072 + ch0; float f[16];
#pragma unroll
        for (int q = 0; q < 4; ++q) { const f32x4 a = *(const f32x4*)(sc + 4 * q); f[4 * q] = a[0]; f[4 * q + 1] = a[1]; f[4 * q + 2] = a[2]; f[4 * q + 3] = a[3]; }
        raw[mat][o][0] = pack8(f); raw[mat][o][1] = pack8(f + 8);
      } else { raw[mat][o][0] = (u32x4){0u, 0u, 0u, 0u}; raw[mat][o][1] = (u32x4){0u, 0u, 0u, 0u}; }
    }
  }
}
DI void conv_apply(const float* sCW, int mat, int cgp, const u32x4 (&raw)[3][4][2], float (&y)[16]) {
#pragma unroll
  for (int c = 0; c < 16; ++c) y[c] = 0.f;
#pragma unroll
  for (int o = 0; o < 4; ++o) { float xv[16]; unpack8(raw[mat][o][0], xv); unpack8(raw[mat][o][1], xv + 8);
#pragma unroll
    for (int q = 0; q < 4; ++q) { const f32x4 w = *(const f32x4*)(sCW + (mat * 4 + o) * 128 + 16 * cgp + 4 * q);
      y[4 * q] += w[0] * xv[4 * q]; y[4 * q + 1] += w[1] * xv[4 * q + 1]; y[4 * q + 2] += w[2] * xv[4 * q + 2]; y[4 * q + 3] += w[3] * xv[4 * q + 3]; } }
#pragma unroll
  for (int c = 0; c < 16; ++c) y[c] = siluf_(y[c]);
}

DI void delta_pre(const Params& p, int l, int it, unsigned char* smem) {
  const int ci = it >> 3, hh = it & 7, tid = otid(), wid = tid >> 6, lane = tid & 63, fr = lane & 15, fq = lane >> 4;
  bf16_t* sKB = (bf16_t*)smem; bf16_t* sQB = (bf16_t*)(smem + 17408); float* sKF = (float*)(smem + 34816); float* sVF = (float*)(smem + 68608);
  float* sA = (float*)(smem + 102400); float* sGC = (float*)(smem + 118784); float* sBT = sGC + 64; float* sEG = sGC + 128; float* sR1 = sGC + 192;
  const bf16_t* proj = (const bf16_t*)(p.ws + OFF_PROJ); const float* side = (const float*)(p.ws + OFF_SIDE);
  bf16_t* m1 = (bf16_t*)(p.ws + OFF_M1);
  bf16_t* dW = m1 + 0 * M1_BLK + (size_t)it * 8192; bf16_t* dQ = m1 + 1 * M1_BLK + (size_t)it * 8192; bf16_t* dKT = m1 + 2 * M1_BLK + (size_t)it * 8192;
  bf16_t* dUT = m1 + 3 * M1_BLK + (size_t)it * 8192; bf16_t* dIN = m1 + 8 * M1_BLK + (size_t)it * 4096;
  if (wid == 0) {
    const int row = ci * 64 + lane;
    const float bl = side[(size_t)row * 16 + hh], al = side[(size_t)row * 16 + 8 + hh] + p.dt_bias[l * 8 + hh];
    const float sp = al > 20.f ? al : log1pf(__expf(al));
    float g = -__expf(p.a_log[l * 8 + hh]) * sp;
#pragma unroll
    for (int o = 1; o < 64; o <<= 1) { const float t = __shfl_up(g, o); if (lane >= o) g += t; }
    const float bt = sigmoidf_(bl), eg = __expf(g);
    sGC[lane] = g; sBT[lane] = bt; sEG[lane] = eg; sR1[lane] = bt * eg;
    if (lane == 63) ((float*)(p.ws + OFF_DG))[it] = eg;
  }
  { const int tok = tid >> 3, cgp = tid & 7; float y[16]; const float* sCW = (const float*)(smem + 122880);
    u32x4 raw[3][4][2]; conv_fetch(p, proj, l, ci, hh, cgp, tok, raw);
    conv_apply(sCW, 0, cgp, raw, y);
    { float ss = 0.f;
#pragma unroll
      for (int c = 0; c < 16; ++c) ss += y[c] * y[c];
      ss += __shfl_xor(ss, 1); ss += __shfl_xor(ss, 2); ss += __shfl_xor(ss, 4);
      const float rn = rsqrtf(ss + 1e-6f) * 0.08838834764831845f;
#pragma unroll
      for (int c = 0; c < 16; ++c) y[c] *= rn;
      *(u32x4*)(sQB + tok * 136 + 16 * cgp) = pack8(y); *(u32x4*)(sQB + tok * 136 + 16 * cgp + 8) = pack8(y + 8); }
    conv_apply(sCW, 1, cgp, raw, y);
    { float ss = 0.f;
#pragma unroll
      for (int c = 0; c < 16; ++c) ss += y[c] * y[c];
      ss += __shfl_xor(ss, 1); ss += __shfl_xor(ss, 2); ss += __shfl_xor(ss, 4);
      const float rn = rsqrtf(ss + 1e-6f);
#pragma unroll
      for (int c = 0; c < 16; ++c) { y[c] *= rn; sKF[tok * 132 + 16 * cgp + c] = y[c]; }
      *(u32x4*)(sKB + tok * 136 + 16 * cgp) = pack8(y); *(u32x4*)(sKB + tok * 136 + 16 * cgp + 8) = pack8(y + 8); }
    conv_apply(sCW, 2, cgp, raw, y);
#pragma unroll
    for (int c = 0; c < 16; ++c) sVF[tok * 132 + 16 * cgp + c] = y[c];
  }
  __syncthreads();
  {
    const int mt = wid & 3; const bf16_t* Asrc = (wid < 4) ? sKB : sQB;
    bf16x8 a[4];
#pragma unroll
    for (int s = 0; s < 4; ++s) a[s] = *(const bf16x8*)(Asrc + (16 * mt + fr) * 136 + 32 * s + 8 * fq);
#pragma unroll
    for (int nt = 0; nt < 4; ++nt) {
      f32x4 c = {0.f, 0.f, 0.f, 0.f};
#pragma unroll
      for (int s = 0; s < 4; ++s) { const bf16x8 b = *(const bf16x8*)(sKB + (16 * nt + fr) * 136 + 32 * s + 8 * fq); c = MFMA16(a[s], b, c); }
      const int j = 16 * nt + fr; const float gj = sGC[j];
#pragma unroll
      for (int r = 0; r < 4; ++r) { const int i = 16 * mt + 4 * fq + r; const float gi = sGC[i]; const float dec = __expf(fminf(gi - gj, 0.f));
        if (wid < 4) sA[i * 64 + j] = (i > j) ? sBT[i] * c[r] * dec : 0.f;
        else dIN[i * 64 + (j & 32) + kinv(j & 31)] = f2bf((i >= j) ? c[r] * dec : 0.f); }
    }
  }
  __syncthreads();
  if (wid < 4) {
    int zv = 0; asm volatile("" : "+v"(zv));
    const int c = tid; const float* src = (c < 128) ? sVF + c : sKF + (c - 128); const float* scl = ((c < 128) ? sBT : sR1) + zv; const float* sAz = sA + zv;
    f32x2 sp[32];
#pragma unroll
    for (int i = 0; i < 32; ++i) sp[i] = (f32x2){0.f, 0.f};
    f32x4 Bk[2][8]; float rs[2], rc[2];
    f32x2 a0 = {0.f, 0.f}, a1 = {0.f, 0.f};
    rs[0] = src[0]; rc[0] = scl[0];
#pragma unroll
    for (int t = 0; t < 95; ++t) {
      const int i = t < 33 ? t : 33 + ((t - 33) >> 1), part = t < 33 ? 0 : ((t - 33) & 1), n = (i + 3) / 4;
      const int j0 = part * 8, j1 = (part == 0) ? (n < 8 ? n : 8) : n;
      const bool last = (part == 1) || (n <= 8);
      if (t + 1 < 95) { const int t2 = t + 1, i2 = t2 < 33 ? t2 : 33 + ((t2 - 33) >> 1), p2 = t2 < 33 ? 0 : ((t2 - 33) & 1), n2 = (i2 + 3) / 4;
        const int k0 = p2 * 8, k1 = (p2 == 0) ? (n2 < 8 ? n2 : 8) : n2;
#pragma unroll
        for (int j4 = k0; j4 < k1; ++j4) Bk[t2 & 1][j4 - k0] = *(const f32x4*)(sAz + i2 * 64 + 4 * j4);
        if (p2 == 0) { rs[t2 & 1] = src[i2 * 132]; rc[t2 & 1] = scl[i2]; } }
      __builtin_amdgcn_sched_barrier(0);
      if (part == 0) { a0 = (f32x2){rs[t & 1] * rc[t & 1], 0.f}; a1 = (f32x2){0.f, 0.f}; }
#pragma unroll
      for (int j4 = j0; j4 < j1; ++j4) { const f32x4 a = Bk[t & 1][j4 - j0];
        a0 -= (f32x2){a[0], a[1]} * sp[2 * j4]; a1 -= (f32x2){a[2], a[3]} * sp[2 * j4 + 1]; }
      if (last) { const f32x2 tt = a0 + a1; sp[i >> 1][i & 1] = tt[0] + tt[1]; }
      __builtin_amdgcn_sched_barrier(0);
    }
    float sol[64];
#pragma unroll
    for (int i = 0; i < 64; ++i) sol[i] = sp[i >> 1][i & 1];
    if (c < 128) {
#pragma unroll
      for (int q = 0; q < 8; ++q) *(u32x4*)(dUT + c * 64 + 8 * q) = pack8(sol + 8 * q);
    } else { const int d = c - 128, pos = (d & ~31) + kinv(d & 31);
#pragma unroll
      for (int i = 0; i < 64; ++i) dW[i * 128 + pos] = f2bf(-sol[i]); }
  } else {
    const int t = tid - 256; const float gl = sGC[63];
    { const int tok = t >> 2, db = t & 3; const float eg = sEG[tok]; float v[32];
#pragma unroll
      for (int pp = 0; pp < 32; ++pp) v[pp] = bf2f(sQB[tok * 136 + 32 * db + kperm(pp)]) * eg;
#pragma unroll
      for (int q = 0; q < 4; ++q) *(u32x4*)(dQ + tok * 128 + 32 * db + 8 * q) = pack8(v + 8 * q); }
    { const int d = t >> 1, tb = t & 1; float v[32];
#pragma unroll
      for (int pp = 0; pp < 32; ++pp) { const int tok = 32 * tb + kperm(pp); v[pp] = sKF[tok * 132 + d] * __expf(gl - sGC[tok]); }
#pragma unroll
      for (int q = 0; q < 4; ++q) *(u32x4*)(dKT + d * 64 + 32 * tb + 8 * q) = pack8(v + 8 * q); }
  }
  __syncthreads();
}

DI void ret_pre(const Params& p, int l, int it, unsigned char* smem) {
  const int ci = it >> 3, hh = it & 7, tid = otid(), wid = tid >> 6, lane = tid & 63, fr = lane & 15, fq = lane >> 4;
  bf16_t* sQB = (bf16_t*)smem; bf16_t* sKB = (bf16_t*)(smem + 17408); float* sKZ = (float*)(smem + 34816); float* sVF = (float*)(smem + 68608);
  const bf16_t* proj = (const bf16_t*)(p.ws + OFF_PROJ);
  bf16_t* m1 = (bf16_t*)(p.ws + OFF_M1);
  bf16_t* rQ = m1 + 4 * M1_BLK + (size_t)it * 8192; bf16_t* rKT = m1 + 5 * M1_BLK + (size_t)it * 8192; bf16_t* rVT = m1 + 6 * M1_BLK + (size_t)it * 8192;
  bf16_t* rIN = m1 + 8 * M1_BLK + (size_t)NITEM * 4096 + (size_t)it * 4096;
  const float lg = __logf(1.f - exp2f(-5.f - (float)hh));
  { const int tok = tid >> 3, cgp = tid & 7; const bf16_t* rp = proj + (size_t)(ci * 64 + tok) * LDP;
    const int pos = (ci >= 256) ? 2048 + tok : (ci & 63) * 64 + tok;
    float q1[8], q2[8], k1[8], k2[8], vv[16];
    unpack8(*(const u32x4*)(rp + 8192 + hh * 128 + 8 * cgp), q1); unpack8(*(const u32x4*)(rp + 8192 + hh * 128 + 64 + 8 * cgp), q2);
    unpack8(*(const u32x4*)(rp + 9216 + hh * 128 + 8 * cgp), k1); unpack8(*(const u32x4*)(rp + 9216 + hh * 128 + 64 + 8 * cgp), k2);
    unpack8(*(const u32x4*)(rp + 10240 + hh * 128 + 16 * cgp), vv); unpack8(*(const u32x4*)(rp + 10240 + hh * 128 + 16 * cgp + 8), vv + 8);
    const float zeta = __expf(lg * (float)(63 - tok)) * 0.08838834764831845f;
    float qa[8], qb[8], ka[8], kb[8];
#pragma unroll
    for (int j = 0; j < 8; ++j) { const int i = 8 * cgp + j;
      const float inv = exp2f(-(float)i * (13.287712379549449f / 64.f)); const float ang = (float)pos * inv;
      float rv = ang * 0.15915494309189535f; rv = rv - floorf(rv);
      const float sn = __builtin_amdgcn_sinf(rv), cs = __builtin_amdgcn_cosf(rv);
      qa[j] = q1[j] * cs - q2[j] * sn; qb[j] = q1[j] * sn + q2[j] * cs;
      ka[j] = (k1[j] * cs - k2[j] * sn); kb[j] = (k1[j] * sn + k2[j] * cs);
      sKZ[tok * 132 + i] = ka[j] * zeta; sKZ[tok * 132 + 64 + i] = kb[j] * zeta;
      ka[j] *= 0.08838834764831845f; kb[j] *= 0.08838834764831845f; }
    *(u32x4*)(sQB + tok * 136 + 8 * cgp) = pack8(qa); *(u32x4*)(sQB + tok * 136 + 64 + 8 * cgp) = pack8(qb);
    *(u32x4*)(sKB + tok * 136 + 8 * cgp) = pack8(ka); *(u32x4*)(sKB + tok * 136 + 64 + 8 * cgp) = pack8(kb);
#pragma unroll
    for (int c = 0; c < 16; ++c) sVF[tok * 132 + 16 * cgp + c] = vv[c];
  }
  __syncthreads();
  { const int mt = wid >> 1;
    bf16x8 a[4];
#pragma unroll
    for (int s = 0; s < 4; ++s) a[s] = *(const bf16x8*)(sQB + (16 * mt + fr) * 136 + 32 * s + 8 * fq);
#pragma unroll
    for (int n2 = 0; n2 < 2; ++n2) { const int nt = 2 * (wid & 1) + n2;
      f32x4 c = {0.f, 0.f, 0.f, 0.f};
#pragma unroll
      for (int s = 0; s < 4; ++s) { const bf16x8 b = *(const bf16x8*)(sKB + (16 * nt + fr) * 136 + 32 * s + 8 * fq); c = MFMA16(a[s], b, c); }
      const int j = 16 * nt + fr;
#pragma unroll
      for (int r = 0; r < 4; ++r) { const int i = 16 * mt + 4 * fq + r;
        rIN[i * 64 + (j & 32) + kinv(j & 31)] = f2bf((i >= j) ? c[r] * __expf(lg * (float)(i - j)) : 0.f); }
    }
  }
  write_perm(rQ, [&](int tok, int d) { return bf2f(sQB[tok * 136 + d]) * __expf(lg * (float)(tok + 1)); });
  write_T_perm(rKT, [&](int tok, int d) { return sKZ[tok * 132 + d]; });
  write_T_perm(rVT, [&](int tok, int e) { return sVF[tok * 132 + e]; });
  __syncthreads();
}

DI void misc_item(const Params& p, int l, int it, unsigned char* smem) {
  const int ci = it >> 3, hh = it & 7, tid = otid();
  bf16_t* sVB = (bf16_t*)smem;
  const bf16_t* proj = (const bf16_t*)(p.ws + OFF_PROJ);
  bf16_t* aVT = (bf16_t*)(p.ws + OFF_M1) + 7 * M1_BLK + (size_t)it * 8192;
  { const int tok = tid >> 3, cgp = tid & 7; const bf16_t* rp = proj + (size_t)(ci * 64 + tok) * LDP;
    const u32x4 v0 = *(const u32x4*)(rp + 2048 + hh * 128 + 16 * cgp), v1 = *(const u32x4*)(rp + 2048 + hh * 128 + 16 * cgp + 8);
    *(u32x4*)(sVB + tok * 136 + 16 * cgp) = v0; *(u32x4*)(sVB + tok * 136 + 16 * cgp + 8) = v1;
    float* ok = nullptr; float* ov = nullptr;
    if (ci < 256) { const int b = ci >> 6, c = ci & 63;
      if (c >= 56) { const size_t o = ((((size_t)l * 4 + b) * 512 + (c - 56) * 64 + tok) * 8 + hh) * 128 + 16 * cgp; ok = p.out + O_PK + o; ov = p.out + O_PV + o; }
    } else { const size_t o = ((((size_t)l * 8 + (ci - 256)) * 512 + 448 + tok) * 8 + hh) * 128 + 16 * cgp; ok = p.out + O_SK + o; ov = p.out + O_SV + o; }
    if (ok) { float f[16]; unpack8(v0, f); unpack8(v1, f + 8);
#pragma unroll
      for (int q = 0; q < 4; ++q) *(f32x4*)(ov + 4 * q) = (f32x4){f[4 * q], f[4 * q + 1], f[4 * q + 2], f[4 * q + 3]};
      unpack8(*(const u32x4*)(rp + 1024 + hh * 128 + 16 * cgp), f); unpack8(*(const u32x4*)(rp + 1024 + hh * 128 + 16 * cgp + 8), f + 8);
#pragma unroll
      for (int q = 0; q < 4; ++q) *(f32x4*)(ok + 4 * q) = (f32x4){f[4 * q], f[4 * q + 1], f[4 * q + 2], f[4 * q + 3]}; }
  }
  if (ci >= 256 || (ci & 63) == 63) {
    float* oc = (ci < 256) ? p.out + O_PC + ((size_t)l * 4 + (ci >> 6)) * 3 * 3072 : p.out + O_SC + ((size_t)l * 8 + (ci - 256)) * 3 * 3072;
    for (int idx = tid; idx < 3 * 384; idx += 512) { const int rr = idx / 384, ch = hh * 384 + idx % 384;
      oc[rr * 3072 + ch] = bf2f(proj[(size_t)(ci * 64 + 61 + rr) * LDP + 4096 + ch]); }
  }
  __syncthreads();
  write_T_perm(aVT, [&](int tok, int e) { return bf2f(sVB[tok * 136 + e]); });
  __syncthreads();
}
DI void cache_item(const Params& p, int l, int cit, unsigned char* smem) {
  const int hh = cit & 7, j = (cit >> 3) & 7, sb = cit >> 6, tid = otid();
  float* sVF = (float*)smem;
  bf16_t* kc = (bf16_t*)(p.ws + OFF_KC) + (size_t)cit * 8192; bf16_t* cvt = (bf16_t*)(p.ws + OFF_CVT) + (size_t)cit * 8192;
  { const int key = tid >> 3, cgp = tid & 7;
    const size_t so = ((((size_t)l * 8 + sb) * 512 + 64 * j + key) * 8 + hh) * 128 + 16 * cgp;
    float fk[16], fv[16];
#pragma unroll
    for (int q = 0; q < 4; ++q) { const f32x4 a = *(const f32x4*)(p.cache_k + so + 4 * q); const f32x4 b = *(const f32x4*)(p.cache_v + so + 4 * q);
#pragma unroll
      for (int e = 0; e < 4; ++e) { fk[4 * q + e] = a[e]; fv[4 * q + e] = b[e]; } }
    *(u32x4*)(kc + key * 128 + 16 * cgp) = pack8(fk); *(u32x4*)(kc + key * 128 + 16 * cgp + 8) = pack8(fk + 8);
#pragma unroll
    for (int c = 0; c < 16; ++c) sVF[key * 132 + 16 * cgp + c] = fv[c];
    if (j >= 1) { const size_t oo = ((((size_t)l * 8 + sb) * 512 + 64 * (j - 1) + key) * 8 + hh) * 128 + 16 * cgp;
#pragma unroll
      for (int q = 0; q < 4; ++q) { *(f32x4*)(p.out + O_SK + oo + 4 * q) = (f32x4){fk[4 * q], fk[4 * q + 1], fk[4 * q + 2], fk[4 * q + 3]};
        *(f32x4*)(p.out + O_SV + oo + 4 * q) = (f32x4){fv[4 * q], fv[4 * q + 1], fv[4 * q + 2], fv[4 * q + 3]}; } }
  }
  __syncthreads();
  write_T_perm(cvt, [&](int tok, int e) { return sVF[tok * 132 + e]; });
  __syncthreads();
}

template <int TYPE> DI void scan_item(const Params& p, int l, int seq, int hh, int sl) {
  const int lane = otid() & 63, fr = lane & 15, fq = lane >> 4, e0 = 16 * sl;
  const int nsteps = seq < 4 ? 64 : 1, ci0 = seq < 4 ? seq * 64 : 256 + (seq - 4);
  const bf16_t* m1 = (const bf16_t*)(p.ws + OFF_M1);
  bf16_t* proj = (bf16_t*)(p.ws + OFF_PROJ);
  const float* dG = (const float*)(p.ws + OFF_DG);
  f32x4 S[8];
  if (seq < 4) {
#pragma unroll
    for (int t = 0; t < 8; ++t) S[t] = (f32x4){0.f, 0.f, 0.f, 0.f};
  } else { const float* st = (TYPE == 0 ? p.state_delta : p.state_ret) + (((size_t)l * 8 + (seq - 4)) * 8 + hh) * 16384 + e0 + fr;
#pragma unroll
    for (int t = 0; t < 8; ++t)
#pragma unroll
      for (int i = 0; i < 4; ++i) S[t][i] = st[(16 * t + 4 * fq + i) * 128]; }
  const float gret = __expf(64.f * __logf(1.f - exp2f(-5.f - (float)hh)));
  for (int n = 0; n < nsteps; ++n) {
    const int it = (ci0 + n) * 8 + hh;
    const bf16_t* W = m1 + 0 * M1_BLK + (size_t)it * 8192;
    const bf16_t* Q = m1 + (TYPE == 0 ? 1 : 4) * M1_BLK + (size_t)it * 8192;
    const bf16_t* KT = m1 + (TYPE == 0 ? 2 : 5) * M1_BLK + (size_t)it * 8192;
    const bf16_t* UT = m1 + (TYPE == 0 ? 3 : 6) * M1_BLK + (size_t)it * 8192;
    const bf16_t* IN = m1 + 8 * M1_BLK + (TYPE == 0 ? 0 : (size_t)NITEM * 4096) + (size_t)it * 4096;
    bf16x8 Sf[4];
#pragma unroll
    for (int s = 0; s < 4; ++s) Sf[s] = pack_frag(S[2 * s], S[2 * s + 1]);
    bf16x8 Vf[2];
    if (TYPE == 0) {
      f32x4 Vn[4];
#pragma unroll
      for (int mt = 0; mt < 4; ++mt) { const u32x2 u = *(const u32x2*)(UT + (e0 + fr) * 64 + 16 * mt + 4 * fq); Vn[mt] = (f32x4){bflo(u.x), bfhi(u.x), bflo(u.y), bfhi(u.y)}; }
#pragma unroll
      for (int s = 0; s < 4; ++s)
#pragma unroll
        for (int mt = 0; mt < 4; ++mt) { const bf16x8 a = *(const bf16x8*)(W + (16 * mt + fr) * 128 + 32 * s + 8 * fq); Vn[mt] = MFMA16(a, Sf[s], Vn[mt]); }
      Vf[0] = pack_frag(Vn[0], Vn[1]); Vf[1] = pack_frag(Vn[2], Vn[3]);
    } else {
      Vf[0] = *(const bf16x8*)(UT + (e0 + fr) * 64 + 8 * fq); Vf[1] = *(const bf16x8*)(UT + (e0 + fr) * 64 + 32 + 8 * fq);
    }
    f32x4 O[4];
#pragma unroll
    for (int nt = 0; nt < 4; ++nt) O[nt] = (f32x4){0.f, 0.f, 0.f, 0.f};
#pragma unroll
    for (int s = 0; s < 4; ++s)
#pragma unroll
      for (int nt = 0; nt < 4; ++nt) { const bf16x8 b = *(const bf16x8*)(Q + (16 * nt + fr) * 128 + 32 * s + 8 * fq); O[nt] = MFMA16(Sf[s], b, O[nt]); }
#pragma unroll
    for (int s2 = 0; s2 < 2; ++s2)
#pragma unroll
      for (int nt = 0; nt < 4; ++nt) { const bf16x8 b = *(const bf16x8*)(IN + (16 * nt + fr) * 64 + 32 * s2 + 8 * fq); O[nt] = MFMA16(Vf[s2], b, O[nt]); }
#pragma unroll
    for (int nt = 0; nt < 4; ++nt) { u32x2 w; w.x = pk2(O[nt][0], O[nt][1]); w.y = pk2(O[nt][2], O[nt][3]);
      *(u32x2*)(proj + (size_t)((ci0 + n) * 64 + 16 * nt + fr) * LDP + (TYPE == 0 ? C_OBRAW : C_OCRAW) + hh * 128 + e0 + 4 * fq) = w; }
    const float gb = (TYPE == 0) ? dG[it] : gret;
#pragma unroll
    for (int dt = 0; dt < 8; ++dt) { S[dt] = S[dt] * gb;
#pragma unroll
      for (int s2 = 0; s2 < 2; ++s2) { const bf16x8 a = *(const bf16x8*)(KT + (16 * dt + fr) * 64 + 32 * s2 + 8 * fq); S[dt] = MFMA16(a, Vf[s2], S[dt]); } }
  }
  { float* so = p.out + (seq < 4 ? (TYPE == 0 ? O_PD : O_PR) + (((size_t)l * 4 + seq) * 8 + hh) * 16384 : (TYPE == 0 ? O_SD : O_SR) + (((size_t)l * 8 + (seq - 4)) * 8 + hh) * 16384) + e0 + fr;
#pragma unroll
    for (int t = 0; t < 8; ++t)
#pragma unroll
      for (int i = 0; i < 4; ++i) so[(16 * t + 4 * fq + i) * 128] = S[t][i]; }
}

template <int TYPE> DI void scan_step(const unsigned char* B, f32x4 (&S)[8], const u32x4 (&uc)[2], float gb, bf16_t* orow, int fr, int fq) {
#define SW_A128(base_, row_, s_) (*(const bf16x8*)((base_) + (((row_) * 16 + ((4 * (s_) + fq) ^ fr)) * 16)))
#define SW_A64(base_, row_, s_) (*(const bf16x8*)((base_) + (((row_) * 8 + ((4 * (s_) + fq) ^ (fr >> 1))) * 16)))
  bf16x8 Sf[4];
#pragma unroll
  for (int s = 0; s < 4; ++s) Sf[s] = pack_frag(S[2 * s], S[2 * s + 1]);
  bf16x8 Vf[2];
  if (TYPE == 0) {
    f32x4 Vn[4];
#pragma unroll
    for (int mt = 0; mt < 4; ++mt) { const unsigned ux = uc[mt >> 1][(mt & 1) * 2], uy = uc[mt >> 1][(mt & 1) * 2 + 1]; Vn[mt] = (f32x4){bflo(ux), bfhi(ux), bflo(uy), bfhi(uy)}; }
#pragma unroll
    for (int s = 0; s < 4; ++s)
#pragma unroll
      for (int mt = 0; mt < 4; ++mt) Vn[mt] = MFMA16(SW_A128(B, 16 * mt + fr, s), Sf[s], Vn[mt]);
    Vf[0] = pack_frag(Vn[0], Vn[1]); Vf[1] = pack_frag(Vn[2], Vn[3]);
  } else { Vf[0] = __builtin_bit_cast(bf16x8, uc[0]); Vf[1] = __builtin_bit_cast(bf16x8, uc[1]); }
  f32x4 O[4];
#pragma unroll
  for (int nt = 0; nt < 4; ++nt) O[nt] = (f32x4){0.f, 0.f, 0.f, 0.f};
#pragma unroll
  for (int s = 0; s < 4; ++s)
#pragma unroll
    for (int nt = 0; nt < 4; ++nt) O[nt] = MFMA16(Sf[s], SW_A128(B + 16384, 16 * nt + fr, s), O[nt]);
#pragma unroll
  for (int s2 = 0; s2 < 2; ++s2)
#pragma unroll
    for (int nt = 0; nt < 4; ++nt) O[nt] = MFMA16(Vf[s2], SW_A64(B + 49152, 16 * nt + fr, s2), O[nt]);
#pragma unroll
  for (int nt = 0; nt < 4; ++nt) { u32x2 w; w.x = pk2(O[nt][0], O[nt][1]); w.y = pk2(O[nt][2], O[nt][3]); *(u32x2*)(orow + (size_t)(16 * nt) * LDP) = w; }
#pragma unroll
  for (int dt = 0; dt < 8; ++dt) { S[dt] = S[dt] * gb;
#pragma unroll
    for (int s2 = 0; s2 < 2; ++s2) S[dt] = MFMA16(SW_A64(B + 32768, 16 * dt + fr, s2), Vf[s2], S[dt]); }
#undef SW_A128
#undef SW_A64
}
template <int TYPE> DI void scan_wg(const Params& p, int l, int seq, int hh, unsigned char* smem) {
  const int tid = otid(), lane = tid & 63, wv = tid >> 6, fr = lane & 15, fq = lane >> 4, e0 = 16 * wv;
  const int ci0 = seq * 64;
  const bf16_t* m1 = (const bf16_t*)(p.ws + OFF_M1);
  bf16_t* proj = (bf16_t*)(p.ws + OFF_PROJ);
  const float* dG = (const float*)(p.ws + OFF_DG);
  const bf16_t* gW = m1 + 0 * M1_BLK; const bf16_t* gQ = m1 + (TYPE == 0 ? 1 : 4) * M1_BLK; const bf16_t* gKT = m1 + (TYPE == 0 ? 2 : 5) * M1_BLK;
  const bf16_t* gUT = m1 + (TYPE == 0 ? 3 : 6) * M1_BLK; const bf16_t* gIN = m1 + 8 * M1_BLK + (TYPE == 0 ? 0 : (size_t)NITEM * 4096);
  f32x4 S[8];
#pragma unroll
  for (int t = 0; t < 8; ++t) S[t] = (f32x4){0.f, 0.f, 0.f, 0.f};
  const float gvec = (TYPE == 0) ? dG[(ci0 + lane) * 8 + hh] : __expf(64.f * __logf(1.f - exp2f(-5.f - (float)hh)));
  int d128[2], d64[2];
#pragma unroll
  for (int k = 0; k < 2; ++k) { const int q = tid + 512 * k; { const int r = q >> 4, c = q & 15; d128[k] = (r * 16 + (c ^ (r & 15))) * 16; }
    { const int r = q >> 3, c = q & 7; d64[k] = (r * 8 + (c ^ ((r >> 1) & 7))) * 16; } }
  u32x4 st[2][7]; u32x4 uv[2][2];
#define SW_ISSUE(n_, X_) do { const size_t it_ = (size_t)((ci0 + (n_)) * 8 + hh); \
    if (TYPE == 0) { st[X_][0] = *(const u32x4*)(gW + it_ * 8192 + tid * 8); st[X_][1] = *(const u32x4*)(gW + it_ * 8192 + (tid + 512) * 8); } \
    st[X_][2] = *(const u32x4*)(gQ + it_ * 8192 + tid * 8); st[X_][3] = *(const u32x4*)(gQ + it_ * 8192 + (tid + 512) * 8); \
    st[X_][4] = *(const u32x4*)(gKT + it_ * 8192 + tid * 8); st[X_][5] = *(const u32x4*)(gKT + it_ * 8192 + (tid + 512) * 8); \
    st[X_][6] = *(const u32x4*)(gIN + it_ * 4096 + tid * 8); \
    if (TYPE == 0) { _Pragma("unroll") for (int mt = 0; mt < 4; ++mt) { const u32x2 u_ = *(const u32x2*)(gUT + it_ * 8192 + (e0 + fr) * 64 + 16 * mt + 4 * fq); uv[X_][mt >> 1][(mt & 1) * 2] = u_.x; uv[X_][mt >> 1][(mt & 1) * 2 + 1] = u_.y; } } \
    else { uv[X_][0] = *(const u32x4*)(gUT + it_ * 8192 + (e0 + fr) * 64 + 8 * fq); uv[X_][1] = *(const u32x4*)(gUT + it_ * 8192 + (e0 + fr) * 64 + 32 + 8 * fq); } } while (0)
#define SW_COMMIT(b_, X_) do { unsigned char* B_ = smem + (b_) * 57344; \
    if (TYPE == 0) { *(u32x4*)(B_ + d128[0]) = st[X_][0]; *(u32x4*)(B_ + d128[1]) = st[X_][1]; } \
    *(u32x4*)(B_ + 16384 + d128[0]) = st[X_][2]; *(u32x4*)(B_ + 16384 + d128[1]) = st[X_][3]; \
    *(u32x4*)(B_ + 32768 + d64[0]) = st[X_][4]; *(u32x4*)(B_ + 32768 + d64[1]) = st[X_][5]; *(u32x4*)(B_ + 49152 + d64[0]) = st[X_][6]; \
    ucur[0] = uv[X_][0]; ucur[1] = uv[X_][1]; } while (0)
  u32x4 ucur[2];
  bf16_t* obase = proj + (size_t)(ci0 * 64 + fr) * LDP + (TYPE == 0 ? C_OBRAW : C_OCRAW) + hh * 128 + e0 + 4 * fq;
  SW_ISSUE(0, 0);
  SW_COMMIT(0, 0);
  SW_ISSUE(1, 1);
  __syncthreads();
  for (int n = 0; n < 64; n += 2) {
    if (n + 2 < 64) SW_ISSUE(n + 2, 0);
    scan_step<TYPE>(smem, S, ucur, __shfl(gvec, n), obase + (size_t)(n * 64) * LDP, fr, fq);
    SW_COMMIT(1, 1);
    __syncthreads();
    if (n + 3 < 64) SW_ISSUE(n + 3, 1);
    scan_step<TYPE>(smem + 57344, S, ucur, __shfl(gvec, n + 1), obase + (size_t)((n + 1) * 64) * LDP, fr, fq);
    if (n + 2 < 64) SW_COMMIT(0, 0);
    __syncthreads();
  }
#undef SW_ISSUE
#undef SW_COMMIT
  { float* so = p.out + (TYPE == 0 ? O_PD : O_PR) + (((size_t)l * 4 + seq) * 8 + hh) * 16384 + e0 + fr;
#pragma unroll
    for (int t = 0; t < 8; ++t)
#pragma unroll
      for (int i = 0; i < 4; ++i) so[(16 * t + 4 * fq + i) * 128] = S[t][i]; }
}

template <int TYPE> DI void scan_step2(const unsigned char* B, f32x4 (&S)[2][8], const u32x4 (&uc)[2][2], float gb, bf16_t* orow, int fr, int fq) {
#define SW_A128(base_, row_, s_) (*(const bf16x8*)((base_) + (((row_) * 16 + ((4 * (s_) + fq) ^ fr)) * 16)))
#define SW_A64(base_, row_, s_) (*(const bf16x8*)((base_) + (((row_) * 8 + ((4 * (s_) + fq) ^ (fr >> 1))) * 16)))
  bf16x8 Sf[2][4];
#pragma unroll
  for (int c = 0; c < 2; ++c)
#pragma unroll
    for (int s = 0; s < 4; ++s) Sf[c][s] = pack_frag(S[c][2 * s], S[c][2 * s + 1]);
  bf16x8 Vf[2][2];
  if (TYPE == 0) {
    f32x4 Vn[2][4];
#pragma unroll
    for (int c = 0; c < 2; ++c)
#pragma unroll
      for (int mt = 0; mt < 4; ++mt) { const unsigned ux = uc[c][mt >> 1][(mt & 1) * 2], uy = uc[c][mt >> 1][(mt & 1) * 2 + 1]; Vn[c][mt] = (f32x4){bflo(ux), bfhi(ux), bflo(uy), bfhi(uy)}; }
#pragma unroll
    for (int s = 0; s < 4; ++s)
#pragma unroll
      for (int mt = 0; mt < 4; ++mt) { const bf16x8 a = SW_A128(B, 16 * mt + fr, s); Vn[0][mt] = MFMA16(a, Sf[0][s], Vn[0][mt]); Vn[1][mt] = MFMA16(a, Sf[1][s], Vn[1][mt]); }
#pragma unroll
    for (int c = 0; c < 2; ++c) { Vf[c][0] = pack_frag(Vn[c][0], Vn[c][1]); Vf[c][1] = pack_frag(Vn[c][2], Vn[c][3]); }
  } else {
#pragma unroll
    for (int c = 0; c < 2; ++c) { Vf[c][0] = __builtin_bit_cast(bf16x8, uc[c][0]); Vf[c][1] = __builtin_bit_cast(bf16x8, uc[c][1]); }
  }
  f32x4 O[2][4];
#pragma unroll
  for (int c = 0; c < 2; ++c)
#pragma unroll
    for (int nt = 0; nt < 4; ++nt) O[c][nt] = (f32x4){0.f, 0.f, 0.f, 0.f};
#pragma unroll
  for (int s = 0; s < 4; ++s)
#pragma unroll
    for (int nt = 0; nt < 4; ++nt) { const bf16x8 b = SW_A128(B + 16384, 16 * nt + fr, s); O[0][nt] = MFMA16(Sf[0][s], b, O[0][nt]); O[1][nt] = MFMA16(Sf[1][s], b, O[1][nt]); }
#pragma unroll
  for (int s2 = 0; s2 < 2; ++s2)
#pragma unroll
    for (int nt = 0; nt < 4; ++nt) { const bf16x8 b = SW_A64(B + 49152, 16 * nt + fr, s2); O[0][nt] = MFMA16(Vf[0][s2], b, O[0][nt]); O[1][nt] = MFMA16(Vf[1][s2], b, O[1][nt]); }
#pragma unroll
  for (int c = 0; c < 2; ++c)
#pragma unroll
    for (int nt = 0; nt < 4; ++nt) { u32x2 w; w.x = pk2(O[c][nt][0], O[c][nt][1]); w.y = pk2(O[c][nt][2], O[c][nt][3]); *(u32x2*)(orow + (size_t)(16 * nt) * LDP + 16 * c) = w; }
#pragma unroll
  for (int dt = 0; dt < 8; ++dt) { S[0][dt] = S[0][dt] * gb; S[1][dt] = S[1][dt] * gb;
#pragma unroll
    for (int s2 = 0; s2 < 2; ++s2) { const bf16x8 a = SW_A64(B + 32768, 16 * dt + fr, s2); S[0][dt] = MFMA16(a, Vf[0][s2], S[0][dt]); S[1][dt] = MFMA16(a, Vf[1][s2], S[1][dt]); } }
#undef SW_A128
#undef SW_A64
}
template <int TYPE> DI void scan_wg2(const Params& p, int l, int seq, int hh, unsigned char* smem) {
  const int tid = otid(), lane = tid & 63, wv = tid >> 6, fr = lane & 15, fq = lane >> 4;
  const int ci0 = seq * 64;
  const bf16_t* m1 = (const bf16_t*)(p.ws + OFF_M1);
  const bf16_t* gW = m1 + 0 * M1_BLK; const bf16_t* gQ = m1 + (TYPE == 0 ? 1 : 4) * M1_BLK; const bf16_t* gKT = m1 + (TYPE == 0 ? 2 : 5) * M1_BLK;
  const bf16_t* gUT = m1 + (TYPE == 0 ? 3 : 6) * M1_BLK; const bf16_t* gIN = m1 + 8 * M1_BLK + (TYPE == 0 ? 0 : (size_t)NITEM * 4096);
  if (wv >= 4) {
    const int lt = tid - 256;
    const int b128 = ((lt >> 4) * 16 + ((lt & 15) ^ ((lt >> 4) & 15))) * 16, b64 = ((lt >> 3) * 8 + ((lt & 7) ^ ((lt >> 4) & 7))) * 16;
    u32x4 st[2][14];
#define LW_ISSUE(n_, X_) do { const size_t it_ = (size_t)((ci0 + (n_)) * 8 + hh); \
      _Pragma("unroll") for (int k = 0; k < 4; ++k) { if (TYPE == 0) st[X_][k] = *(const u32x4*)(gW + it_ * 8192 + (lt + 256 * k) * 8); \
        st[X_][4 + k] = *(const u32x4*)(gQ + it_ * 8192 + (lt + 256 * k) * 8); st[X_][8 + k] = *(const u32x4*)(gKT + it_ * 8192 + (lt + 256 * k) * 8); } \
      st[X_][12] = *(const u32x4*)(gIN + it_ * 4096 + lt * 8); st[X_][13] = *(const u32x4*)(gIN + it_ * 4096 + (lt + 256) * 8); } while (0)
#define LW_COMMIT(b_, X_) do { unsigned char* B_ = smem + (b_) * 57344; \
      _Pragma("unroll") for (int k = 0; k < 4; ++k) { if (TYPE == 0) *(u32x4*)(B_ + b128 + k * 4096) = st[X_][k]; \
        *(u32x4*)(B_ + 16384 + b128 + k * 4096) = st[X_][4 + k]; *(u32x4*)(B_ + 32768 + b64 + k * 4096) = st[X_][8 + k]; } \
      *(u32x4*)(B_ + 49152 + b64) = st[X_][12]; *(u32x4*)(B_ + 49152 + b64 + 4096) = st[X_][13]; } while (0)
    LW_ISSUE(0, 0); LW_COMMIT(0, 0); LW_ISSUE(1, 1);
    __syncthreads();
    for (int n = 0; n < 64; n += 2) {
      if (n + 2 < 64) LW_ISSUE(n + 2, 0);
      LW_COMMIT(1, 1);
      __syncthreads();
      if (n + 3 < 64) LW_ISSUE(n + 3, 1);
      if (n + 2 < 64) LW_COMMIT(0, 0);
      __syncthreads();
    }
#undef LW_ISSUE
#undef LW_COMMIT
  } else {
    const int e0 = 32 * wv;
    bf16_t* proj = (bf16_t*)(p.ws + OFF_PROJ);
    const float* dG = (const float*)(p.ws + OFF_DG);
    f32x4 S[2][8];
#pragma unroll
    for (int c = 0; c < 2; ++c)
#pragma unroll
      for (int t = 0; t < 8; ++t) S[c][t] = (f32x4){0.f, 0.f, 0.f, 0.f};
    const float gvec = (TYPE == 0) ? dG[(ci0 + lane) * 8 + hh] : __expf(64.f * __logf(1.f - exp2f(-5.f - (float)hh)));
    u32x4 ucur[2][2], unext[2][2];
#define CW_ULOAD(n_, dst_) do { const size_t it_ = (size_t)((ci0 + (n_)) * 8 + hh); _Pragma("unroll") for (int c = 0; c < 2; ++c) { \
      if (TYPE == 0) { _Pragma("unroll") for (int mt = 0; mt < 4; ++mt) { const u32x2 u_ = *(const u32x2*)(gUT + it_ * 8192 + (e0 + 16 * c + fr) * 64 + 16 * mt + 4 * fq); dst_[c][mt >> 1][(mt & 1) * 2] = u_.x; dst_[c][mt >> 1][(mt & 1) * 2 + 1] = u_.y; } } \
      else { dst_[c][0] = *(const u32x4*)(gUT + it_ * 8192 + (e0 + 16 * c + fr) * 64 + 8 * fq); dst_[c][1] = *(const u32x4*)(gUT + it_ * 8192 + (e0 + 16 * c + fr) * 64 + 32 + 8 * fq); } } } while (0)
    bf16_t* obase = proj + (size_t)(ci0 * 64 + fr) * LDP + (TYPE == 0 ? C_OBRAW : C_OCRAW) + hh * 128 + e0 + 4 * fq;
    CW_ULOAD(0, ucur);
    __syncthreads();
    for (int n = 0; n < 64; ++n) {
      if (n + 1 < 64) CW_ULOAD(n + 1, unext);
      scan_step2<TYPE>(smem + (n & 1) * 57344, S, ucur, __shfl(gvec, n), obase + (size_t)(n * 64) * LDP, fr, fq);
#pragma unroll
      for (int c = 0; c < 2; ++c) { ucur[c][0] = unext[c][0]; ucur[c][1] = unext[c][1]; }
      __syncthreads();
    }
#undef CW_ULOAD
    { float* so = p.out + (TYPE == 0 ? O_PD : O_PR) + (((size_t)l * 4 + seq) * 8 + hh) * 16384 + e0 + fr;
#pragma unroll
      for (int c = 0; c < 2; ++c)
#pragma unroll
        for (int t = 0; t < 8; ++t)
#pragma unroll
          for (int i = 0; i < 4; ++i) so[(16 * t + 4 * fq + i) * 128 + 16 * c] = S[c][t][i]; }
  }
}

DI void attn_item(const Params& p, int l, int ai) {
  const int qt = ai & 3, hh = (ai >> 2) & 7, ci = ai >> 5;
  const int lane = otid() & 63, fr = lane & 15, fq = lane >> 4;
  bf16_t* proj = (bf16_t*)(p.ws + OFF_PROJ);
  const bf16_t* aVT = (const bf16_t*)(p.ws + OFF_M1) + 7 * M1_BLK;
  const bf16_t* kcb = (const bf16_t*)(p.ws + OFF_KC); const bf16_t* cvt = (const bf16_t*)(p.ws + OFF_CVT);
  const float* rb = p.rel_bias + ((size_t)l * 8 + hh) * 257;
  const int qrow = ci * 64 + 16 * qt + fr;
  bf16x8 Qf[4];
#pragma unroll
  for (int s = 0; s < 4; ++s) Qf[s] = *(const bf16x8*)(proj + (size_t)qrow * LDP + hh * 128 + 32 * s + 8 * fq);
  const int jmin = (ci < 256) ? ((ci & 63) >= 8 ? 0 : 8 - (ci & 63)) : 0;
  const float bfar = rb[256]; const int iq = 16 * qt + fr;
  float m = -1e30f, lsum = 0.f;
  f32x4 O[8];
#pragma unroll
  for (int et = 0; et < 8; ++et) O[et] = (f32x4){0.f, 0.f, 0.f, 0.f};
#pragma unroll 1
  for (int grp = 0; grp < 3; ++grp) {
    if (3 * grp + 2 < jmin) continue;
    f32x4 sc[12]; float gmx = -1e30f;
#pragma unroll
    for (int jj = 0; jj < 3; ++jj) { const int j = 3 * grp + jj;
      if (j >= jmin) {
        const bf16_t* Kp; int ks;
        if (ci < 256 || j == 8) { Kp = proj + (size_t)((ci < 256 ? ci - 8 + j : ci) * 64) * LDP + 1024 + hh * 128; ks = LDP; }
        else { Kp = kcb + (size_t)(((ci - 256) * 8 + j) * 8 + hh) * 8192; ks = 128; }
#pragma unroll
        for (int kt = 0; kt < 4; ++kt) {
          f32x4 c = {0.f, 0.f, 0.f, 0.f};
#pragma unroll
          for (int s = 0; s < 4; ++s) { const bf16x8 a = *(const bf16x8*)(Kp + (size_t)(16 * kt + fr) * ks + 32 * s + 8 * fq); c = MFMA16(a, Qf[s], c); }
#pragma unroll
          for (int i = 0; i < 4; ++i) { float bias = bfar;
            if (grp == 2) { const int r = 64 * j + 16 * kt + 4 * fq + i; int dist = 512 + iq - r; dist = dist < -128 ? -128 : (dist > 128 ? 128 : dist); bias = rb[dist + 128]; }
            c[i] = c[i] * 0.08838834764831845f + bias; gmx = fmaxf(gmx, c[i]); }
          sc[4 * jj + kt] = c;
        }
      } else {
#pragma unroll
        for (int kt = 0; kt < 4; ++kt) sc[4 * jj + kt] = (f32x4){-1e30f, -1e30f, -1e30f, -1e30f};
      }
    }
    gmx = fmaxf(gmx, __shfl_xor(gmx, 16)); gmx = fmaxf(gmx, __shfl_xor(gmx, 32));
    const float mnew = fmaxf(m, gmx), alpha = __expf(m - mnew); m = mnew;
    lsum *= alpha;
#pragma unroll
    for (int et = 0; et < 8; ++et) O[et] = O[et] * alpha;
#pragma unroll
    for (int t = 0; t < 12; ++t)
#pragma unroll
      for (int i = 0; i < 4; ++i) { const float e = __expf(sc[t][i] - m); sc[t][i] = e; lsum += e; }
#pragma unroll
    for (int jj = 0; jj < 3; ++jj) { const int j = 3 * grp + jj;
      if (j >= jmin) {
        const bf16_t* Vp;
        if (ci < 256 || j == 8) Vp = aVT + (size_t)((ci < 256 ? ci - 8 + j : ci) * 8 + hh) * 8192;
        else Vp = cvt + (size_t)(((ci - 256) * 8 + j) * 8 + hh) * 8192;
#pragma unroll
        for (int s2 = 0; s2 < 2; ++s2) { const bf16x8 pf = pack_frag(sc[4 * jj + 2 * s2], sc[4 * jj + 2 * s2 + 1]);
#pragma unroll
          for (int et = 0; et < 8; ++et) { const bf16x8 a = *(const bf16x8*)(Vp + (16 * et + fr) * 64 + 32 * s2 + 8 * fq); O[et] = MFMA16(a, pf, O[et]); } }
      }
    }
  }
  lsum += __shfl_xor(lsum, 16); lsum += __shfl_xor(lsum, 32);
  const float inv = 1.f / lsum;
#pragma unroll
  for (int et = 0; et < 8; ++et) { const u32x2 z = *(const u32x2*)(proj + (size_t)qrow * LDP + 3072 + hh * 128 + 16 * et + 4 * fq);
    u32x2 w; w.x = pk2(O[et][0] * inv * siluf_(bflo(z.x)), O[et][1] * inv * siluf_(bfhi(z.x))); w.y = pk2(O[et][2] * inv * siluf_(bflo(z.y)), O[et][3] * inv * siluf_(bfhi(z.y)));
    *(u32x2*)(proj + (size_t)qrow * LDP + C_ACAT + hh * 128 + 16 * et + 4 * fq) = w; }
}

DI void attn_stage(const unsigned char* Kl, const float* sB, int j, int iq, float bfar, const bf16x8 (&Qf)[4], f32x4 (&O)[8], float& m, float& lsum, int fr, int fq) {
#define AW_A128(base_, row_, s_) (*(const bf16x8*)((base_) + (((row_) * 16 + ((4 * (s_) + fq) ^ fr)) * 16)))
#define AW_A64(base_, row_, s_) (*(const bf16x8*)((base_) + (((row_) * 8 + ((4 * (s_) + fq) ^ (fr >> 1))) * 16)))
  const unsigned char* Vl = Kl + 32768;
  f32x4 sc[4]; float gmx = -1e30f;
#pragma unroll
  for (int kt = 0; kt < 4; ++kt) {
    f32x4 c = {0.f, 0.f, 0.f, 0.f};
#pragma unroll
    for (int s = 0; s < 4; ++s) c = MFMA16(AW_A128(Kl, 16 * kt + fr, s), Qf[s], c);
#pragma unroll
    for (int i = 0; i < 4; ++i) { float bias = bfar;
      if (j >= 6) { const int r = 64 * j + 16 * kt + 4 * fq + i; int dist = 512 + iq - r; dist = dist < -128 ? -128 : (dist > 128 ? 128 : dist); bias = sB[dist + 128]; }
      c[i] = c[i] * 0.08838834764831845f + bias; gmx = fmaxf(gmx, c[i]); }
    sc[kt] = c;
  }
  gmx = fmaxf(gmx, __shfl_xor(gmx, 16)); gmx = fmaxf(gmx, __shfl_xor(gmx, 32));
  const float mnew = fmaxf(m, gmx), alpha = __expf(m - mnew); m = mnew;
  lsum *= alpha;
#pragma unroll
  for (int et = 0; et < 8; ++et) O[et] = O[et] * alpha;
#pragma unroll
  for (int kt = 0; kt < 4; ++kt)
#pragma unroll
    for (int i = 0; i < 4; ++i) { const float e = __expf(sc[kt][i] - m); sc[kt][i] = e; lsum += e; }
#pragma unroll
  for (int s2 = 0; s2 < 2; ++s2) { const bf16x8 pf = pack_frag(sc[2 * s2], sc[2 * s2 + 1]);
#pragma unroll
    for (int et = 0; et < 8; ++et) O[et] = MFMA16(AW_A64(Vl, 16 * et + fr, s2), pf, O[et]); }
#undef AW_A128
#undef AW_A64
}
DI void attn_wg(const Params& p, int l, int wi, unsigned char* smem) {
  const int tid = otid(), lane = tid & 63, wv = tid >> 6, fr = lane & 15, fq = lane >> 4;
  const int ci = wi >> 2, hp = wi & 3, hsel = wv >> 2, hh = 2 * hp + hsel, qt = wv & 3;
  bf16_t* proj = (bf16_t*)(p.ws + OFF_PROJ);
  const bf16_t* aVT = (const bf16_t*)(p.ws + OFF_M1) + 7 * M1_BLK;
  const bf16_t* kcb = (const bf16_t*)(p.ws + OFF_KC); const bf16_t* cvt = (const bf16_t*)(p.ws + OFF_CVT);
  const float* rb = p.rel_bias + ((size_t)l * 8 + 2 * hp) * 257;
  float* sBias = (float*)(smem + 131072 + 256);
  const int qrow = ci * 64 + 16 * qt + fr;
  bf16x8 Qf[4];
#pragma unroll
  for (int s = 0; s < 4; ++s) Qf[s] = *(const bf16x8*)(proj + (size_t)qrow * LDP + hh * 128 + 32 * s + 8 * fq);
  const int jmin = (ci < 256) ? ((ci & 63) >= 8 ? 0 : 8 - (ci & 63)) : 0;
  const float bfar = rb[hsel * 257 + 256]; const int iq = 16 * qt + fr;
  const int row0 = tid >> 4, kcol = tid & 15;
  const int dKb = (row0 * 16 + (kcol ^ (row0 & 15))) * 16, dVb = 32768 + ((tid >> 3) * 8 + ((tid & 7) ^ ((tid >> 4) & 7))) * 16;
  u32x4 st[2][8];
#define AW_ISSUE(j_, X_) do { const bf16_t* Kb_; const bf16_t* Vb_; int ks_; size_t khs_; \
    if (ci < 256 || (j_) == 8) { const int cj_ = (ci < 256) ? ci - 8 + (j_) : ci; Kb_ = proj + (size_t)(cj_ * 64) * LDP + 1024 + 2 * hp * 128; ks_ = LDP; khs_ = 128; Vb_ = aVT + (size_t)(cj_ * 8 + 2 * hp) * 8192; } \
    else { const size_t o_ = (size_t)(((ci - 256) * 8 + (j_)) * 8 + 2 * hp) * 8192; Kb_ = kcb + o_; ks_ = 128; khs_ = 8192; Vb_ = cvt + o_; } \
    const bf16_t* kp_ = Kb_ + (size_t)row0 * ks_ + kcol * 8; \
    _Pragma("unroll") for (int k = 0; k < 4; ++k) { st[X_][k] = *(const u32x4*)(kp_ + (k >> 1) * khs_ + (size_t)(32 * (k & 1)) * ks_); st[X_][4 + k] = *(const u32x4*)(Vb_ + (size_t)(tid + 512 * k) * 8); } } while (0)
#define AW_COMMIT(b_, X_) do { unsigned char* B_ = smem + (b_) * 65536; _Pragma("unroll") for (int k = 0; k < 4; ++k) { \
    *(u32x4*)(B_ + dKb + (k >> 1) * 16384 + (k & 1) * 8192) = st[X_][k]; *(u32x4*)(B_ + dVb + (k >> 1) * 16384 + (k & 1) * 8192) = st[X_][4 + k]; } } while (0)
  float m = -1e30f, lsum = 0.f;
  f32x4 O[8];
#pragma unroll
  for (int et = 0; et < 8; ++et) O[et] = (f32x4){0.f, 0.f, 0.f, 0.f};
  AW_ISSUE(jmin, 0);
  if (tid < 257) { sBias[tid] = rb[tid]; sBias[260 + tid] = rb[257 + tid]; }
  AW_COMMIT(0, 0);
  if (jmin + 1 < 9) AW_ISSUE(jmin + 1, 1);
  __syncthreads();
  const float* sB = sBias + hsel * 260;
  for (int j = jmin; j < 9; j += 2) {
    if (j + 2 < 9) AW_ISSUE(j + 2, 0);
    attn_stage(smem + hsel * 16384, sB, j, iq, bfar, Qf, O, m, lsum, fr, fq);
    if (j + 1 < 9) AW_COMMIT(1, 1);
    __syncthreads();
    if (j + 1 >= 9) break;
    if (j + 3 < 9) AW_ISSUE(j + 3, 1);
    attn_stage(smem + 65536 + hsel * 16384, sB, j + 1, iq, bfar, Qf, O, m, lsum, fr, fq);
    if (j + 2 < 9) AW_COMMIT(0, 0);
    __syncthreads();
  }
#undef AW_ISSUE
#undef AW_COMMIT
  lsum += __shfl_xor(lsum, 16); lsum += __shfl_xor(lsum, 32);
  const float inv = 1.f / lsum;
#pragma unroll
  for (int et = 0; et < 8; ++et) { const u32x2 z = *(const u32x2*)(proj + (size_t)qrow * LDP + 3072 + hh * 128 + 16 * et + 4 * fq);
    u32x2 w; w.x = pk2(O[et][0] * inv * siluf_(bflo(z.x)), O[et][1] * inv * siluf_(bfhi(z.x))); w.y = pk2(O[et][2] * inv * siluf_(bflo(z.y)), O[et][3] * inv * siluf_(bfhi(z.y)));
    *(u32x2*)(proj + (size_t)qrow * LDP + C_ACAT + hh * 128 + 16 * et + 4 * fq) = w; }
}

DI void m2_phase(const Params& p, int l, int rep, unsigned char* smem) {
  const int tid_ = otid(); const int wv = tid_ >> 6;
  if (oblk() < 64) {
    const int chain = oblk(), ty = chain >> 5, sq = (chain & 31) >> 3, hh = chain & 7;
    for (int r3 = 0; r3 < R_SW; ++r3) { if (ty == 0) scan_wg2<0>(p, l, sq, hh, smem); else scan_wg2<1>(p, l, sq, hh, smem); }
  } else {
    for (int idx = (oblk() - 64) * 8 + wv; idx < 1024; idx += (gridDim.x - 64) * 8) {
      const int ty = idx >> 9, r = idx & 511, sq = 4 + (r >> 6), hh = (r >> 3) & 7, sl = r & 7;
      if (ty == 0) scan_item<0>(p, l, sq, hh, sl); else scan_item<1>(p, l, sq, hh, sl); }
  }
  unsigned* cnt = (unsigned*)(p.ws + OFF_CNT) + 64 * (l * 2 + rep);
  for (;;) {
    __syncthreads();
    if (tid_ == 0) *(volatile unsigned*)(smem + 131072) = atomicAdd(cnt, 1u);
    __syncthreads();
    const unsigned idx = *(volatile unsigned*)(smem + 131072);
    if (idx >= 1056u) break;
    for (int r2 = 0; r2 < R_AT; ++r2) attn_wg(p, l, (int)idx, smem);
  }
}

DI void m3_phase(const Params& p, int l) {
  bf16_t* proj = (bf16_t*)(p.ws + OFF_PROJ);
  const int tid_ = otid(); const int lane = tid_ & 63, gw = oblk() * 8 + (tid_ >> 6), nw = gridDim.x * 8;
  for (int wi = gw; wi < 2 * MROWS; wi += nw) {
    const int r = wi >> 1, br = wi & 1; bf16_t* rp = proj + (size_t)r * LDP;
    float v[16], z[16];
    unpack8(*(const u32x4*)(rp + (br ? C_OCRAW : C_OBRAW) + 16 * lane), v); unpack8(*(const u32x4*)(rp + (br ? C_OCRAW : C_OBRAW) + 16 * lane + 8), v + 8);
    unpack8(*(const u32x4*)(rp + (br ? 11264 : 7168) + 16 * lane), z); unpack8(*(const u32x4*)(rp + (br ? 11264 : 7168) + 16 * lane + 8), z + 8);
    const float* nw_ = br ? p.ret_norm + (size_t)l * 1024 + 16 * lane : p.delta_norm + (size_t)l * 128 + 16 * (lane & 7);
    float mu = 0.f;
    if (br) {
#pragma unroll
      for (int c = 0; c < 16; ++c) mu += v[c];
      mu += __shfl_xor(mu, 1); mu += __shfl_xor(mu, 2); mu += __shfl_xor(mu, 4); mu *= (1.f / 128.f); }
    float ss = 0.f;
#pragma unroll
    for (int c = 0; c < 16; ++c) { v[c] -= mu; ss += v[c] * v[c]; }
    ss += __shfl_xor(ss, 1); ss += __shfl_xor(ss, 2); ss += __shfl_xor(ss, 4);
    const float rn = rsqrtf(ss * (1.f / 128.f) + 1e-6f);
#pragma unroll
    for (int c = 0; c < 16; ++c) v[c] = v[c] * rn * nw_[c] * siluf_(z[c]);
    *(u32x4*)(rp + C_ACAT + 1024 + br * 1024 + 16 * lane) = pack8(v); *(u32x4*)(rp + C_ACAT + 1024 + br * 1024 + 16 * lane + 8) = pack8(v + 8);
  }
}

DI void merge_phase(const Params& p) {
  const bf16_t* proj = (const bf16_t*)(p.ws + OFF_PROJ); const bf16_t* P = (const bf16_t*)(p.ws + OFF_M1); bf16_t* mg = (bf16_t*)(p.ws + OFF_H);
  const int tid_ = otid(); const int lane = tid_ & 63, gw = oblk() * 8 + (tid_ >> 6), nw = gridDim.x * 8;
  for (int r = gw; r < MROWS; r += nw) {
    const bf16_t* pr = P + (size_t)r * (3 * DM); const bf16_t* gr = proj + (size_t)r * LDP + 12288;
#pragma unroll
    for (int q = 0; q < 4; ++q) { const int c = q * 512 + lane * 8; float acc[8];
#pragma unroll
      for (int j = 0; j < 8; ++j) acc[j] = 0.f;
#pragma unroll
      for (int br = 0; br < 3; ++br) { float pv[8], gv[8]; unpack8(*(const u32x4*)(pr + br * DM + c), pv); unpack8(*(const u32x4*)(gr + br * DM + c), gv);
#pragma unroll
        for (int j = 0; j < 8; ++j) acc[j] += pv[j] * sigmoidf_(gv[j]); }
      *(u32x4*)(mg + (size_t)r * DM + c) = pack8(acc); }
  }
}

#define XB_TMO      128
#define XB_XCNT(j)  (256  + 64 * (j))
#define XB_XSUB(j)  (1280 + 64 * (j))
#define XB_XGEN(j)  (2304 + 64 * (j))
#define XB_TOP      3328
#define XB_TOPGEN   3392
#define XCD_BAR_WORDS 3456
#define XB_SPIN_CAP (1u << 18)
DI unsigned xb_ld(unsigned* p) { return __hip_atomic_load(p, __ATOMIC_RELAXED, __HIP_MEMORY_SCOPE_AGENT); }
DI unsigned xb_add(unsigned* p, unsigned v) { return __hip_atomic_fetch_add(p, v, __ATOMIC_RELAXED, __HIP_MEMORY_SCOPE_AGENT); }
DI unsigned xb_xcc_id() { return (unsigned)__builtin_amdgcn_s_getreg((3 << 11) | 20) & 0xFu; }
#define XB_SPIN(cond, bar) do { unsigned _sp = 0; while (cond) { __builtin_amdgcn_s_sleep(1); \
    if ((++_sp & 255u) == 0u) { if (xb_ld(&(bar)[XB_TMO])) break; if (_sp > XB_SPIN_CAP) { atomicAdd(&(bar)[XB_TMO], 1u); break; } } } } while (0)
struct XcdBarrier { unsigned* bar; unsigned x; volatile LAS unsigned* st; };
DI XcdBarrier xcd_barrier_post(unsigned* bar, volatile LAS unsigned* st) {
  XcdBarrier b; b.bar = bar; b.x = xb_xcc_id(); b.st = st;
  if (threadIdx.x == 0) (void)xb_add(&bar[XB_XCNT(b.x)], 1u);
  return b;
}
DI void xcd_barrier_complete(unsigned* bar, unsigned x, unsigned& nloc, unsigned& nx) {
  const unsigned G = gridDim.x * gridDim.y * gridDim.z;
  unsigned sum, cnt, mine, sp = 0u;
  for (;;) {
    sum = 0u; cnt = 0u; mine = 0u;
#pragma unroll
    for (unsigned j = 0; j < 16; ++j) { const unsigned c = xb_ld(&bar[XB_XCNT(j)]); sum += c; cnt += (c > 0u) ? 1u : 0u; mine = (j == x) ? c : mine; }
    if (sum == G) break;
    __builtin_amdgcn_s_sleep(1);
    if ((++sp & 255u) == 0u) { if (xb_ld(&bar[XB_TMO])) break; if (sp > XB_SPIN_CAP) { atomicAdd(&bar[XB_TMO], 1u); break; } }
  }
  nloc = mine > 0u ? mine : 1u; nx = cnt > 0u ? cnt : 1u;
}
DI void xcd_barrier(const XcdBarrier& b) {
  asm volatile("s_waitcnt vmcnt(0)" ::: "memory");
  __syncthreads();
  if (threadIdx.x == 0) {
    unsigned* bar = b.bar;
    __builtin_amdgcn_s_waitcnt(0);
    unsigned nloc = b.st[0], nx = b.st[1];
    if (nloc == 0u) { xcd_barrier_complete(bar, b.x, nloc, nx); b.st[0] = nloc; b.st[1] = nx; }
    const unsigned old = xb_add(&bar[XB_XSUB(b.x)], 1u);
    const unsigned gen = old / nloc;
    if (old + 1u == (gen + 1u) * nloc) {
      __builtin_amdgcn_fence(__ATOMIC_RELEASE, "agent");
      asm volatile("s_waitcnt vmcnt(0)" ::: "memory");
      const unsigned og = xb_add(&bar[XB_TOP], 1u);
      const unsigned tg = og / nx;
      if (og + 1u == (tg + 1u) * nx) xb_add(&bar[XB_TOPGEN], 1u);
      else XB_SPIN(xb_ld(&bar[XB_TOPGEN]) == tg, bar);
      __builtin_amdgcn_fence(__ATOMIC_ACQUIRE, "agent");
      xb_add(&bar[XB_XGEN(b.x)], 1u);
      asm volatile("s_waitcnt vmcnt(0)" ::: "memory");
    } else {
      XB_SPIN(xb_ld(&bar[XB_XGEN(b.x)]) == gen, bar);
      __builtin_amdgcn_fence(__ATOMIC_ACQUIRE, "agent");
      asm volatile("s_waitcnt vmcnt(0)" ::: "memory");
    }
  }
  __syncthreads();
}

__global__ void __launch_bounds__(512, 2) mega(Params p) {
  extern __shared__ __attribute__((aligned(16))) unsigned char smem[];
  cg::grid_group grid = cg::this_grid();
  const int G = gridDim.x;
  if (threadIdx.x == 0) { ((volatile LAS unsigned*)(LAS unsigned char*)smem)[(131072 + 16) / 4] = 0u; ((volatile LAS unsigned*)(LAS unsigned char*)smem)[(131072 + 20) / 4] = 0u; }
  __syncthreads();
  XcdBarrier xb = xcd_barrier_post((unsigned*)(p.ws + OFF_BAR), (volatile LAS unsigned*)((LAS unsigned char*)smem + 131072 + 16));
  if (oblk() == 0 && threadIdx.x < 4) ((unsigned*)(p.ws + OFF_CNT))[64 * threadIdx.x] = 0u;
  if (T_ROW) { convert_weights(p, 0, (float*)smem, 2, oblk(), gridDim.x);
  prenorm_phase(p, 0); }
  grid.sync();
  for (int l = 0; l < 2; ++l) {
    { pg8::Gemm g{(const bf16_t*)(p.ws + OFF_H), (const bf16_t*)(p.ws + OFF_WIN), MROWS, NW1, DM, DM, DM, 1 << 20, 0};
      pg8::StaticOrder S; S.init(MROWS, NW1, G, oblk());
      EpiProj E{(bf16_t*)(p.ws + OFF_PROJ), (float*)(p.ws + OFF_SIDE), LDP, 72};
      for (int rep = 0; rep < R_G1; ++rep) pg8::gemm_phase(( LAS unsigned char*)smem, g, S, E); }
    xcd_barrier(xb);
    { float* sCW = (float*)(smem + 122880); const int hh0 = oblk() & 7;
      for (int idx = threadIdx.x; idx < 1536; idx += 512) { const int mat = idx / 512, tap = (idx >> 7) & 3, col = idx & 127;
        sCW[idx] = p.conv_w[((size_t)l * 4 + tap) * 3072 + mat * 1024 + hh0 * 128 + col]; }
      __syncthreads(); }
    for (int rep = 0; rep < R_M1; ++rep)
    for (int t = oblk(); t < 3 * NITEM + 512; t += G) {
      if (t < NITEM) { for (int r2 = 0; r2 < R_DP; ++r2) delta_pre(p, l, t, smem); }
      else if (t < 2 * NITEM) { if (T_RP) ret_pre(p, l, t - NITEM, smem); }
      else if (t < 3 * NITEM) { if (T_MI) misc_item(p, l, t - 2 * NITEM, smem); }
      else { if (T_MI) cache_item(p, l, t - 3 * NITEM, smem); }
    }
    xcd_barrier(xb);
    for (int rep = 0; rep < R_M2; ++rep) m2_phase(p, l, rep, smem);
    xcd_barrier(xb);
    for (int rep = 0; rep < R_M3; ++rep) m3_phase(p, l);
    xcd_barrier(xb);
    for (int rep = 0; rep < R_G2; ++rep) {
      pg8::Gemm g{(const bf16_t*)(p.ws + OFF_PROJ) + C_ACAT, (const bf16_t*)(p.ws + OFF_WBR), MROWS, 3 * DM, 1024, LDP, 1024, 8, 2048};
      pg8::StaticOrder S; S.init(MROWS, 3 * DM, G, oblk());
      EpiProj E{(bf16_t*)(p.ws + OFF_M1), nullptr, 3 * DM, 1 << 20};
      pg8::gemm_phase((LAS unsigned char*)smem, g, S, E); }
    xcd_barrier(xb);
    merge_phase(p);
    xcd_barrier(xb);
    if (l == 0) {
      { pg8::Gemm g{(const bf16_t*)(p.ws + OFF_H), (const bf16_t*)(p.ws + OFF_WOUT), MROWS, DM, DM, DM, DM, 1 << 20, 0};
        pg8::StaticOrder S; S.init(MROWS, DM, G, oblk());
        EpiF32 E{(float*)(p.ws + OFF_M1 + 69206016)};
        pg8::gemm_phase((LAS unsigned char*)smem, g, S, E); }
      { const int c0 = 528 - ((528 + G - 1) / G - 1) * G;
        if (c0 < G && oblk() >= c0) convert_weights(p, 1, (float*)smem, 0, oblk() - c0, G - c0);
        else if (c0 >= G) convert_weights(p, 1, (float*)smem, 0, oblk(), G); }
      xcd_barrier(xb);
      postnorm_phase(p, l, 0, MROWS, 0, G);
    } else {
      { pg8::Gemm g{(const bf16_t*)(p.ws + OFF_H), (const bf16_t*)(p.ws + OFF_WOUT), 16384, DM, DM, DM, DM, 1 << 20, 0};
        pg8::StaticOrder S; S.init(16384, DM, G, oblk());
        EpiF32 E{(float*)(p.ws + OFF_M1 + 69206016)};
        pg8::gemm_phase((LAS unsigned char*)smem, g, S, E); }
      xcd_barrier(xb);
      if (oblk() < 16 && G > 16) {
        pg8::Gemm g{(const bf16_t*)(p.ws + OFF_H) + (size_t)16384 * DM, (const bf16_t*)(p.ws + OFF_WOUT), 512, DM, DM, DM, DM, 1 << 20, 0};
        pg8::StaticOrder S; S.init(512, DM, 16, oblk());
        EpiF32 E{(float*)(p.ws + OFF_M1 + 69206016) + (size_t)16384 * DM};
        pg8::gemm_phase((LAS unsigned char*)smem, g, S, E);
      } else if (G > 16) postnorm_phase(p, l, 0, 16384, 16, G - 16);
      xcd_barrier(xb);
      postnorm_phase(p, l, 16384, MROWS, 0, G);
    }
    if (l == 0) { if (T_ROW) convert_weights(p, 1, (float*)smem, 1, oblk(), gridDim.x); xcd_barrier(xb); }
  }
}

extern "C" void kernel_launch(void* const* d_in, const int* in_sizes, int n_in, void* d_out, int out_size,
                              void* d_ws, size_t ws_size, hipStream_t stream) {
  constexpr size_t kLds = 131072 + 256 + 4096;
  static int grid_blocks = 0;
  if (!grid_blocks) {
    (void)hipFuncSetAttribute((const void*)mega, hipFuncAttributeMaxDynamicSharedMemorySize, (int)kLds);
    int dev = 0, cus = 0, per_cu = 0;
    (void)hipGetDevice(&dev);
    (void)hipDeviceGetAttribute(&cus, hipDeviceAttributeMultiprocessorCount, dev);
    (void)hipOccupancyMaxActiveBlocksPerMultiprocessor(&per_cu, mega, 512, kLds);
    if (per_cu > 1) per_cu = 1;
    grid_blocks = cus * per_cu;
    if (grid_blocks > 256) grid_blocks = 256;
  }
  if (ws_size < WS_NEED) { fprintf(stderr, "workspace too small: %zu < %zu\n", ws_size, (size_t)WS_NEED); return; }
  (void)hipMemsetAsync((unsigned char*)d_ws + OFF_BAR, 0, 16384, stream);
  Params p{};
  const float** pp = (const float**)&p;
  for (int i = 0; i < 20; ++i) pp[i] = (const float*)d_in[i];
  p.out = (float*)d_out; p.ws = (unsigned char*)d_ws;
  void* args[] = {&p};
  hipError_t e = hipLaunchCooperativeKernel((void*)mega, dim3(grid_blocks), dim3(512), args, kLds, stream);
  if (e != hipSuccess) fprintf(stderr, "cooperative launch failed: %s (grid %d)\n", hipGetErrorString(e), grid_blocks);
}
```

```cpp
#include <hip/hip_runtime.h>
#include <hip/hip_cooperative_groups.h>
#include <cstdio>
namespace cg = cooperative_groups;
#ifndef R_DP
#define R_DP 1
#endif
#ifndef R_SW
#define R_SW 1
#endif
#ifndef R_AT
#define R_AT 1
#endif
#ifndef R_G1
#define R_G1 1
#endif
#ifndef R_M1
#define R_M1 1
#endif
#ifndef R_M2
#define R_M2 1
#endif
#ifndef R_M3
#define R_M3 1
#endif
#ifndef R_G2
#define R_G2 1
#endif
#ifndef R_G3
#define R_G3 1
#endif
#ifndef T_ROW
#define T_ROW 1
#endif
#ifndef T_G1
#define T_G1 1
#endif
#ifndef T_DP
#define T_DP 1
#endif
#ifndef T_RP
#define T_RP 1
#endif
#ifndef T_MI
#define T_MI 1
#endif
#ifndef T_M2
#define T_M2 1
#endif
#ifndef T_M3
#define T_M3 1
#endif
#ifndef T_G2
#define T_G2 1
#endif
#ifndef T_G3
#define T_G3 1
#endif
#ifndef T_AT
#define T_AT 1
#endif
#ifndef T_SC
#define T_SC 1
#endif

#define DI __device__ __forceinline__
#define LAS __attribute__((address_space(3)))
typedef unsigned short bf16_t;
typedef short bf16x8 __attribute__((ext_vector_type(8)));
typedef float f32x4 __attribute__((ext_vector_type(4)));
typedef float f32x2 __attribute__((ext_vector_type(2)));
typedef unsigned u32x4 __attribute__((ext_vector_type(4)));
typedef unsigned u32x2 __attribute__((ext_vector_type(2)));
typedef __bf16 bf2_t __attribute__((ext_vector_type(2)));

constexpr int DM = 2048, MROWS = 16896, LDP = 18432, NW1 = 18688, NIN = 18448, NITEM = 2112;
constexpr int C_ACAT = 4096, C_OBRAW = 8192, C_OCRAW = 9216;
constexpr size_t O_PK = 34603008, O_PV = 38797312, O_PC = 42991616, O_PD = 43065344, O_PR = 44113920, O_SK = 45162496, O_SV = 53551104, O_SC = 61939712, O_SD = 62087168, O_SR = 64184320;
constexpr size_t OFF_WIN = 0, OFF_WBR = 76546048, OFF_WOUT = 89128960, OFF_H = 97517568, OFF_PROJ = 166723584, OFF_SIDE = 789577728, OFF_DG = 790659072,
                 OFF_CNT = 790667520, OFF_KC = 790675456, OFF_CVT = 799064064, OFF_M1 = 807452672, OFF_BAR = 1118879744, WS_NEED = 1118879744 + 16384;
constexpr size_t M1_BLK = (size_t)NITEM * 8192;

struct Params {
  const float *x_prompt, *x_sample, *cache_k, *cache_v, *state_conv, *state_delta, *state_ret, *norm_pre, *norm_post, *w_in, *rel_bias, *conv_w, *a_log, *dt_bias,
      *delta_norm, *ret_norm, *w_ba, *w_bb, *w_bc, *w_out;
  float* out; unsigned char* ws;
};

DI unsigned pk2(float lo, float hi) { f32x2 v = {lo, hi}; bf2_t b = __builtin_convertvector(v, bf2_t); return __builtin_bit_cast(unsigned, b); }
DI bf16_t f2bf(float x) { return (bf16_t)(pk2(x, 0.f) & 0xffffu); }
DI float bflo(unsigned w) { return __uint_as_float(w << 16); }
DI float bfhi(unsigned w) { return __uint_as_float(w & 0xffff0000u); }
DI float bf2f(bf16_t b) { return __uint_as_float(((unsigned)b) << 16); }
DI float sigmoidf_(float x) { return __builtin_amdgcn_rcpf(1.f + __expf(-x)); }
DI float siluf_(float x) { return x * __builtin_amdgcn_rcpf(1.f + __expf(-x)); }
DI int oblk() { int b = blockIdx.x; asm volatile("" : "+s"(b)); return __builtin_amdgcn_readfirstlane(b); }
DI int otid() { int t = threadIdx.x; asm volatile("" : "+v"(t)); return t; }
DI int kperm(int p) { return 16 * ((p >> 2) & 1) + 4 * (p >> 3) + (p & 3); }
DI int kinv(int x) { return 8 * ((x >> 2) & 3) + 4 * (x >> 4) + (x & 3); }
DI float wsum(float v) { for (int o = 32; o > 0; o >>= 1) v += __shfl_xor(v, o); return v; }
DI void unpack8(u32x4 a, float* o) { o[0] = bflo(a.x); o[1] = bfhi(a.x); o[2] = bflo(a.y); o[3] = bfhi(a.y); o[4] = bflo(a.z); o[5] = bfhi(a.z); o[6] = bflo(a.w); o[7] = bfhi(a.w); }
DI u32x4 pack8(const float* v) { u32x4 w; w.x = pk2(v[0], v[1]); w.y = pk2(v[2], v[3]); w.z = pk2(v[4], v[5]); w.w = pk2(v[6], v[7]); return w; }
DI bf16x8 pack_frag(f32x4 a, f32x4 b) { u32x4 w; w.x = pk2(a[0], a[1]); w.y = pk2(a[2], a[3]); w.z = pk2(b[0], b[1]); w.w = pk2(b[2], b[3]); return __builtin_bit_cast(bf16x8, w); }
#define MFMA16(a, b, c) __builtin_amdgcn_mfma_f32_16x16x32_bf16((a), (b), (c), 0, 0, 0)

namespace pg8 {
constexpr int BM = 256, BK = 64, HALF = 128, HTB = HALF * BK * 2, STAGE_BYTES = 8 * HTB, NXCD = 8, WGM = 8;
DI int lds_byte(int r, int c) { const int st = (r >> 4) * 2 + (c >> 5), rr = r & 15, cc = c & 31, ob = rr * 64 + cc * 2; return st * 1024 + (ob ^ (((ob >> 9) & 1) << 5)); }
DI void stage_rc(int b, int& R, int& C) { const int st = b / 1024, sb = b % 1024, swz = sb ^ (((sb >> 9) & 1) << 5); R = (st >> 1) * 16 + swz / 64; C = (st & 1) * 32 + (swz % 64) / 2; }
DI int perm32(int rho) { const int n = rho >> 4, i = rho & 15; return 8 * (i >> 2) + 4 * n + (i & 3); }
struct Unit { int pm, pn; };
struct Gemm { const bf16_t* A; const bf16_t* Bt; int M, N, K, lda, ldb, a_div, a_step; };
struct StaticOrder {
  int nM, nN, nwg, G, c;
  DI void init(int M, int N, int G_, int c_) { nM = M / BM; nN = N / BM; nwg = nM * nN; G = G_; c = c_; }
  DI bool next(int i, Unit& u) const {
    const long L = (long)i * G + c; if (L >= nwg) return false;
    int wgid = (int)L; { const int q = nwg / NXCD, r = nwg % NXCD, xcd = wgid % NXCD, off = wgid / NXCD; wgid = (xcd < r ? xcd * (q + 1) : r * (q + 1) + (xcd - r) * q) + off; }
    const int nig = WGM * nN, gid = wgid / nig, fm = gid * WGM, gsz = (nM - fm) < WGM ? (nM - fm) : WGM;
    u.pm = fm + ((wgid % nig) % gsz); u.pn = (wgid % nig) / gsz; return true;
  }
};

template <class Epi>
DI void gemm_phase(LAS unsigned char* lds, const Gemm g, const StaticOrder& S, const Epi& E) {
  const int tid = otid(), wid = __builtin_amdgcn_readfirstlane(tid >> 6), lane = tid & 63, wr = wid >> 2, wc = wid & 3, fr = lane & 15, fq = lane >> 4;
  const int K = g.K, nt = K / BK;
  unsigned voffA[2], voffB[2];
#pragma unroll
  for (int i = 0; i < 2; ++i) { int R, C; stage_rc(tid * 16 + i * 8192, R, C); const int Rb = Epi::PERM ? ((R & ~31) + perm32(R & 31)) : R;
    voffA[i] = (unsigned)(R * g.lda + C) * 2u; voffB[i] = (unsigned)(Rb * g.ldb + C) * 2u; }
  const size_t kstep = (size_t)(BK * 2);
  const size_t hstepA = (size_t)HALF * g.lda * 2, hstepB = (size_t)HALF * g.ldb * 2;
  const size_t tstepA = 2 * hstepA, tstepB = 2 * hstepB;
  const unsigned ldsw = (unsigned)wid * 1024u;
  const int aoff = lds_byte(wr * 64 + fr, fq * 8), boff = lds_byte(wc * 32 + fr, fq * 8);
#define PG8_SA(b, h) (((b) * 2 + (h)) * HTB)
#define PG8_SB(b, h) ((4 + (b) * 2 + (h)) * HTB)
#define PG8_STAGE(bufoff, gbase, voff) do { const char* _gb = (const char*)(gbase); asm volatile("" : "+s"(_gb)); _Pragma("unroll") for (int _i = 0; _i < 2; ++_i) \
    __builtin_amdgcn_global_load_lds((const unsigned*)(_gb + (voff)[_i]), (LAS unsigned*)(lds + (bufoff) + ldsw + _i * 8192), 16, 0, 0); } while (0)
#define PG8_LDA(dst, b, h) do { _Pragma("unroll") for (int m = 0; m < 4; ++m) _Pragma("unroll") for (int k = 0; k < 2; ++k) dst[m][k] = *(const LAS bf16x8*)(lds + PG8_SA(b, h) + aoff + m * 2048 + k * 1024); } while (0)
#define PG8_LDB(dst, b, h) do { _Pragma("unroll") for (int n = 0; n < 2; ++n) _Pragma("unroll") for (int k = 0; k < 2; ++k) dst[n][k] = *(const LAS bf16x8*)(lds + PG8_SB(b, h) + boff + n * 2048 + k * 1024); } while (0)
#define PG8_MMA(ai, bj, At, Bt) do { __builtin_amdgcn_s_setprio(1); _Pragma("unroll") for (int m = 0; m < 4; ++m) _Pragma("unroll") for (int n = 0; n < 2; ++n) _Pragma("unroll") for (int k = 0; k < 2; ++k) \
    acc[ai][bj][m][n] = __builtin_amdgcn_mfma_f32_16x16x32_bf16(Bt[n][k], At[m][k], acc[ai][bj][m][n], 0, 0, 0); __builtin_amdgcn_s_setprio(0); } while (0)
#define PG8_WAIT_V(n) asm volatile("s_waitcnt vmcnt(" #n ")" ::: "memory")
#define PG8_WAIT_L(n) asm volatile("s_waitcnt lgkmcnt(" #n ")" ::: "memory")
#define PG8_BAR __builtin_amdgcn_s_barrier()
#define PG8_SCHED __builtin_amdgcn_sched_barrier(0)
  Unit cur, nxt; int ui = 0;
  if (!S.next(0, cur)) return;
  f32x4 acc[2][2][4][2];
#pragma unroll
  for (int a = 0; a < 2; ++a)
#pragma unroll
    for (int b = 0; b < 2; ++b)
#pragma unroll
      for (int m = 0; m < 4; ++m)
#pragma unroll
        for (int n = 0; n < 2; ++n) acc[a][b][m][n] = (f32x4){0.f, 0.f, 0.f, 0.f};
  bf16x8 At[4][2], B0[2][2], B1[2][2];
  const char* cA = (const char*)g.A + (size_t)cur.pm * tstepA + (size_t)((cur.pn / g.a_div) * g.a_step); const char* cB = (const char*)g.Bt + (size_t)cur.pn * tstepB;
  PG8_STAGE(PG8_SB(0, 0), cB, voffB); PG8_STAGE(PG8_SA(0, 0), cA, voffA); PG8_STAGE(PG8_SB(0, 1), cB + hstepB, voffB); PG8_STAGE(PG8_SA(0, 1), cA + hstepA, voffA);
  if (wr == 1) PG8_BAR;
  PG8_WAIT_V(4); PG8_BAR;
  PG8_STAGE(PG8_SB(1, 0), cB + kstep, voffB); PG8_STAGE(PG8_SA(1, 0), cA + kstep, voffA); PG8_STAGE(PG8_SB(1, 1), cB + hstepB + kstep, voffB);
  PG8_WAIT_V(6); PG8_BAR;
  for (;;) {
    const bool has_next = S.next(ui + 1, nxt);
    const char* nA = has_next ? (const char*)g.A + (size_t)nxt.pm * tstepA + (size_t)((nxt.pn / g.a_div) * g.a_step) : cA; const char* nB = has_next ? (const char*)g.Bt + (size_t)nxt.pn * tstepB : cB;
    for (int t = 0; t < nt; t += 2) {
      const bool last = (t == nt - 2);
      const char* a1 = cA + (size_t)(t + 1) * kstep;
      const char* a2 = last ? nA : cA + (size_t)(t + 2) * kstep; const char* b2 = last ? nB : cB + (size_t)(t + 2) * kstep;
      const char* a3 = a2 + kstep; const char* b3 = b2 + kstep;
      PG8_LDB(B0, 0, 0); PG8_SCHED; PG8_LDA(At, 0, 0); PG8_STAGE(PG8_SA(1, 1), a1 + hstepA, voffA);
      PG8_WAIT_L(8); PG8_BAR; PG8_WAIT_L(0); PG8_MMA(0, 0, At, B0); PG8_BAR; PG8_SCHED;
      PG8_LDB(B1, 0, 1); PG8_STAGE(PG8_SB(0, 0), b2, voffB);
      PG8_BAR; PG8_WAIT_L(0); PG8_MMA(0, 1, At, B1); PG8_BAR;
      PG8_LDA(At, 0, 1); PG8_STAGE(PG8_SA(0, 0), a2, voffA);
      PG8_BAR; PG8_WAIT_L(0); PG8_MMA(1, 0, At, B0); PG8_BAR; PG8_SCHED;
      PG8_STAGE(PG8_SB(0, 1), b2 + hstepB, voffB);
      PG8_WAIT_V(6); PG8_BAR; PG8_MMA(1, 1, At, B1); PG8_BAR;
      PG8_LDB(B0, 1, 0); PG8_SCHED; PG8_LDA(At, 1, 0); PG8_STAGE(PG8_SA(0, 1), a2 + hstepA, voffA);
      PG8_WAIT_L(8); PG8_BAR; PG8_WAIT_L(0); PG8_MMA(0, 0, At, B0); PG8_BAR; PG8_SCHED;
      PG8_LDB(B1, 1, 1); PG8_STAGE(PG8_SB(1, 0), b3, voffB);
      PG8_BAR; PG8_WAIT_L(0); PG8_MMA(0, 1, At, B1); PG8_BAR;
      PG8_LDA(At, 1, 1); PG8_STAGE(PG8_SA(1, 0), a3, voffA);
      PG8_BAR; PG8_WAIT_L(0); PG8_MMA(1, 0, At, B0); PG8_BAR; PG8_SCHED;
      PG8_STAGE(PG8_SB(1, 1), b3 + hstepB, voffB);
      PG8_WAIT_V(6); PG8_BAR; PG8_MMA(1, 1, At, B1); PG8_BAR;
    }
    E(acc, cur, wr, wc, fr, fq);
    if (!has_next) break;
#pragma unroll
    for (int a = 0; a < 2; ++a)
#pragma unroll
      for (int b = 0; b < 2; ++b)
#pragma unroll
        for (int m = 0; m < 4; ++m)
#pragma unroll
          for (int n = 0; n < 2; ++n) acc[a][b][m][n] = (f32x4){0.f, 0.f, 0.f, 0.f};
    cur = nxt; cA = nA; cB = nB; ++ui;
  }
  PG8_WAIT_V(0);
  if (wr == 0) PG8_BAR;
  PG8_BAR;
#undef PG8_SA
#undef PG8_SB
#undef PG8_STAGE
#undef PG8_LDA
#undef PG8_LDB
#undef PG8_MMA
#undef PG8_WAIT_V
#undef PG8_WAIT_L
#undef PG8_BAR
#undef PG8_SCHED
}
}

struct EpiProj {
  static constexpr bool PERM = true;
  bf16_t* O; float* side; int ldc, nmain;
  DI void operator()(const f32x4 (&acc)[2][2][4][2], const pg8::Unit& u, int wr, int wc, int fr, int fq) const {
    const int row0 = u.pm * 256 + wr * 64 + fr;
    if (u.pn < nmain) {
      const int col0 = u.pn * 256 + wc * 32 + 8 * fq;
#pragma unroll
      for (int ai = 0; ai < 2; ++ai)
#pragma unroll
        for (int m = 0; m < 4; ++m) { bf16_t* rowp = O + (size_t)(row0 + ai * 128 + m * 16) * ldc + col0;
#pragma unroll
          for (int bj = 0; bj < 2; ++bj) { const f32x4 v0 = acc[ai][bj][m][0], v1 = acc[ai][bj][m][1];
            u32x4 w; w.x = pk2(v0[0], v0[1]); w.y = pk2(v0[2], v0[3]); w.z = pk2(v1[0], v1[1]); w.w = pk2(v1[2], v1[3]);
            *(u32x4*)(rowp + bj * 128) = w; } }
    } else if (wc == 0 && fq < 2) {
#pragma unroll
      for (int ai = 0; ai < 2; ++ai)
#pragma unroll
        for (int m = 0; m < 4; ++m) { float* sp = side + (size_t)(row0 + ai * 128 + m * 16) * 16 + 8 * fq;
          *(f32x4*)sp = acc[ai][0][m][0]; *(f32x4*)(sp + 4) = acc[ai][0][m][1]; }
    }
  }
};
struct EpiGate {
  static constexpr bool PERM = true;
  bf16_t* O; const bf16_t* proj; int br;
  DI void operator()(const f32x4 (&acc)[2][2][4][2], const pg8::Unit& u, int wr, int wc, int fr, int fq) const {
    const int row0 = u.pm * 256 + wr * 64 + fr, col0 = u.pn * 256 + wc * 32 + 8 * fq;
#pragma unroll
    for (int ai = 0; ai < 2; ++ai)
#pragma unroll
      for (int m = 0; m < 4; ++m) { const int row = row0 + ai * 128 + m * 16;
        bf16_t* rowp = O + (size_t)row * DM + col0; const bf16_t* gp = proj + (size_t)row * LDP + 12288 + br * 2048 + col0;
#pragma unroll
        for (int bj = 0; bj < 2; ++bj) { const f32x4 v0 = acc[ai][bj][m][0], v1 = acc[ai][bj][m][1];
          float gt[8], v[8]; unpack8(*(const u32x4*)(gp + bj * 128), gt);
#pragma unroll
          for (int j = 0; j < 4; ++j) { v[j] = v0[j] * sigmoidf_(gt[j]); v[4 + j] = v1[j] * sigmoidf_(gt[4 + j]); }
          if (br > 0) { float pv[8]; unpack8(*(const u32x4*)(rowp + bj * 128), pv);
#pragma unroll
            for (int j = 0; j < 8; ++j) v[j] += pv[j]; }
          *(u32x4*)(rowp + bj * 128) = pack8(v); } }
  }
};
struct EpiF32 {
  static constexpr bool PERM = false;
  float* C;
  DI void operator()(const f32x4 (&acc)[2][2][4][2], const pg8::Unit& u, int wr, int wc, int fr, int fq) const {
    const int row0 = u.pm * 256 + wr * 64 + fr, col0 = u.pn * 256 + wc * 32 + 4 * fq;
#pragma unroll
    for (int ai = 0; ai < 2; ++ai)
#pragma unroll
      for (int m = 0; m < 4; ++m) { float* rowp = C + (size_t)(row0 + ai * 128 + m * 16) * DM + col0;
#pragma unroll
        for (int bj = 0; bj < 2; ++bj)
#pragma unroll
          for (int n = 0; n < 2; ++n) *(f32x4*)(rowp + bj * 128 + n * 16) = acc[ai][bj][m][n]; }
  }
};

DI void conv_tile(float* T, const float* src, int ldsrc, int n0, int nvalid, int k0, bf16_t* dst, int K) {
  const int tid = otid();
  f32x4 v[8];
#pragma unroll
  for (int ps = 0; ps < 8; ++ps) { const int k = ps * 8 + (tid >> 6), c4 = (tid & 63) * 4;
    v[ps] = (f32x4){0.f, 0.f, 0.f, 0.f};
    if (c4 < nvalid) v[ps] = *(const f32x4*)(src + (size_t)(k0 + k) * ldsrc + n0 + c4); }
#pragma unroll
  for (int ps = 0; ps < 8; ++ps) { const int k = ps * 8 + (tid >> 6), c4 = (tid & 63) * 4;
    T[k * 257 + c4] = v[ps][0]; T[k * 257 + c4 + 1] = v[ps][1]; T[k * 257 + c4 + 2] = v[ps][2]; T[k * 257 + c4 + 3] = v[ps][3]; }
  __syncthreads();
#pragma unroll
  for (int i = 0; i < 4; ++i) { const int n = (tid >> 3) + 64 * i, kg = tid & 7; float w[8];
#pragma unroll
    for (int j = 0; j < 8; ++j) w[j] = T[(8 * kg + j) * 257 + n];
    *(u32x4*)(dst + (size_t)n * K + k0 + 8 * kg) = pack8(w); }
  __syncthreads();
}
DI void convert_weights(const Params& p, int l, float* T, int part, int first, int stride) {
  bf16_t* win = (bf16_t*)(p.ws + OFF_WIN); bf16_t* wbr = (bf16_t*)(p.ws + OFF_WBR); bf16_t* wout = (bf16_t*)(p.ws + OFF_WOUT);
  const int n_in = 73 * 32, n_br = 3 * 8 * 16, n_out = 8 * 32;
  const int t_lo = (part == 1) ? n_in + n_br : 0, t_hi = (part == 0) ? n_in + n_br : n_in + n_br + n_out;
  for (int t = t_lo + first; t < t_hi; t += stride) {
    if (t < n_in) { const int ntile = t >> 5, kt = t & 31, np0 = ntile * 256; int n0 = 0, nv = 256;
      if (np0 < 8192) n0 = np0; else if (np0 < 18432) n0 = np0 + 16; else { n0 = 8192; nv = 16; }
      conv_tile(T, p.w_in + (size_t)l * DM * NIN, NIN, n0, nv, kt * 64, win + (size_t)np0 * DM, DM);
    } else if (t < n_in + n_br) { const int u = t - n_in, br = u >> 7, r = u & 127, ntile = r >> 4, kt = r & 15;
      const float* src = (br == 0 ? p.w_ba : br == 1 ? p.w_bb : p.w_bc) + (size_t)l * 1024 * DM;
      conv_tile(T, src, DM, ntile * 256, 256, kt * 64, wbr + (size_t)br * DM * 1024 + (size_t)ntile * 256 * 1024, 1024);
    } else { const int u = t - n_in - n_br, ntile = u >> 5, kt = u & 31;
      conv_tile(T, p.w_out + (size_t)l * DM * DM, DM, ntile * 256, 256, kt * 64, wout + (size_t)ntile * 256 * DM, DM); }
  }
}

DI void prenorm_phase(const Params& p, int l) {
  bf16_t* h = (bf16_t*)(p.ws + OFF_H); const float* g = p.norm_pre + (size_t)l * DM;
  const int tid_ = otid(); const int lane = tid_ & 63, gw = oblk() * 8 + (tid_ >> 6), nw = gridDim.x * 8;
  for (int r = gw; r < MROWS; r += nw) {
    const float* xr = (r < 16384) ? p.x_prompt + (size_t)r * DM : p.x_sample + (size_t)(r - 16384) * DM;
    f32x4 v[8]; float ss = 0.f;
#pragma unroll
    for (int i = 0; i < 8; ++i) { v[i] = *(const f32x4*)(xr + i * 256 + lane * 4); ss += v[i][0] * v[i][0] + v[i][1] * v[i][1] + v[i][2] * v[i][2] + v[i][3] * v[i][3]; }
    ss = wsum(ss); const float rn = rsqrtf(ss * (1.f / DM) + 1e-6f);
#pragma unroll
    for (int i = 0; i < 8; ++i) { const f32x4 gg = *(const f32x4*)(g + i * 256 + lane * 4);
      u32x2 w; w.x = pk2(v[i][0] * rn * gg[0], v[i][1] * rn * gg[1]); w.y = pk2(v[i][2] * rn * gg[2], v[i][3] * rn * gg[3]);
      *(u32x2*)(h + (size_t)r * DM + i * 256 + lane * 4) = w; }
  }
}
DI void postnorm_phase(const Params& p, int l, int row_lo, int row_hi, int wg_first, int wg_count) {
  bf16_t* h = (bf16_t*)(p.ws + OFF_H); const float* ypre = (const float*)(p.ws + OFF_M1 + 69206016);
  const float* gpost = p.norm_post + (size_t)l * DM; const float* gpre = p.norm_pre + (size_t)(l + 1) * DM;
  const int tid_ = otid(); const int lane = tid_ & 63, gw = (oblk() - wg_first) * 8 + (tid_ >> 6), nw = wg_count * 8;
  for (int r = row_lo + gw; r < row_hi; r += nw) {
    const float* xr = (l > 0) ? p.out + (size_t)r * DM : ((r < 16384) ? p.x_prompt + (size_t)r * DM : p.x_sample + (size_t)(r - 16384) * DM);
    const float* yr = ypre + (size_t)r * DM;
    f32x4 v[8]; float ss = 0.f;
#pragma unroll
    for (int i = 0; i < 8; ++i) { v[i] = *(const f32x4*)(yr + i * 256 + lane * 4); ss += v[i][0] * v[i][0] + v[i][1] * v[i][1] + v[i][2] * v[i][2] + v[i][3] * v[i][3]; }
    ss = wsum(ss); const float rn = rsqrtf(ss * (1.f / DM) + 1e-6f); float s2 = 0.f;
#pragma unroll
    for (int i = 0; i < 8; ++i) { const f32x4 gg = *(const f32x4*)(gpost + i * 256 + lane * 4); const f32x4 xx = *(const f32x4*)(xr + i * 256 + lane * 4);
#pragma unroll
      for (int j = 0; j < 4; ++j) { v[i][j] = xx[j] + v[i][j] * rn * gg[j]; s2 += v[i][j] * v[i][j]; }
      *(f32x4*)(p.out + (size_t)r * DM + i * 256 + lane * 4) = v[i]; }
    if (l == 0) { s2 = wsum(s2); const float r2 = rsqrtf(s2 * (1.f / DM) + 1e-6f);
#pragma unroll
      for (int i = 0; i < 8; ++i) { const f32x4 gg = *(const f32x4*)(gpre + i * 256 + lane * 4);
        u32x2 w; w.x = pk2(v[i][0] * r2 * gg[0], v[i][1] * r2 * gg[1]); w.y = pk2(v[i][2] * r2 * gg[2], v[i][3] * r2 * gg[3]);
        *(u32x2*)(h + (size_t)r * DM + i * 256 + lane * 4) = w; } }
  }
}

template <class F> DI void write_T_perm(bf16_t* dst, F&& val) {
  const int t = otid(), r = t >> 2, q4 = t & 3, tb = q4 >> 1, p0 = 16 * (q4 & 1);
  float v[16];
#pragma unroll
  for (int j = 0; j < 16; ++j) v[j] = val(32 * tb + kperm(p0 + j), r);
  *(u32x4*)(dst + r * 64 + 32 * tb + p0) = pack8(v); *(u32x4*)(dst + r * 64 + 32 * tb + p0 + 8) = pack8(v + 8);
}
template <class F> DI void write_perm(bf16_t* dst, F&& val) {
  const int t = otid(), tok = t >> 3, cgp = t & 7, db = cgp >> 1, p0 = 16 * (cgp & 1);
  float v[16];
#pragma unroll
  for (int j = 0; j < 16; ++j) v[j] = val(tok, 32 * db + kperm(p0 + j));
  *(u32x4*)(dst + tok * 128 + 32 * db + p0) = pack8(v); *(u32x4*)(dst + tok * 128 + 32 * db + p0 + 8) = pack8(v + 8);
}

DI void conv16(const Params& p, const bf16_t* proj, int l, int ci, int ch0, int tok, float (&y)[16]) {
  const float* cw = p.conv_w + (size_t)l * 4 * 3072 + ch0;
#pragma unroll
  for (int c = 0; c < 16; ++c) y[c] = 0.f;
#pragma unroll
  for (int o = 0; o < 4; ++o) {
    const int t = tok - 3 + o; float xv[16];
    if (t >= 0 || (ci < 256 && (ci & 63) != 0)) {
      const bf16_t* src = proj + (size_t)(ci * 64 + t) * LDP + 4096 + ch0;
      unpack8(*(const u32x4*)src, xv); unpack8(*(const u32x4*)(src + 8), xv + 8);
    } else if (ci >= 256) {
      const float* sc = p.state_conv + ((size_t)(l * 8 + (ci - 256)) * 3 + (3 + t)) * 3072 + ch0;
#pragma unroll
      for (int q = 0; q < 4; ++q) { const f32x4 a = *(const f32x4*)(sc + 4 * q); xv[4 * q] = a[0]; xv[4 * q + 1] = a[1]; xv[4 * q + 2] = a[2]; xv[4 * q + 3] = a[3]; }
    } else {
#pragma unroll
      for (int c = 0; c < 16; ++c) xv[c] = 0.f;
    }
#pragma unroll
    for (int q = 0; q < 4; ++q) { const f32x4 w = *(const f32x4*)(cw + o * 3072 + 4 * q);
      y[4 * q] += w[0] * xv[4 * q]; y[4 * q + 1] += w[1] * xv[4 * q + 1]; y[4 * q + 2] += w[2] * xv[4 * q + 2]; y[4 * q + 3] += w[3] * xv[4 * q + 3]; }
  }
#pragma unroll
  for (int c = 0; c < 16; ++c) y[c] = siluf_(y[c]);
}

DI void conv_fetch(const Params& p, const bf16_t* proj, int l, int ci, int hh, int cgp, int tok, u32x4 (&raw)[3][4][2]) {
#pragma unroll
  for (int o = 0; o < 4; ++o) {
    const int t = tok - 3 + o;
#pragma unroll
    for (int mat = 0; mat < 3; ++mat) {
      const int ch0 = mat * 1024 + hh * 128 + 16 * cgp;
      if (t >= 0 || (ci < 256 && (ci & 63) != 0)) {
        const bf16_t* src = proj + (size_t)(ci * 64 + t) * LDP + 4096 + ch0;
        raw[mat][o][0] = *(const u32x4*)src; raw[mat][o][1] = *(const u32x4*)(src + 8);
      } else if (ci >= 256) {
        const float* sc = p.state_conv + ((size_t)(l * 8 + (ci - 256)) * 3 + (3 + t)) * 3072 + ch0; float f[16];
#pragma unroll
        for (int q = 0; q < 4; ++q) { const f32x4 a = *(const f32x4*)(sc + 4 * q); f[4 * q] = a[0]; f[4 * q + 1] = a[1]; f[4 * q + 2] = a[2]; f[4 * q + 3] = a[3]; }
        raw[mat][o][0] = pack8(f); raw[mat][o][1] = pack8(f + 8);
      } else { raw[mat][o][0] = (u32x4){0u, 0u, 0u, 0u}; raw[mat][o][1] = (u32x4){0u, 0u, 0u, 0u}; }
    }
  }
}
DI void conv_apply(const float* sCW, int mat, int cgp, const u32x4 (&raw)[3][4][2], float (&y)[16]) {
#pragma unroll
  for (int c = 0; c < 16; ++c) y[c] = 0.f;
#pragma unroll
  for (int o = 0; o < 4; ++o) { float xv[16]; unpack8(raw[mat][o][0], xv); unpack8(raw[mat][o][1], xv + 8);
#pragma unroll
    for (int q = 0; q < 4; ++q) { const f32x4 w = *(const f32x4*)(sCW + (mat * 4 + o) * 128 + 16 * cgp + 4 * q);
      y[4 * q] += w[0] * xv[4 * q]; y[4 * q + 1] += w[1] * xv[4 * q + 1]; y[4 * q + 2] += w[2] * xv[4 * q + 2]; y[4 * q + 3] += w[3] * xv[4 * q + 3]; } }
#pragma unroll
  for (int c = 0; c < 16; ++c) y[c] = siluf_(y[c]);
}

DI void delta_pre(const Params& p, int l, int it, unsigned char* smem) {
  const int ci = it >> 3, hh = it & 7, tid = otid(), wid = tid >> 6, lane = tid & 63, fr = lane & 15, fq = lane >> 4;
  bf16_t* sKB = (bf16_t*)smem; bf16_t* sQB = (bf16_t*)(smem + 17408); float* sKF = (float*)(smem + 34816); float* sVF = (float*)(smem + 68608);
  float* sA = (float*)(smem + 102400); float* sGC = (float*)(smem + 118784); float* sBT = sGC + 64; float* sEG = sGC + 128; float* sR1 = sGC + 192;
  const bf16_t* proj = (const bf16_t*)(p.ws + OFF_PROJ); const float* side = (const float*)(p.ws + OFF_SIDE);
  bf16_t* m1 = (bf16_t*)(p.ws + OFF_M1);
  bf16_t* dW = m1 + 0 * M1_BLK + (size_t)it * 8192; bf16_t* dQ = m1 + 1 * M1_BLK + (size_t)it * 8192; bf16_t* dKT = m1 + 2 * M1_BLK + (size_t)it * 8192;
  bf16_t* dUT = m1 + 3 * M1_BLK + (size_t)it * 8192; bf16_t* dIN = m1 + 8 * M1_BLK + (size_t)it * 4096;
  if (wid == 0) {
    const int row = ci * 64 + lane;
    const float bl = side[(size_t)row * 16 + hh], al = side[(size_t)row * 16 + 8 + hh] + p.dt_bias[l * 8 + hh];
    const float sp = al > 20.f ? al : log1pf(__expf(al));
    float g = -__expf(p.a_log[l * 8 + hh]) * sp;
#pragma unroll
    for (int o = 1; o < 64; o <<= 1) { const float t = __shfl_up(g, o); if (lane >= o) g += t; }
    const float bt = sigmoidf_(bl), eg = __expf(g);
    sGC[lane] = g; sBT[lane] = bt; sEG[lane] = eg; sR1[lane] = bt * eg;
    if (lane == 63) ((float*)(p.ws + OFF_DG))[it] = eg;
  }
  { const int tok = tid >> 3, cgp = tid & 7; float y[16]; const float* sCW = (const float*)(smem + 122880);
    u32x4 raw[3][4][2]; conv_fetch(p, proj, l, ci, hh, cgp, tok, raw);
    conv_apply(sCW, 0, cgp, raw, y);
    { float ss = 0.f;
#pragma unroll
      for (int c = 0; c < 16; ++c) ss += y[c] * y[c];
      ss += __shfl_xor(ss, 1); ss += __shfl_xor(ss, 2); ss += __shfl_xor(ss, 4);
      const float rn = rsqrtf(ss + 1e-6f) * 0.08838834764831845f;
#pragma unroll
      for (int c = 0; c < 16; ++c) y[c] *= rn;
      *(u32x4*)(sQB + tok * 136 + 16 * cgp) = pack8(y); *(u32x4*)(sQB + tok * 136 + 16 * cgp + 8) = pack8(y + 8); }
    conv_apply(sCW, 1, cgp, raw, y);
    { float ss = 0.f;
#pragma unroll
      for (int c = 0; c < 16; ++c) ss += y[c] * y[c];
      ss += __shfl_xor(ss, 1); ss += __shfl_xor(ss, 2); ss += __shfl_xor(ss, 4);
      const float rn = rsqrtf(ss + 1e-6f);
#pragma unroll
      for (int c = 0; c < 16; ++c) { y[c] *= rn; sKF[tok * 132 + 16 * cgp + c] = y[c]; }
      *(u32x4*)(sKB + tok * 136 + 16 * cgp) = pack8(y); *(u32x4*)(sKB + tok * 136 + 16 * cgp + 8) = pack8(y + 8); }
    conv_apply(sCW, 2, cgp, raw, y);
#pragma unroll
    for (int c = 0; c < 16; ++c) sVF[tok * 132 + 16 * cgp + c] = y[c];
  }
  __syncthreads();
  {
    const int mt = wid & 3; const bf16_t* Asrc = (wid < 4) ? sKB : sQB;
    bf16x8 a[4];
#pragma unroll
    for (int s = 0; s < 4; ++s) a[s] = *(const bf16x8*)(Asrc + (16 * mt + fr) * 136 + 32 * s + 8 * fq);
#pragma unroll
    for (int nt = 0; nt < 4; ++nt) {
      f32x4 c = {0.f, 0.f, 0.f, 0.f};
#pragma unroll
      for (int s = 0; s < 4; ++s) { const bf16x8 b = *(const bf16x8*)(sKB + (16 * nt + fr) * 136 + 32 * s + 8 * fq); c = MFMA16(a[s], b, c); }
      const int j = 16 * nt + fr; const float gj = sGC[j];
#pragma unroll
      for (int r = 0; r < 4; ++r) { const int i = 16 * mt + 4 * fq + r; const float gi = sGC[i]; const float dec = __expf(fminf(gi - gj, 0.f));
        if (wid < 4) sA[i * 64 + j] = (i > j) ? sBT[i] * c[r] * dec : 0.f;
        else dIN[i * 64 + (j & 32) + kinv(j & 31)] = f2bf((i >= j) ? c[r] * dec : 0.f); }
    }
  }
  __syncthreads();
  if (wid < 4) {
    int zv = 0; asm volatile("" : "+v"(zv));
    const int c = tid; const float* src = (c < 128) ? sVF + c : sKF + (c - 128); const float* scl = ((c < 128) ? sBT : sR1) + zv; const float* sAz = sA + zv;
    f32x2 sp[32];
#pragma unroll
    for (int i = 0; i < 32; ++i) sp[i] = (f32x2){0.f, 0.f};
    f32x4 Bk[2][8]; float rs[2], rc[2];
    f32x2 a0 = {0.f, 0.f}, a1 = {0.f, 0.f};
    rs[0] = src[0]; rc[0] = scl[0];
#pragma unroll
    for (int t = 0; t < 95; ++t) {
      const int i = t < 33 ? t : 33 + ((t - 33) >> 1), part = t < 33 ? 0 : ((t - 33) & 1), n = (i + 3) / 4;
      const int j0 = part * 8, j1 = (part == 0) ? (n < 8 ? n : 8) : n;
      const bool last = (part == 1) || (n <= 8);
      if (t + 1 < 95) { const int t2 = t + 1, i2 = t2 < 33 ? t2 : 33 + ((t2 - 33) >> 1), p2 = t2 < 33 ? 0 : ((t2 - 33) & 1), n2 = (i2 + 3) / 4;
        const int k0 = p2 * 8, k1 = (p2 == 0) ? (n2 < 8 ? n2 : 8) : n2;
#pragma unroll
        for (int j4 = k0; j4 < k1; ++j4) Bk[t2 & 1][j4 - k0] = *(const f32x4*)(sAz + i2 * 64 + 4 * j4);
        if (p2 == 0) { rs[t2 & 1] = src[i2 * 132]; rc[t2 & 1] = scl[i2]; } }
      __builtin_amdgcn_sched_barrier(0);
      if (part == 0) { a0 = (f32x2){rs[t & 1] * rc[t & 1], 0.f}; a1 = (f32x2){0.f, 0.f}; }
#pragma unroll
      for (int j4 = j0; j4 < j1; ++j4) { const f32x4 a = Bk[t & 1][j4 - j0];
        a0 -= (f32x2){a[0], a[1]} * sp[2 * j4]; a1 -= (f32x2){a[2], a[3]} * sp[2 * j4 + 1]; }
      if (last) { const f32x2 tt = a0 + a1; sp[i >> 1][i & 1] = tt[0] + tt[1]; }
      __builtin_amdgcn_sched_barrier(0);
    }
    float sol[64];
#pragma unroll
    for (int i = 0; i < 64; ++i) sol[i] = sp[i >> 1][i & 1];
    if (c < 128) {
#pragma unroll
      for (int q = 0; q < 8; ++q) *(u32x4*)(dUT + c * 64 + 8 * q) = pack8(sol + 8 * q);
    } else { const int d = c - 128, pos = (d & ~31) + kinv(d & 31);
#pragma unroll
      for (int i = 0; i < 64; ++i) dW[i * 128 + pos] = f2bf(-sol[i]); }
  } else {
    const int t = tid - 256; const float gl = sGC[63];
    { const int tok = t >> 2, db = t & 3; const float eg = sEG[tok]; float v[32];
#pragma unroll
      for (int pp = 0; pp < 32; ++pp) v[pp] = bf2f(sQB[tok * 136 + 32 * db + kperm(pp)]) * eg;
#pragma unroll
      for (int q = 0; q < 4; ++q) *(u32x4*)(dQ + tok * 128 + 32 * db + 8 * q) = pack8(v + 8 * q); }
    { const int d = t >> 1, tb = t & 1; float v[32];
#pragma unroll
      for (int pp = 0; pp < 32; ++pp) { const int tok = 32 * tb + kperm(pp); v[pp] = sKF[tok * 132 + d] * __expf(gl - sGC[tok]); }
#pragma unroll
      for (int q = 0; q < 4; ++q) *(u32x4*)(dKT + d * 64 + 32 * tb + 8 * q) = pack8(v + 8 * q); }
  }
  __syncthreads();
}

DI void ret_pre(const Params& p, int l, int it, unsigned char* smem) {
  const int ci = it >> 3, hh = it & 7, tid = otid(), wid = tid >> 6, lane = tid & 63, fr = lane & 15, fq = lane >> 4;
  bf16_t* sQB = (bf16_t*)smem; bf16_t* sKB = (bf16_t*)(smem + 17408); float* sKZ = (float*)(smem + 34816); float* sVF = (float*)(smem + 68608);
  const bf16_t* proj = (const bf16_t*)(p.ws + OFF_PROJ);
  bf16_t* m1 = (bf16_t*)(p.ws + OFF_M1);
  bf16_t* rQ = m1 + 4 * M1_BLK + (size_t)it * 8192; bf16_t* rKT = m1 + 5 * M1_BLK + (size_t)it * 8192; bf16_t* rVT = m1 + 6 * M1_BLK + (size_t)it * 8192;
  bf16_t* rIN = m1 + 8 * M1_BLK + (size_t)NITEM * 4096 + (size_t)it * 4096;
  const float lg = __logf(1.f - exp2f(-5.f - (float)hh));
  { const int tok = tid >> 3, cgp = tid & 7; const bf16_t* rp = proj + (size_t)(ci * 64 + tok) * LDP;
    const int pos = (ci >= 256) ? 2048 + tok : (ci & 63) * 64 + tok;
    float q1[8], q2[8], k1[8], k2[8], vv[16];
    unpack8(*(const u32x4*)(rp + 8192 + hh * 128 + 8 * cgp), q1); unpack8(*(const u32x4*)(rp + 8192 + hh * 128 + 64 + 8 * cgp), q2);
    unpack8(*(const u32x4*)(rp + 9216 + hh * 128 + 8 * cgp), k1); unpack8(*(const u32x4*)(rp + 9216 + hh * 128 + 64 + 8 * cgp), k2);
    unpack8(*(const u32x4*)(rp + 10240 + hh * 128 + 16 * cgp), vv); unpack8(*(const u32x4*)(rp + 10240 + hh * 128 + 16 * cgp + 8), vv + 8);
    const float zeta = __expf(lg * (float)(63 - tok)) * 0.08838834764831845f;
    float qa[8], qb[8], ka[8], kb[8];
#pragma unroll
    for (int j = 0; j < 8; ++j) { const int i = 8 * cgp + j;
      const float inv = exp2f(-(float)i * (13.287712379549449f / 64.f)); const float ang = (float)pos * inv;
      float rv = ang * 0.15915494309189535f; rv = rv - floorf(rv);
      const float sn = __builtin_amdgcn_sinf(rv), cs = __builtin_amdgcn_cosf(rv);
      qa[j] = q1[j] * cs - q2[j] * sn; qb[j] = q1[j] * sn + q2[j] * cs;
      ka[j] = (k1[j] * cs - k2[j] * sn); kb[j] = (k1[j] * sn + k2[j] * cs);
      sKZ[tok * 132 + i] = ka[j] * zeta; sKZ[tok * 132 + 64 + i] = kb[j] * zeta;
      ka[j] *= 0.08838834764831845f; kb[j] *= 0.08838834764831845f; }
    *(u32x4*)(sQB + tok * 136 + 8 * cgp) = pack8(qa); *(u32x4*)(sQB + tok * 136 + 64 + 8 * cgp) = pack8(qb);
    *(u32x4*)(sKB + tok * 136 + 8 * cgp) = pack8(ka); *(u32x4*)(sKB + tok * 136 + 64 + 8 * cgp) = pack8(kb);
#pragma unroll
    for (int c = 0; c < 16; ++c) sVF[tok * 132 + 16 * cgp + c] = vv[c];
  }
  __syncthreads();
  { const int mt = wid >> 1;
    bf16x8 a[4];
#pragma unroll
    for (int s = 0; s < 4; ++s) a[s] = *(const bf16x8*)(sQB + (16 * mt + fr) * 136 + 32 * s + 8 * fq);
#pragma unroll
    for (int n2 = 0; n2 < 2; ++n2) { const int nt = 2 * (wid & 1) + n2;
      f32x4 c = {0.f, 0.f, 0.f, 0.f};
#pragma unroll
      for (int s = 0; s < 4; ++s) { const bf16x8 b = *(const bf16x8*)(sKB + (16 * nt + fr) * 136 + 32 * s + 8 * fq); c = MFMA16(a[s], b, c); }
      const int j = 16 * nt + fr;
#pragma unroll
      for (int r = 0; r < 4; ++r) { const int i = 16 * mt + 4 * fq + r;
        rIN[i * 64 + (j & 32) + kinv(j & 31)] = f2bf((i >= j) ? c[r] * __expf(lg * (float)(i - j)) : 0.f); }
    }
  }
  write_perm(rQ, [&](int tok, int d) { return bf2f(sQB[tok * 136 + d]) * __expf(lg * (float)(tok + 1)); });
  write_T_perm(rKT, [&](int tok, int d) { return sKZ[tok * 132 + d]; });
  write_T_perm(rVT, [&](int tok, int e) { return sVF[tok * 132 + e]; });
  __syncthreads();
}

DI void misc_item(const Params& p, int l, int it, unsigned char* smem) {
  const int ci = it >> 3, hh = it & 7, tid = otid();
  bf16_t* sVB = (bf16_t*)smem;
  const bf16_t* proj = (const bf16_t*)(p.ws + OFF_PROJ);
  bf16_t* aVT = (bf16_t*)(p.ws + OFF_M1) + 7 * M1_BLK + (size_t)it * 8192;
  { const int tok = tid >> 3, cgp = tid & 7; const bf16_t* rp = proj + (size_t)(ci * 64 + tok) * LDP;
    const u32x4 v0 = *(const u32x4*)(rp + 2048 + hh * 128 + 16 * cgp), v1 = *(const u32x4*)(rp + 2048 + hh * 128 + 16 * cgp + 8);
    *(u32x4*)(sVB + tok * 136 + 16 * cgp) = v0; *(u32x4*)(sVB + tok * 136 + 16 * cgp + 8) = v1;
    float* ok = nullptr; float* ov = nullptr;
    if (ci < 256) { const int b = ci >> 6, c = ci & 63;
      if (c >= 56) { const size_t o = ((((size_t)l * 4 + b) * 512 + (c - 56) * 64 + tok) * 8 + hh) * 128 + 16 * cgp; ok = p.out + O_PK + o; ov = p.out + O_PV + o; }
    } else { const size_t o = ((((size_t)l * 8 + (ci - 256)) * 512 + 448 + tok) * 8 + hh) * 128 + 16 * cgp; ok = p.out + O_SK + o; ov = p.out + O_SV + o; }
    if (ok) { float f[16]; unpack8(v0, f); unpack8(v1, f + 8);
#pragma unroll
      for (int q = 0; q < 4; ++q) *(f32x4*)(ov + 4 * q) = (f32x4){f[4 * q], f[4 * q + 1], f[4 * q + 2], f[4 * q + 3]};
      unpack8(*(const u32x4*)(rp + 1024 + hh * 128 + 16 * cgp), f); unpack8(*(const u32x4*)(rp + 1024 + hh * 128 + 16 * cgp + 8), f + 8);
#pragma unroll
      for (int q = 0; q < 4; ++q) *(f32x4*)(ok + 4 * q) = (f32x4){f[4 * q], f[4 * q + 1], f[4 * q + 2], f[4 * q + 3]}; }
  }
  if (ci >= 256 || (ci & 63) == 63) {
    float* oc = (ci < 256) ? p.out + O_PC + ((size_t)l * 4 + (ci >> 6)) * 3 * 3072 : p.out + O_SC + ((size_t)l * 8 + (ci - 256)) * 3 * 3072;
    for (int idx = tid; idx < 3 * 384; idx += 512) { const int rr = idx / 384, ch = hh * 384 + idx % 384;
      oc[rr * 3072 + ch] = bf2f(proj[(size_t)(ci * 64 + 61 + rr) * LDP + 4096 + ch]); }
  }
  __syncthreads();
  write_T_perm(aVT, [&](int tok, int e) { return bf2f(sVB[tok * 136 + e]); });
  __syncthreads();
}
DI void cache_item(const Params& p, int l, int cit, unsigned char* smem) {
  const int hh = cit & 7, j = (cit >> 3) & 7, sb = cit >> 6, tid = otid();
  float* sVF = (float*)smem;
  bf16_t* kc = (bf16_t*)(p.ws + OFF_KC) + (size_t)cit * 8192; bf16_t* cvt = (bf16_t*)(p.ws + OFF_CVT) + (size_t)cit * 8192;
  { const int key = tid >> 3, cgp = tid & 7;
    const size_t so = ((((size_t)l * 8 + sb) * 512 + 64 * j + key) * 8 + hh) * 128 + 16 * cgp;
    float fk[16], fv[16];
#pragma unroll
    for (int q = 0; q < 4; ++q) { const f32x4 a = *(const f32x4*)(p.cache_k + so + 4 * q); const f32x4 b = *(const f32x4*)(p.cache_v + so + 4 * q);
#pragma unroll
      for (int e = 0; e < 4; ++e) { fk[4 * q + e] = a[e]; fv[4 * q + e] = b[e]; } }
    *(u32x4*)(kc + key * 128 + 16 * cgp) = pack8(fk); *(u32x4*)(kc + key * 128 + 16 * cgp + 8) = pack8(fk + 8);
#pragma unroll
    for (int c = 0; c < 16; ++c) sVF[key * 132 + 16 * cgp + c] = fv[c];
    if (j >= 1) { const size_t oo = ((((size_t)l * 8 + sb) * 512 + 64 * (j - 1) + key) * 8 + hh) * 128 + 16 * cgp;
#pragma unroll
      for (int q = 0; q < 4; ++q) { *(f32x4*)(p.out + O_SK + oo + 4 * q) = (f32x4){fk[4 * q], fk[4 * q + 1], fk[4 * q + 2], fk[4 * q + 3]};
        *(f32x4*)(p.out + O_SV + oo + 4 * q) = (f32x4){fv[4 * q], fv[4 * q + 1], fv[4 * q + 2], fv[4 * q + 3]}; } }
  }
  __syncthreads();
  write_T_perm(cvt, [&](int tok, int e) { return sVF[tok * 132 + e]; });
  __syncthreads();
}

template <int TYPE> DI void scan_item(const Params& p, int l, int seq, int hh, int sl) {
  const int lane = otid() & 63, fr = lane & 15, fq = lane >> 4, e0 = 16 * sl;
  const int nsteps = seq < 4 ? 64 : 1, ci0 = seq < 4 ? seq * 64 : 256 + (seq - 4);
  const bf16_t* m1 = (const bf16_t*)(p.ws + OFF_M1);
  bf16_t* proj = (bf16_t*)(p.ws + OFF_PROJ);
  const float* dG = (const float*)(p.ws + OFF_DG);
  f32x4 S[8];
  if (seq < 4) {
#pragma unroll
    for (int t = 0; t < 8; ++t) S[t] = (f32x4){0.f, 0.f, 0.f, 0.f};
  } else { const float* st = (TYPE == 0 ? p.state_delta : p.state_ret) + (((size_t)l * 8 + (seq - 4)) * 8 + hh) * 16384 + e0 + fr;
#pragma unroll
    for (int t = 0; t < 8; ++t)
#pragma unroll
      for (int i = 0; i < 4; ++i) S[t][i] = st[(16 * t + 4 * fq + i) * 128]; }
  const float gret = __expf(64.f * __logf(1.f - exp2f(-5.f - (float)hh)));
  for (int n = 0; n < nsteps; ++n) {
    const int it = (ci0 + n) * 8 + hh;
    const bf16_t* W = m1 + 0 * M1_BLK + (size_t)it * 8192;
    const bf16_t* Q = m1 + (TYPE == 0 ? 1 : 4) * M1_BLK + (size_t)it * 8192;
    const bf16_t* KT = m1 + (TYPE == 0 ? 2 : 5) * M1_BLK + (size_t)it * 8192;
    const bf16_t* UT = m1 + (TYPE == 0 ? 3 : 6) * M1_BLK + (size_t)it * 8192;
    const bf16_t* IN = m1 + 8 * M1_BLK + (TYPE == 0 ? 0 : (size_t)NITEM * 4096) + (size_t)it * 4096;
    bf16x8 Sf[4];
#pragma unroll
    for (int s = 0; s < 4; ++s) Sf[s] = pack_frag(S[2 * s], S[2 * s + 1]);
    bf16x8 Vf[2];
    if (TYPE == 0) {
      f32x4 Vn[4];
#pragma unroll
      for (int mt = 0; mt < 4; ++mt) { const u32x2 u = *(const u32x2*)(UT + (e0 + fr) * 64 + 16 * mt + 4 * fq); Vn[mt] = (f32x4){bflo(u.x), bfhi(u.x), bflo(u.y), bfhi(u.y)}; }
#pragma unroll
      for (int s = 0; s < 4; ++s)
#pragma unroll
        for (int mt = 0; mt < 4; ++mt) { const bf16x8 a = *(const bf16x8*)(W + (16 * mt + fr) * 128 + 32 * s + 8 * fq); Vn[mt] = MFMA16(a, Sf[s], Vn[mt]); }
      Vf[0] = pack_frag(Vn[0], Vn[1]); Vf[1] = pack_frag(Vn[2], Vn[3]);
    } else {
      Vf[0] = *(const bf16x8*)(UT + (e0 + fr) * 64 + 8 * fq); Vf[1] = *(const bf16x8*)(UT + (e0 + fr) * 64 + 32 + 8 * fq);
    }
    f32x4 O[4];
#pragma unroll
    for (int nt = 0; nt < 4; ++nt) O[nt] = (f32x4){0.f, 0.f, 0.f, 0.f};
#pragma unroll
    for (int s = 0; s < 4; ++s)
#pragma unroll
      for (int nt = 0; nt < 4; ++nt) { const bf16x8 b = *(const bf16x8*)(Q + (16 * nt + fr) * 128 + 32 * s + 8 * fq); O[nt] = MFMA16(Sf[s], b, O[nt]); }
#pragma unroll
    for (int s2 = 0; s2 < 2; ++s2)
#pragma unroll
      for (int nt = 0; nt < 4; ++nt) { const bf16x8 b = *(const bf16x8*)(IN + (16 * nt + fr) * 64 + 32 * s2 + 8 * fq); O[nt] = MFMA16(Vf[s2], b, O[nt]); }
#pragma unroll
    for (int nt = 0; nt < 4; ++nt) { u32x2 w; w.x = pk2(O[nt][0], O[nt][1]); w.y = pk2(O[nt][2], O[nt][3]);
      *(u32x2*)(proj + (size_t)((ci0 + n) * 64 + 16 * nt + fr) * LDP + (TYPE == 0 ? C_OBRAW : C_OCRAW) + hh * 128 + e0 + 4 * fq) = w; }
    const float gb = (TYPE == 0) ? dG[it] : gret;
#pragma unroll
    for (int dt = 0; dt < 8; ++dt) { S[dt] = S[dt] * gb;
#pragma unroll
      for (int s2 = 0; s2 < 2; ++s2) { const bf16x8 a = *(const bf16x8*)(KT + (16 * dt + fr) * 64 + 32 * s2 + 8 * fq); S[dt] = MFMA16(a, Vf[s2], S[dt]); } }
  }
  { float* so = p.out + (seq < 4 ? (TYPE == 0 ? O_PD : O_PR) + (((size_t)l * 4 + seq) * 8 + hh) * 16384 : (TYPE == 0 ? O_SD : O_SR) + (((size_t)l * 8 + (seq - 4)) * 8 + hh) * 16384) + e0 + fr;
#pragma unroll
    for (int t = 0; t < 8; ++t)
#pragma unroll
      for (int i = 0; i < 4; ++i) so[(16 * t + 4 * fq + i) * 128] = S[t][i]; }
}

template <int TYPE> DI void scan_step(const unsigned char* B, f32x4 (&S)[8], const u32x4 (&uc)[2], float gb, bf16_t* orow, int fr, int fq) {
#define SW_A128(base_, row_, s_) (*(const bf16x8*)((base_) + (((row_) * 16 + ((4 * (s_) + fq) ^ fr)) * 16)))
#define SW_A64(base_, row_, s_) (*(const bf16x8*)((base_) + (((row_) * 8 + ((4 * (s_) + fq) ^ (fr >> 1))) * 16)))
  bf16x8 Sf[4];
#pragma unroll
  for (int s = 0; s < 4; ++s) Sf[s] = pack_frag(S[2 * s], S[2 * s + 1]);
  bf16x8 Vf[2];
  if (TYPE == 0) {
    f32x4 Vn[4];
#pragma unroll
    for (int mt = 0; mt < 4; ++mt) { const unsigned ux = uc[mt >> 1][(mt & 1) * 2], uy = uc[mt >> 1][(mt & 1) * 2 + 1]; Vn[mt] = (f32x4){bflo(ux), bfhi(ux), bflo(uy), bfhi(uy)}; }
#pragma unroll
    for (int s = 0; s < 4; ++s)
#pragma unroll
      for (int mt = 0; mt < 4; ++mt) Vn[mt] = MFMA16(SW_A128(B, 16 * mt + fr, s), Sf[s], Vn[mt]);
    Vf[0] = pack_frag(Vn[0], Vn[1]); Vf[1] = pack_frag(Vn[2], Vn[3]);
  } else { Vf[0] = __builtin_bit_cast(bf16x8, uc[0]); Vf[1] = __builtin_bit_cast(bf16x8, uc[1]); }
  f32x4 O[4];
#pragma unroll
  for (int nt = 0; nt < 4; ++nt) O[nt] = (f32x4){0.f, 0.f, 0.f, 0.f};
#pragma unroll
  for (int s = 0; s < 4; ++s)
#pragma unroll
    for (int nt = 0; nt < 4; ++nt) O[nt] = MFMA16(Sf[s], SW_A128(B + 16384, 16 * nt + fr, s), O[nt]);
#pragma unroll
  for (int s2 = 0; s2 < 2; ++s2)
#pragma unroll
    for (int nt = 0; nt < 4; ++nt) O[nt] = MFMA16(Vf[s2], SW_A64(B + 49152, 16 * nt + fr, s2), O[nt]);
#pragma unroll
  for (int nt = 0; nt < 4; ++nt) { u32x2 w; w.x = pk2(O[nt][0], O[nt][1]); w.y = pk2(O[nt][2], O[nt][3]); *(u32x2*)(orow + (size_t)(16 * nt) * LDP) = w; }
#pragma unroll
  for (int dt = 0; dt < 8; ++dt) { S[dt] = S[dt] * gb;
#pragma unroll
    for (int s2 = 0; s2 < 2; ++s2) S[dt] = MFMA16(SW_A64(B + 32768, 16 * dt + fr, s2), Vf[s2], S[dt]); }
#undef SW_A128
#undef SW_A64
}
template <int TYPE> DI void scan_wg(const Params& p, int l, int seq, int hh, unsigned char* smem) {
  const int tid = otid(), lane = tid & 63, wv = tid >> 6, fr = lane & 15, fq = lane >> 4, e0 = 16 * wv;
  const int ci0 = seq * 64;
  const bf16_t* m1 = (const bf16_t*)(p.ws + OFF_M1);
  bf16_t* proj = (bf16_t*)(p.ws + OFF_PROJ);
  const float* dG = (const float*)(p.ws + OFF_DG);
  const bf16_t* gW = m1 + 0 * M1_BLK; const bf16_t* gQ = m1 + (TYPE == 0 ? 1 : 4) * M1_BLK; const bf16_t* gKT = m1 + (TYPE == 0 ? 2 : 5) * M1_BLK;
  const bf16_t* gUT = m1 + (TYPE == 0 ? 3 : 6) * M1_BLK; const bf16_t* gIN = m1 + 8 * M1_BLK + (TYPE == 0 ? 0 : (size_t)NITEM * 4096);
  f32x4 S[8];
#pragma unroll
  for (int t = 0; t < 8; ++t) S[t] = (f32x4){0.f, 0.f, 0.f, 0.f};
  const float gvec = (TYPE == 0) ? dG[(ci0 + lane) * 8 + hh] : __expf(64.f * __logf(1.f - exp2f(-5.f - (float)hh)));
  int d128[2], d64[2];
#pragma unroll
  for (int k = 0; k < 2; ++k) { const int q = tid + 512 * k; { const int r = q >> 4, c = q & 15; d128[k] = (r * 16 + (c ^ (r & 15))) * 16; }
    { const int r = q >> 3, c = q & 7; d64[k] = (r * 8 + (c ^ ((r >> 1) & 7))) * 16; } }
  u32x4 st[2][7]; u32x4 uv[2][2];
#define SW_ISSUE(n_, X_) do { const size_t it_ = (size_t)((ci0 + (n_)) * 8 + hh); \
    if (TYPE == 0) { st[X_][0] = *(const u32x4*)(gW + it_ * 8192 + tid * 8); st[X_][1] = *(const u32x4*)(gW + it_ * 8192 + (tid + 512) * 8); } \
    st[X_][2] = *(const u32x4*)(gQ + it_ * 8192 + tid * 8); st[X_][3] = *(const u32x4*)(gQ + it_ * 8192 + (tid + 512) * 8); \
    st[X_][4] = *(const u32x4*)(gKT + it_ * 8192 + tid * 8); st[X_][5] = *(const u32x4*)(gKT + it_ * 8192 + (tid + 512) * 8); \
    st[X_][6] = *(const u32x4*)(gIN + it_ * 4096 + tid * 8); \
    if (TYPE == 0) { _Pragma("unroll") for (int mt = 0; mt < 4; ++mt) { const u32x2 u_ = *(const u32x2*)(gUT + it_ * 8192 + (e0 + fr) * 64 + 16 * mt + 4 * fq); uv[X_][mt >> 1][(mt & 1) * 2] = u_.x; uv[X_][mt >> 1][(mt & 1) * 2 + 1] = u_.y; } } \
    else { uv[X_][0] = *(const u32x4*)(gUT + it_ * 8192 + (e0 + fr) * 64 + 8 * fq); uv[X_][1] = *(const u32x4*)(gUT + it_ * 8192 + (e0 + fr) * 64 + 32 + 8 * fq); } } while (0)
#define SW_COMMIT(b_, X_) do { unsigned char* B_ = smem + (b_) * 57344; \
    if (TYPE == 0) { *(u32x4*)(B_ + d128[0]) = st[X_][0]; *(u32x4*)(B_ + d128[1]) = st[X_][1]; } \
    *(u32x4*)(B_ + 16384 + d128[0]) = st[X_][2]; *(u32x4*)(B_ + 16384 + d128[1]) = st[X_][3]; \
    *(u32x4*)(B_ + 32768 + d64[0]) = st[X_][4]; *(u32x4*)(B_ + 32768 + d64[1]) = st[X_][5]; *(u32x4*)(B_ + 49152 + d64[0]) = st[X_][6]; \
    ucur[0] = uv[X_][0]; ucur[1] = uv[X_][1]; } while (0)
  u32x4 ucur[2];
  bf16_t* obase = proj + (size_t)(ci0 * 64 + fr) * LDP + (TYPE == 0 ? C_OBRAW : C_OCRAW) + hh * 128 + e0 + 4 * fq;
  SW_ISSUE(0, 0);
  SW_COMMIT(0, 0);
  SW_ISSUE(1, 1);
  __syncthreads();
  for (int n = 0; n < 64; n += 2) {
    if (n + 2 < 64) SW_ISSUE(n + 2, 0);
    scan_step<TYPE>(smem, S, ucur, __shfl(gvec, n), obase + (size_t)(n * 64) * LDP, fr, fq);
    SW_COMMIT(1, 1);
    __syncthreads();
    if (n + 3 < 64) SW_ISSUE(n + 3, 1);
    scan_step<TYPE>(smem + 57344, S, ucur, __shfl(gvec, n + 1), obase + (size_t)((n + 1) * 64) * LDP, fr, fq);
    if (n + 2 < 64) SW_COMMIT(0, 0);
    __syncthreads();
  }
#undef SW_ISSUE
#undef SW_COMMIT
  { float* so = p.out + (TYPE == 0 ? O_PD : O_PR) + (((size_t)l * 4 + seq) * 8 + hh) * 16384 + e0 + fr;
#pragma unroll
    for (int t = 0; t < 8; ++t)
#pragma unroll
      for (int i = 0; i < 4; ++i) so[(16 * t + 4 * fq + i) * 128] = S[t][i]; }
}

template <int TYPE> DI void scan_step2(const unsigned char* B, f32x4 (&S)[2][8], const u32x4 (&uc)[2][2], float gb, bf16_t* orow, int fr, int fq) {
#define SW_A128(base_, row_, s_) (*(const bf16x8*)((base_) + (((row_) * 16 + ((4 * (s_) + fq) ^ fr)) * 16)))
#define SW_A64(base_, row_, s_) (*(const bf16x8*)((base_) + (((row_) * 8 + ((4 * (s_) + fq) ^ (fr >> 1))) * 16)))
  bf16x8 Sf[2][4];
#pragma unroll
  for (int c = 0; c < 2; ++c)
#pragma unroll
    for (int s = 0; s < 4; ++s) Sf[c][s] = pack_frag(S[c][2 * s], S[c][2 * s + 1]);
  bf16x8 Vf[2][2];
  if (TYPE == 0) {
    f32x4 Vn[2][4];
#pragma unroll
    for (int c = 0; c < 2; ++c)
#pragma unroll
      for (int mt = 0; mt < 4; ++mt) { const unsigned ux = uc[c][mt >> 1][(mt & 1) * 2], uy = uc[c][mt >> 1][(mt & 1) * 2 + 1]; Vn[c][mt] = (f32x4){bflo(ux), bfhi(ux), bflo(uy), bfhi(uy)}; }
#pragma unroll
    for (int s = 0; s < 4; ++s)
#pragma unroll
      for (int mt = 0; mt < 4; ++mt) { const bf16x8 a = SW_A128(B, 16 * mt + fr, s); Vn[0][mt] = MFMA16(a, Sf[0][s], Vn[0][mt]); Vn[1][mt] = MFMA16(a, Sf[1][s], Vn[1][mt]); }
#pragma unroll
    for (int c = 0; c < 2; ++c) { Vf[c][0] = pack_frag(Vn[c][0], Vn[c][1]); Vf[c][1] = pack_frag(Vn[c][2], Vn[c][3]); }
  } else {
#pragma unroll
    for (int c = 0; c < 2; ++c) { Vf[c][0] = __builtin_bit_cast(bf16x8, uc[c][0]); Vf[c][1] = __builtin_bit_cast(bf16x8, uc[c][1]); }
  }
  f32x4 O[2][4];
#pragma unroll
  for (int c = 0; c < 2; ++c)
#pragma unroll
    for (int nt = 0; nt < 4; ++nt) O[c][nt] = (f32x4){0.f, 0.f, 0.f, 0.f};
#pragma unroll
  for (int s = 0; s < 4; ++s)
#pragma unroll
    for (int nt = 0; nt < 4; ++nt) { const bf16x8 b = SW_A128(B + 16384, 16 * nt + fr, s); O[0][nt] = MFMA16(Sf[0][s], b, O[0][nt]); O[1][nt] = MFMA16(Sf[1][s], b, O[1][nt]); }
#pragma unroll
  for (int s2 = 0; s2 < 2; ++s2)
#pragma unroll
    for (int nt = 0; nt < 4; ++nt) { const bf16x8 b = SW_A64(B + 49152, 16 * nt + fr, s2); O[0][nt] = MFMA16(Vf[0][s2], b, O[0][nt]); O[1][nt] = MFMA16(Vf[1][s2], b, O[1][nt]); }
#pragma unroll
  for (int c = 0; c < 2; ++c)
#pragma unroll
    for (int nt = 0; nt < 4; ++nt) { u32x2 w; w.x = pk2(O[c][nt][0], O[c][nt][1]); w.y = pk2(O[c][nt][2], O[c][nt][3]); *(u32x2*)(orow + (size_t)(16 * nt) * LDP + 16 * c) = w; }
#pragma unroll
  for (int dt = 0; dt < 8; ++dt) { S[0][dt] = S[0][dt] * gb; S[1][dt] = S[1][dt] * gb;
#pragma unroll
    for (int s2 = 0; s2 < 2; ++s2) { const bf16x8 a = SW_A64(B + 32768, 16 * dt + fr, s2); S[0][dt] = MFMA16(a, Vf[0][s2], S[0][dt]); S[1][dt] = MFMA16(a, Vf[1][s2], S[1][dt]); } }
#undef SW_A128
#undef SW_A64
}
template <int TYPE> DI void scan_wg2(const Params& p, int l, int seq, int hh, unsigned char* smem) {
  const int tid = otid(), lane = tid & 63, wv = tid >> 6, fr = lane & 15, fq = lane >> 4;
  const int ci0 = seq * 64;
  const bf16_t* m1 = (const bf16_t*)(p.ws + OFF_M1);
  const bf16_t* gW = m1 + 0 * M1_BLK; const bf16_t* gQ = m1 + (TYPE == 0 ? 1 : 4) * M1_BLK; const bf16_t* gKT = m1 + (TYPE == 0 ? 2 : 5) * M1_BLK;
  const bf16_t* gUT = m1 + (TYPE == 0 ? 3 : 6) * M1_BLK; const bf16_t* gIN = m1 + 8 * M1_BLK + (TYPE == 0 ? 0 : (size_t)NITEM * 4096);
  if (wv >= 4) {
    const int lt = tid - 256;
    const int b128 = ((lt >> 4) * 16 + ((lt & 15) ^ ((lt >> 4) & 15))) * 16, b64 = ((lt >> 3) * 8 + ((lt & 7) ^ ((lt >> 4) & 7))) * 16;
    u32x4 st[2][14];
#define LW_ISSUE(n_, X_) do { const size_t it_ = (size_t)((ci0 + (n_)) * 8 + hh); \
      _Pragma("unroll") for (int k = 0; k < 4; ++k) { if (TYPE == 0) st[X_][k] = *(const u32x4*)(gW + it_ * 8192 + (lt + 256 * k) * 8); \
        st[X_][4 + k] = *(const u32x4*)(gQ + it_ * 8192 + (lt + 256 * k) * 8); st[X_][8 + k] = *(const u32x4*)(gKT + it_ * 8192 + (lt + 256 * k) * 8); } \
      st[X_][12] = *(const u32x4*)(gIN + it_ * 4096 + lt * 8); st[X_][13] = *(const u32x4*)(gIN + it_ * 4096 + (lt + 256) * 8); } while (0)
#define LW_COMMIT(b_, X_) do { unsigned char* B_ = smem + (b_) * 57344; \
      _Pragma("unroll") for (int k = 0; k < 4; ++k) { if (TYPE == 0) *(u32x4*)(B_ + b128 + k * 4096) = st[X_][k]; \
        *(u32x4*)(B_ + 16384 + b128 + k * 4096) = st[X_][4 + k]; *(u32x4*)(B_ + 32768 + b64 + k * 4096) = st[X_][8 + k]; } \
      *(u32x4*)(B_ + 49152 + b64) = st[X_][12]; *(u32x4*)(B_ + 49152 + b64 + 4096) = st[X_][13]; } while (0)
    LW_ISSUE(0, 0); LW_COMMIT(0, 0); LW_ISSUE(1, 1);
    __syncthreads();
    for (int n = 0; n < 64; n += 2) {
      if (n + 2 < 64) LW_ISSUE(n + 2, 0);
      LW_COMMIT(1, 1);
      __syncthreads();
      if (n + 3 < 64) LW_ISSUE(n + 3, 1);
      if (n + 2 < 64) LW_COMMIT(0, 0);
      __syncthreads();
    }
#undef LW_ISSUE
#undef LW_COMMIT
  } else {
    const int e0 = 32 * wv;
    bf16_t* proj = (bf16_t*)(p.ws + OFF_PROJ);
    const float* dG = (const float*)(p.ws + OFF_DG);
    f32x4 S[2][8];
#pragma unroll
    for (int c = 0; c < 2; ++c)
#pragma unroll
      for (int t = 0; t < 8; ++t) S[c][t] = (f32x4){0.f, 0.f, 0.f, 0.f};
    const float gvec = (TYPE == 0) ? dG[(ci0 + lane) * 8 + hh] : __expf(64.f * __logf(1.f - exp2f(-5.f - (float)hh)));
    u32x4 ucur[2][2], unext[2][2];
#define CW_ULOAD(n_, dst_) do { const size_t it_ = (size_t)((ci0 + (n_)) * 8 + hh); _Pragma("unroll") for (int c = 0; c < 2; ++c) { \
      if (TYPE == 0) { _Pragma("unroll") for (int mt = 0; mt < 4; ++mt) { const u32x2 u_ = *(const u32x2*)(gUT + it_ * 8192 + (e0 + 16 * c + fr) * 64 + 16 * mt + 4 * fq); dst_[c][mt >> 1][(mt & 1) * 2] = u_.x; dst_[c][mt >> 1][(mt & 1) * 2 + 1] = u_.y; } } \
      else { dst_[c][0] = *(const u32x4*)(gUT + it_ * 8192 + (e0 + 16 * c + fr) * 64 + 8 * fq); dst_[c][1] = *(const u32x4*)(gUT + it_ * 8192 + (e0 + 16 * c + fr) * 64 + 32 + 8 * fq); } } } while (0)
    bf16_t* obase = proj + (size_t)(ci0 * 64 + fr) * LDP + (TYPE == 0 ? C_OBRAW : C_OCRAW) + hh * 128 + e0 + 4 * fq;
    CW_ULOAD(0, ucur);
    __syncthreads();
    for (int n = 0; n < 64; ++n) {
      if (n + 1 < 64) CW_ULOAD(n + 1, unext);
      scan_step2<TYPE>(smem + (n & 1) * 57344, S, ucur, __shfl(gvec, n), obase + (size_t)(n * 64) * LDP, fr, fq);
#pragma unroll
      for (int c = 0; c < 2; ++c) { ucur[c][0] = unext[c][0]; ucur[c][1] = unext[c][1]; }
      __syncthreads();
    }
#undef CW_ULOAD
    { float* so = p.out + (TYPE == 0 ? O_PD : O_PR) + (((size_t)l * 4 + seq) * 8 + hh) * 16384 + e0 + fr;
#pragma unroll
      for (int c = 0; c < 2; ++c)
#pragma unroll
        for (int t = 0; t < 8; ++t)
#pragma unroll
          for (int i = 0; i < 4; ++i) so[(16 * t + 4 * fq + i) * 128 + 16 * c] = S[c][t][i]; }
  }
}

DI void attn_item(const Params& p, int l, int ai) {
  const int qt = ai & 3, hh = (ai >> 2) & 7, ci = ai >> 5;
  const int lane = otid() & 63, fr = lane & 15, fq = lane >> 4;
  bf16_t* proj = (bf16_t*)(p.ws + OFF_PROJ);
  const bf16_t* aVT = (const bf16_t*)(p.ws + OFF_M1) + 7 * M1_BLK;
  const bf16_t* kcb = (const bf16_t*)(p.ws + OFF_KC); const bf16_t* cvt = (const bf16_t*)(p.ws + OFF_CVT);
  const float* rb = p.rel_bias + ((size_t)l * 8 + hh) * 257;
  const int qrow = ci * 64 + 16 * qt + fr;
  bf16x8 Qf[4];
#pragma unroll
  for (int s = 0; s < 4; ++s) Qf[s] = *(const bf16x8*)(proj + (size_t)qrow * LDP + hh * 128 + 32 * s + 8 * fq);
  const int jmin = (ci < 256) ? ((ci & 63) >= 8 ? 0 : 8 - (ci & 63)) : 0;
  const float bfar = rb[256]; const int iq = 16 * qt + fr;
  float m = -1e30f, lsum = 0.f;
  f32x4 O[8];
#pragma unroll
  for (int et = 0; et < 8; ++et) O[et] = (f32x4){0.f, 0.f, 0.f, 0.f};
#pragma unroll 1
  for (int grp = 0; grp < 3; ++grp) {
    if (3 * grp + 2 < jmin) continue;
    f32x4 sc[12]; float gmx = -1e30f;
#pragma unroll
    for (int jj = 0; jj < 3; ++jj) { const int j = 3 * grp + jj;
      if (j >= jmin) {
        const bf16_t* Kp; int ks;
        if (ci < 256 || j == 8) { Kp = proj + (size_t)((ci < 256 ? ci - 8 + j : ci) * 64) * LDP + 1024 + hh * 128; ks = LDP; }
        else { Kp = kcb + (size_t)(((ci - 256) * 8 + j) * 8 + hh) * 8192; ks = 128; }
#pragma unroll
        for (int kt = 0; kt < 4; ++kt) {
          f32x4 c = {0.f, 0.f, 0.f, 0.f};
#pragma unroll
          for (int s = 0; s < 4; ++s) { const bf16x8 a = *(const bf16x8*)(Kp + (size_t)(16 * kt + fr) * ks + 32 * s + 8 * fq); c = MFMA16(a, Qf[s], c); }
#pragma unroll
          for (int i = 0; i < 4; ++i) { float bias = bfar;
            if (grp == 2) { const int r = 64 * j + 16 * kt + 4 * fq + i; int dist = 512 + iq - r; dist = dist < -128 ? -128 : (dist > 128 ? 128 : dist); bias = rb[dist + 128]; }
            c[i] = c[i] * 0.08838834764831845f + bias; gmx = fmaxf(gmx, c[i]); }
          sc[4 * jj + kt] = c;
        }
      } else {
#pragma unroll
        for (int kt = 0; kt < 4; ++kt) sc[4 * jj + kt] = (f32x4){-1e30f, -1e30f, -1e30f, -1e30f};
      }
    }
    gmx = fmaxf(gmx, __shfl_xor(gmx, 16)); gmx = fmaxf(gmx, __shfl_xor(gmx, 32));
    const float mnew = fmaxf(m, gmx), alpha = __expf(m - mnew); m = mnew;
    lsum *= alpha;
#pragma unroll
    for (int et = 0; et < 8; ++et) O[et] = O[et] * alpha;
#pragma unroll
    for (int t = 0; t < 12; ++t)
#pragma unroll
      for (int i = 0; i < 4; ++i) { const float e = __expf(sc[t][i] - m); sc[t][i] = e; lsum += e; }
#pragma unroll
    for (int jj = 0; jj < 3; ++jj) { const int j = 3 * grp + jj;
      if (j >= jmin) {
        const bf16_t* Vp;
        if (ci < 256 || j == 8) Vp = aVT + (size_t)((ci < 256 ? ci - 8 + j : ci) * 8 + hh) * 8192;
        else Vp = cvt + (size_t)(((ci - 256) * 8 + j) * 8 + hh) * 8192;
#pragma unroll
        for (int s2 = 0; s2 < 2; ++s2) { const bf16x8 pf = pack_frag(sc[4 * jj + 2 * s2], sc[4 * jj + 2 * s2 + 1]);
#pragma unroll
          for (int et = 0; et < 8; ++et) { const bf16x8 a = *(const bf16x8*)(Vp + (16 * et + fr) * 64 + 32 * s2 + 8 * fq); O[et] = MFMA16(a, pf, O[et]); } }
      }
    }
  }
  lsum += __shfl_xor(lsum, 16); lsum += __shfl_xor(lsum, 32);
  const float inv = __builtin_amdgcn_rcpf(lsum);
#pragma unroll
  for (int et = 0; et < 8; ++et) { const u32x2 z = *(const u32x2*)(proj + (size_t)qrow * LDP + 3072 + hh * 128 + 16 * et + 4 * fq);
    u32x2 w; w.x = pk2(O[et][0] * inv * siluf_(bflo(z.x)), O[et][1] * inv * siluf_(bfhi(z.x))); w.y = pk2(O[et][2] * inv * siluf_(bflo(z.y)), O[et][3] * inv * siluf_(bfhi(z.y)));
    *(u32x2*)(proj + (size_t)qrow * LDP + C_ACAT + hh * 128 + 16 * et + 4 * fq) = w; }
}

DI void attn_stage(const unsigned char* Kl, const float* sB, int j, int iq, float bfar, const bf16x8 (&Qf)[4], f32x4 (&O)[8], float& m, float& lsum, int fr, int fq) {
#define AW_A128(base_, row_, s_) (*(const bf16x8*)((base_) + (((row_) * 16 + ((4 * (s_) + fq) ^ fr)) * 16)))
#define AW_A64(base_, row_, s_) (*(const bf16x8*)((base_) + (((row_) * 8 + ((4 * (s_) + fq) ^ (fr >> 1))) * 16)))
  const unsigned char* Vl = Kl + 32768;
  f32x4 sc[4]; float gmx = -1e30f;
#pragma unroll
  for (int kt = 0; kt < 4; ++kt) {
    f32x4 c = {0.f, 0.f, 0.f, 0.f};
#pragma unroll
    for (int s = 0; s < 4; ++s) c = MFMA16(AW_A128(Kl, 16 * kt + fr, s), Qf[s], c);
#pragma unroll
    for (int i = 0; i < 4; ++i) { float bias = bfar;
      if (j >= 6) { const int r = 64 * j + 16 * kt + 4 * fq + i; int dist = 512 + iq - r; dist = dist < -128 ? -128 : (dist > 128 ? 128 : dist); bias = sB[dist + 128]; }
      c[i] = c[i] * 0.08838834764831845f + bias; gmx = fmaxf(gmx, c[i]); }
    sc[kt] = c;
  }
  gmx = fmaxf(gmx, __shfl_xor(gmx, 16)); gmx = fmaxf(gmx, __shfl_xor(gmx, 32));
  const float mnew = fmaxf(m, gmx), alpha = __expf(m - mnew); m = mnew;
  lsum *= alpha;
#pragma unroll
  for (int et = 0; et < 8; ++et) O[et] = O[et] * alpha;
#pragma unroll
  for (int kt = 0; kt < 4; ++kt)
#pragma unroll
    for (int i = 0; i < 4; ++i) { const float e = __expf(sc[kt][i] - m); sc[kt][i] = e; lsum += e; }
#pragma unroll
  for (int s2 = 0; s2 < 2; ++s2) { const bf16x8 pf = pack_frag(sc[2 * s2], sc[2 * s2 + 1]);
#pragma unroll
    for (int et = 0; et < 8; ++et) O[et] = MFMA16(AW_A64(Vl, 16 * et + fr, s2), pf, O[et]); }
#undef AW_A128
#undef AW_A64
}
DI void attn_wg(const Params& p, int l, int wi, unsigned char* smem) {
  const int tid = otid(), lane = tid & 63, wv = tid >> 6, fr = lane & 15, fq = lane >> 4;
  const int ci = wi >> 2, hp = wi & 3, hsel = wv >> 2, hh = 2 * hp + hsel, qt = wv & 3;
  bf16_t* proj = (bf16_t*)(p.ws + OFF_PROJ);
  const bf16_t* aVT = (const bf16_t*)(p.ws + OFF_M1) + 7 * M1_BLK;
  const bf16_t* kcb = (const bf16_t*)(p.ws + OFF_KC); const bf16_t* cvt = (const bf16_t*)(p.ws + OFF_CVT);
  const float* rb = p.rel_bias + ((size_t)l * 8 + 2 * hp) * 257;
  float* sBias = (float*)(smem + 131072 + 256);
  const int qrow = ci * 64 + 16 * qt + fr;
  bf16x8 Qf[4];
#pragma unroll
  for (int s = 0; s < 4; ++s) Qf[s] = *(const bf16x8*)(proj + (size_t)qrow * LDP + hh * 128 + 32 * s + 8 * fq);
  const int jmin = (ci < 256) ? ((ci & 63) >= 8 ? 0 : 8 - (ci & 63)) : 0;
  const float bfar = rb[hsel * 257 + 256]; const int iq = 16 * qt + fr;
  const int row0 = tid >> 4, kcol = tid & 15;
  const int dKb = (row0 * 16 + (kcol ^ (row0 & 15))) * 16, dVb = 32768 + ((tid >> 3) * 8 + ((tid & 7) ^ ((tid >> 4) & 7))) * 16;
  u32x4 st[2][8];
#define AW_ISSUE(j_, X_) do { const bf16_t* Kb_; const bf16_t* Vb_; int ks_; size_t khs_; \
    if (ci < 256 || (j_) == 8) { const int cj_ = (ci < 256) ? ci - 8 + (j_) : ci; Kb_ = proj + (size_t)(cj_ * 64) * LDP + 1024 + 2 * hp * 128; ks_ = LDP; khs_ = 128; Vb_ = aVT + (size_t)(cj_ * 8 + 2 * hp) * 8192; } \
    else { const size_t o_ = (size_t)(((ci - 256) * 8 + (j_)) * 8 + 2 * hp) * 8192; Kb_ = kcb + o_; ks_ = 128; khs_ = 8192; Vb_ = cvt + o_; } \
    const bf16_t* kp_ = Kb_ + (size_t)row0 * ks_ + kcol * 8; \
    _Pragma("unroll") for (int k = 0; k < 4; ++k) { st[X_][k] = *(const u32x4*)(kp_ + (k >> 1) * khs_ + (size_t)(32 * (k & 1)) * ks_); st[X_][4 + k] = *(const u32x4*)(Vb_ + (size_t)(tid + 512 * k) * 8); } } while (0)
#define AW_COMMIT(b_, X_) do { unsigned char* B_ = smem + (b_) * 65536; _Pragma("unroll") for (int k = 0; k < 4; ++k) { \
    *(u32x4*)(B_ + dKb + (k >> 1) * 16384 + (k & 1) * 8192) = st[X_][k]; *(u32x4*)(B_ + dVb + (k >> 1) * 16384 + (k & 1) * 8192) = st[X_][4 + k]; } } while (0)
  float m = -1e30f, lsum = 0.f;
  f32x4 O[8];
#pragma unroll
  for (int et = 0; et < 8; ++et) O[et] = (f32x4){0.f, 0.f, 0.f, 0.f};
  AW_ISSUE(jmin, 0);
  if (tid < 257) { sBias[tid] = rb[tid]; sBias[260 + tid] = rb[257 + tid]; }
  AW_COMMIT(0, 0);
  if (jmin + 1 < 9) AW_ISSUE(jmin + 1, 1);
  __syncthreads();
  const float* sB = sBias + hsel * 260;
  for (int j = jmin; j < 9; j += 2) {
    if (j + 2 < 9) AW_ISSUE(j + 2, 0);
    attn_stage(smem + hsel * 16384, sB, j, iq, bfar, Qf, O, m, lsum, fr, fq);
    if (j + 1 < 9) AW_COMMIT(1, 1);
    __syncthreads();
    if (j + 1 >= 9) break;
    if (j + 3 < 9) AW_ISSUE(j + 3, 1);
    attn_stage(smem + 65536 + hsel * 16384, sB, j + 1, iq, bfar, Qf, O, m, lsum, fr, fq);
    if (j + 2 < 9) AW_COMMIT(0, 0);
    __syncthreads();
  }
#undef AW_ISSUE
#undef AW_COMMIT
  lsum += __shfl_xor(lsum, 16); lsum += __shfl_xor(lsum, 32);
  const float inv = __builtin_amdgcn_rcpf(lsum);
#pragma unroll
  for (int et = 0; et < 8; ++et) { const u32x2 z = *(const u32x2*)(proj + (size_t)qrow * LDP + 3072 + hh * 128 + 16 * et + 4 * fq);
    u32x2 w; w.x = pk2(O[et][0] * inv * siluf_(bflo(z.x)), O[et][1] * inv * siluf_(bfhi(z.x))); w.y = pk2(O[et][2] * inv * siluf_(bflo(z.y)), O[et][3] * inv * siluf_(bfhi(z.y)));
    *(u32x2*)(proj + (size_t)qrow * LDP + C_ACAT + hh * 128 + 16 * et + 4 * fq) = w; }
}

DI void m2_phase(const Params& p, int l, int rep, unsigned char* smem) {
  const int tid_ = otid(); const int wv = tid_ >> 6;
  if (oblk() < 64) {
    const int chain = oblk(), ty = chain >> 5, sq = (chain & 31) >> 3, hh = chain & 7;
    for (int r3 = 0; r3 < R_SW; ++r3) { if (ty == 0) scan_wg2<0>(p, l, sq, hh, smem); else scan_wg2<1>(p, l, sq, hh, smem); }
  } else {
    for (int idx = (oblk() - 64) * 8 + wv; idx < 1024; idx += (gridDim.x - 64) * 8) {
      const int ty = idx >> 9, r = idx & 511, sq = 4 + (r >> 6), hh = (r >> 3) & 7, sl = r & 7;
      if (ty == 0) scan_item<0>(p, l, sq, hh, sl); else scan_item<1>(p, l, sq, hh, sl); }
  }
  unsigned* cnt = (unsigned*)(p.ws + OFF_CNT) + 64 * (l * 2 + rep);
  for (;;) {
    __syncthreads();
    if (tid_ == 0) *(volatile unsigned*)(smem + 131072) = atomicAdd(cnt, 1u);
    __syncthreads();
    const unsigned idx = *(volatile unsigned*)(smem + 131072);
    if (idx >= 1056u) break;
    for (int r2 = 0; r2 < R_AT; ++r2) attn_wg(p, l, (int)idx, smem);
  }
}

DI void m3_phase(const Params& p, int l) {
  bf16_t* proj = (bf16_t*)(p.ws + OFF_PROJ);
  const int tid_ = otid(); const int lane = tid_ & 63, gw = oblk() * 8 + (tid_ >> 6), nw = gridDim.x * 8;
  for (int wi = gw; wi < 2 * MROWS; wi += nw) {
    const int r = wi >> 1, br = wi & 1; bf16_t* rp = proj + (size_t)r * LDP;
    float v[16], z[16];
    unpack8(*(const u32x4*)(rp + (br ? C_OCRAW : C_OBRAW) + 16 * lane), v); unpack8(*(const u32x4*)(rp + (br ? C_OCRAW : C_OBRAW) + 16 * lane + 8), v + 8);
    unpack8(*(const u32x4*)(rp + (br ? 11264 : 7168) + 16 * lane), z); unpack8(*(const u32x4*)(rp + (br ? 11264 : 7168) + 16 * lane + 8), z + 8);
    const float* nw_ = br ? p.ret_norm + (size_t)l * 1024 + 16 * lane : p.delta_norm + (size_t)l * 128 + 16 * (lane & 7);
    float mu = 0.f;
    if (br) {
#pragma unroll
      for (int c = 0; c < 16; ++c) mu += v[c];
      mu += __shfl_xor(mu, 1); mu += __shfl_xor(mu, 2); mu += __shfl_xor(mu, 4); mu *= (1.f / 128.f); }
    float ss = 0.f;
#pragma unroll
    for (int c = 0; c < 16; ++c) { v[c] -= mu; ss += v[c] * v[c]; }
    ss += __shfl_xor(ss, 1); ss += __shfl_xor(ss, 2); ss += __shfl_xor(ss, 4);
    const float rn = rsqrtf(ss * (1.f / 128.f) + 1e-6f);
#pragma unroll
    for (int c = 0; c < 16; ++c) v[c] = v[c] * rn * nw_[c] * siluf_(z[c]);
    *(u32x4*)(rp + C_ACAT + 1024 + br * 1024 + 16 * lane) = pack8(v); *(u32x4*)(rp + C_ACAT + 1024 + br * 1024 + 16 * lane + 8) = pack8(v + 8);
  }
}

DI void merge_phase(const Params& p) {
  const bf16_t* proj = (const bf16_t*)(p.ws + OFF_PROJ); const bf16_t* P = (const bf16_t*)(p.ws + OFF_M1); bf16_t* mg = (bf16_t*)(p.ws + OFF_H);
  const int tid_ = otid(); const int lane = tid_ & 63, gw = oblk() * 8 + (tid_ >> 6), nw = gridDim.x * 8;
  for (int r = gw; r < MROWS; r += nw) {
    const bf16_t* pr = P + (size_t)r * (3 * DM); const bf16_t* gr = proj + (size_t)r * LDP + 12288;
#pragma unroll
    for (int q = 0; q < 4; ++q) { const int c = q * 512 + lane * 8; float acc[8];
#pragma unroll
      for (int j = 0; j < 8; ++j) acc[j] = 0.f;
#pragma unroll
      for (int br = 0; br < 3; ++br) { float pv[8], gv[8]; unpack8(*(const u32x4*)(pr + br * DM + c), pv); unpack8(*(const u32x4*)(gr + br * DM + c), gv);
#pragma unroll
        for (int j = 0; j < 8; ++j) acc[j] += pv[j] * sigmoidf_(gv[j]); }
      *(u32x4*)(mg + (size_t)r * DM + c) = pack8(acc); }
  }
}

#define XB_TMO      128
#define XB_XCNT(j)  (256  + 64 * (j))
#define XB_XSUB(j)  (1280 + 64 * (j))
#define XB_XGEN(j)  (2304 + 64 * (j))
#define XB_TOP      3328
#define XB_TOPGEN   3392
#define XCD_BAR_WORDS 3456
#define XB_SPIN_CAP (1u << 18)
DI unsigned xb_ld(unsigned* p) { return __hip_atomic_load(p, __ATOMIC_RELAXED, __HIP_MEMORY_SCOPE_AGENT); }
DI unsigned xb_add(unsigned* p, unsigned v) { return __hip_atomic_fetch_add(p, v, __ATOMIC_RELAXED, __HIP_MEMORY_SCOPE_AGENT); }
DI unsigned xb_xcc_id() { return (unsigned)__builtin_amdgcn_s_getreg((3 << 11) | 20) & 0xFu; }
#define XB_SPIN(cond, bar) do { unsigned _sp = 0; while (cond) { __builtin_amdgcn_s_sleep(1); \
    if ((++_sp & 255u) == 0u) { if (xb_ld(&(bar)[XB_TMO])) break; if (_sp > XB_SPIN_CAP) { atomicAdd(&(bar)[XB_TMO], 1u); break; } } } } while (0)
struct XcdBarrier { unsigned* bar; unsigned x; volatile LAS unsigned* st; };
DI XcdBarrier xcd_barrier_post(unsigned* bar, volatile LAS unsigned* st) {
  XcdBarrier b; b.bar = bar; b.x = xb_xcc_id(); b.st = st;
  if (threadIdx.x == 0) (void)xb_add(&bar[XB_XCNT(b.x)], 1u);
  return b;
}
DI void xcd_barrier_complete(unsigned* bar, unsigned x, unsigned& nloc, unsigned& nx) {
  const unsigned G = gridDim.x * gridDim.y * gridDim.z;
  unsigned sum, cnt, mine, sp = 0u;
  for (;;) {
    sum = 0u; cnt = 0u; mine = 0u;
#pragma unroll
    for (unsigned j = 0; j < 16; ++j) { const unsigned c = xb_ld(&bar[XB_XCNT(j)]); sum += c; cnt += (c > 0u) ? 1u : 0u; mine = (j == x) ? c : mine; }
    if (sum == G) break;
    __builtin_amdgcn_s_sleep(1);
    if ((++sp & 255u) == 0u) { if (xb_ld(&bar[XB_TMO])) break; if (sp > XB_SPIN_CAP) { atomicAdd(&bar[XB_TMO], 1u); break; } }
  }
  nloc = mine > 0u ? mine : 1u; nx = cnt > 0u ? cnt : 1u;
}
DI void xcd_barrier(const XcdBarrier& b) {
  asm volatile("s_waitcnt vmcnt(0)" ::: "memory");
  __syncthreads();
  if (threadIdx.x == 0) {
    unsigned* bar = b.bar;
    __builtin_amdgcn_s_waitcnt(0);
    unsigned nloc = b.st[0], nx = b.st[1];
    if (nloc == 0u) { xcd_barrier_complete(bar, b.x, nloc, nx); b.st[0] = nloc; b.st[1] = nx; }
    const unsigned old = xb_add(&bar[XB_XSUB(b.x)], 1u);
    const unsigned gen = old / nloc;
    if (old + 1u == (gen + 1u) * nloc) {
      __builtin_amdgcn_fence(__ATOMIC_RELEASE, "agent");
      asm volatile("s_waitcnt vmcnt(0)" ::: "memory");
      const unsigned og = xb_add(&bar[XB_TOP], 1u);
      const unsigned tg = og / nx;
      if (og + 1u == (tg + 1u) * nx) xb_add(&bar[XB_TOPGEN], 1u);
      else XB_SPIN(xb_ld(&bar[XB_TOPGEN]) == tg, bar);
      __builtin_amdgcn_fence(__ATOMIC_ACQUIRE, "agent");
      xb_add(&bar[XB_XGEN(b.x)], 1u);
      asm volatile("s_waitcnt vmcnt(0)" ::: "memory");
    } else {
      XB_SPIN(xb_ld(&bar[XB_XGEN(b.x)]) == gen, bar);
      __builtin_amdgcn_fence(__ATOMIC_ACQUIRE, "agent");
      asm volatile("s_waitcnt vmcnt(0)" ::: "memory");
    }
  }
  __syncthreads();
}

__global__ void __launch_bounds__(512, 2) mega(Params p) {
  extern __shared__ __attribute__((aligned(16))) unsigned char smem[];
  cg::grid_group grid = cg::this_grid();
  const int G = gridDim.x;
  if (threadIdx.x == 0) { ((volatile LAS unsigned*)(LAS unsigned char*)smem)[(131072 + 16) / 4] = 0u; ((volatile LAS unsigned*)(LAS unsigned char*)smem)[(131072 + 20) / 4] = 0u; }
  __syncthreads();
  XcdBarrier xb = xcd_barrier_post((unsigned*)(p.ws + OFF_BAR), (volatile LAS unsigned*)((LAS unsigned char*)smem + 131072 + 16));
  if (oblk() == 0 && threadIdx.x < 4) ((unsigned*)(p.ws + OFF_CNT))[64 * threadIdx.x] = 0u;
  if (T_ROW) { convert_weights(p, 0, (float*)smem, 2, oblk(), gridDim.x);
  prenorm_phase(p, 0); }
  grid.sync();
  for (int l = 0; l < 2; ++l) {
    { pg8::Gemm g{(const bf16_t*)(p.ws + OFF_H), (const bf16_t*)(p.ws + OFF_WIN), MROWS, NW1, DM, DM, DM, 1 << 20, 0};
      pg8::StaticOrder S; S.init(MROWS, NW1, G, oblk());
      EpiProj E{(bf16_t*)(p.ws + OFF_PROJ), (float*)(p.ws + OFF_SIDE), LDP, 72};
      for (int rep = 0; rep < R_G1; ++rep) pg8::gemm_phase(( LAS unsigned char*)smem, g, S, E); }
    xcd_barrier(xb);
    { float* sCW = (float*)(smem + 122880); const int hh0 = oblk() & 7;
      for (int idx = threadIdx.x; idx < 1536; idx += 512) { const int mat = idx / 512, tap = (idx >> 7) & 3, col = idx & 127;
        sCW[idx] = p.conv_w[((size_t)l * 4 + tap) * 3072 + mat * 1024 + hh0 * 128 + col]; }
      __syncthreads(); }
    for (int rep = 0; rep < R_M1; ++rep)
    for (int t = oblk(); t < 3 * NITEM + 512; t += G) {
      if (t < NITEM) { for (int r2 = 0; r2 < R_DP; ++r2) delta_pre(p, l, t, smem); }
      else if (t < 2 * NITEM) { if (T_RP) ret_pre(p, l, t - NITEM, smem); }
      else if (t < 3 * NITEM) { if (T_MI) misc_item(p, l, t - 2 * NITEM, smem); }
      else { if (T_MI) cache_item(p, l, t - 3 * NITEM, smem); }
    }
    xcd_barrier(xb);
    for (int rep = 0; rep < R_M2; ++rep) m2_phase(p, l, rep, smem);
    xcd_barrier(xb);
    for (int rep = 0; rep < R_M3; ++rep) m3_phase(p, l);
    xcd_barrier(xb);
    for (int rep = 0; rep < R_G2; ++rep) {
      pg8::Gemm g{(const bf16_t*)(p.ws + OFF_PROJ) + C_ACAT, (const bf16_t*)(p.ws + OFF_WBR), MROWS, 3 * DM, 1024, LDP, 1024, 8, 2048};
      pg8::StaticOrder S; S.init(MROWS, 3 * DM, G, oblk());
      EpiProj E{(bf16_t*)(p.ws + OFF_M1), nullptr, 3 * DM, 1 << 20};
      pg8::gemm_phase((LAS unsigned char*)smem, g, S, E); }
    xcd_barrier(xb);
    merge_phase(p);
    xcd_barrier(xb);
    if (l == 0) {
      { pg8::Gemm g{(const bf16_t*)(p.ws + OFF_H), (const bf16_t*)(p.ws + OFF_WOUT), MROWS, DM, DM, DM, DM, 1 << 20, 0};
        pg8::StaticOrder S; S.init(MROWS, DM, G, oblk());
        EpiF32 E{(float*)(p.ws + OFF_M1 + 69206016)};
        pg8::gemm_phase((LAS unsigned char*)smem, g, S, E); }
      { const int c0 = 528 - ((528 + G - 1) / G - 1) * G;
        if (c0 < G && oblk() >= c0) convert_weights(p, 1, (float*)smem, 0, oblk() - c0, G - c0);
        else if (c0 >= G) convert_weights(p, 1, (float*)smem, 0, oblk(), G); }
      xcd_barrier(xb);
      postnorm_phase(p, l, 0, MROWS, 0, G);
    } else {
      { pg8::Gemm g{(const bf16_t*)(p.ws + OFF_H), (const bf16_t*)(p.ws + OFF_WOUT), 16384, DM, DM, DM, DM, 1 << 20, 0};
        pg8::StaticOrder S; S.init(16384, DM, G, oblk());
        EpiF32 E{(float*)(p.ws + OFF_M1 + 69206016)};
        pg8::gemm_phase((LAS unsigned char*)smem, g, S, E); }
      xcd_barrier(xb);
      if (oblk() < 16 && G > 16) {
        pg8::Gemm g{(const bf16_t*)(p.ws + OFF_H) + (size_t)16384 * DM, (const bf16_t*)(p.ws + OFF_WOUT), 512, DM, DM, DM, DM, 1 << 20, 0};
        pg8::StaticOrder S; S.init(512, DM, 16, oblk());
        EpiF32 E{(float*)(p.ws + OFF_M1 + 69206016) + (size_t)16384 * DM};
        pg8::gemm_phase((LAS unsigned char*)smem, g, S, E);
      } else if (G > 16) postnorm_phase(p, l, 0, 16384, 16, G - 16);
      xcd_barrier(xb);
      postnorm_phase(p, l, 16384, MROWS, 0, G);
    }
    if (l == 0) { if (T_ROW) convert_weights(p, 1, (float*)smem, 1, oblk(), gridDim.x); xcd_barrier(xb); }
  }
}

extern "C" void kernel_launch(void* const* d_in, const int* in_sizes, int n_in, void* d_out, int out_size,
                              void* d_ws, size_t ws_size, hipStream_t stream) {
  constexpr size_t kLds = 131072 + 256 + 4096;
  static int grid_blocks = 0;
  if (!grid_blocks) {
    (void)hipFuncSetAttribute((const void*)mega, hipFuncAttributeMaxDynamicSharedMemorySize, (int)kLds);
    int dev = 0, cus = 0, per_cu = 0;
    (void)hipGetDevice(&dev);
    (void)hipDeviceGetAttribute(&cus, hipDeviceAttributeMultiprocessorCount, dev);
    (void)hipOccupancyMaxActiveBlocksPerMultiprocessor(&per_cu, mega, 512, kLds);
    if (per_cu > 1) per_cu = 1;
    grid_blocks = cus * per_cu;
    if (grid_blocks > 256) grid_blocks = 256;
  }
  if (ws_size < WS_NEED) { fprintf(stderr, "workspace too small: %zu < %zu\n", ws_size, (size_t)WS_NEED); return; }
  (void)hipMemsetAsync((unsigned char*)d_ws + OFF_BAR, 0, 16384, stream);
  Params p{};
  const float** pp = (const float**)&p;
  for (int i = 0; i < 20; ++i) pp[i] = (const float*)d_in[i];
  p.out = (float*)d_out; p.ws = (unsigned char*)d_ws;
  void* args[] = {&p};
  hipError_t e = hipLaunchCooperativeKernel((void*)mega, dim3(grid_blocks), dim3(512), args, kLds, stream);
  if (e != hipSuccess) fprintf(stderr, "cooperative launch failed: %s (grid %d)\n", hipGetErrorString(e), grid_blocks);
}
```

```cpp
#include <hip/hip_runtime.h>
#include <hip/hip_cooperative_groups.h>
#include <cstdio>
namespace cg = cooperative_groups;
#ifndef R_DP
#define R_DP 1
#endif
#ifndef R_SW
#define R_SW 1
#endif
#ifndef R_AT
#define R_AT 1
#endif
#ifndef R_G1
#define R_G1 1
#endif
#ifndef R_M1
#define R_M1 1
#endif
#ifndef R_M2
#define R_M2 1
#endif
#ifndef R_M3
#define R_M3 1
#endif
#ifndef R_G2
#define R_G2 1
#endif
#ifndef R_G3
#define R_G3 1
#endif
#ifndef T_ROW
#define T_ROW 1
#endif
#ifndef T_G1
#define T_G1 1
#endif
#ifndef T_DP
#define T_DP 1
#endif
#ifndef T_RP
#define T_RP 1
#endif
#ifndef T_MI
#define T_MI 1
#endif
#ifndef T_M2
#define T_M2 1
#endif
#ifndef T_M3
#define T_M3 1
#endif
#ifndef T_G2
#define T_G2 1
#endif
#ifndef T_G3
#define T_G3 1
#endif
#ifndef T_AT
#define T_AT 1
#endif
#ifndef T_SC
#define T_SC 1
#endif

#define DI __device__ __forceinline__
#define LAS __attribute__((address_space(3)))
typedef unsigned short bf16_t;
typedef short bf16x8 __attribute__((ext_vector_type(8)));
typedef float f32x4 __attribute__((ext_vector_type(4)));
typedef float f32x2 __attribute__((ext_vector_type(2)));
typedef unsigned u32x4 __attribute__((ext_vector_type(4)));
typedef unsigned u32x2 __attribute__((ext_vector_type(2)));
typedef __bf16 bf2_t __attribute__((ext_vector_type(2)));

constexpr int DM = 2048, MROWS = 16896, LDP = 18432, NW1 = 18688, NIN = 18448, NITEM = 2112;
constexpr int C_ACAT = 4096, C_OBRAW = 8192, C_OCRAW = 9216;
constexpr size_t O_PK = 34603008, O_PV = 38797312, O_PC = 42991616, O_PD = 43065344, O_PR = 44113920, O_SK = 45162496, O_SV = 53551104, O_SC = 61939712, O_SD = 62087168, O_SR = 64184320;
constexpr size_t OFF_WIN = 0, OFF_WBR = 76546048, OFF_WOUT = 89128960, OFF_H = 97517568, OFF_PROJ = 166723584, OFF_SIDE = 789577728, OFF_DG = 790659072,
                 OFF_CNT = 790667520, OFF_KC = 790675456, OFF_CVT = 799064064, OFF_M1 = 807452672, OFF_BAR = 1118879744, WS_NEED = 1118879744 + 16384;
constexpr size_t M1_BLK = (size_t)NITEM * 8192;

struct Params {
  const float *x_prompt, *x_sample, *cache_k, *cache_v, *state_conv, *state_delta, *state_ret, *norm_pre, *norm_post, *w_in, *rel_bias, *conv_w, *a_log, *dt_bias,
      *delta_norm, *ret_norm, *w_ba, *w_bb, *w_bc, *w_out;
  float* out; unsigned char* ws;
};

DI unsigned pk2(float lo, float hi) { f32x2 v = {lo, hi}; bf2_t b = __builtin_convertvector(v, bf2_t); return __builtin_bit_cast(unsigned, b); }
DI bf16_t f2bf(float x) { return (bf16_t)(pk2(x, 0.f) & 0xffffu); }
DI float bflo(unsigned w) { return __uint_as_float(w << 16); }
DI float bfhi(unsigned w) { return __uint_as_float(w & 0xffff0000u); }
DI float bf2f(bf16_t b) { return __uint_as_float(((unsigned)b) << 16); }
DI float sigmoidf_(float x) { return __builtin_amdgcn_rcpf(1.f + __expf(-x)); }
DI float siluf_(float x) { return x * __builtin_amdgcn_rcpf(1.f + __expf(-x)); }
DI int oblk() { int b = blockIdx.x; asm volatile("" : "+s"(b)); return __builtin_amdgcn_readfirstlane(b); }
DI int otid() { int t = threadIdx.x; asm volatile("" : "+v"(t)); return t; }
DI int kperm(int p) { return 16 * ((p >> 2) & 1) + 4 * (p >> 3) + (p & 3); }
DI int kinv(int x) { return 8 * ((x >> 2) & 3) + 4 * (x >> 4) + (x & 3); }
DI float wsum(float v) { for (int o = 32; o > 0; o >>= 1) v += __shfl_xor(v, o); return v; }
DI void unpack8(u32x4 a, float* o) { o[0] = bflo(a.x); o[1] = bfhi(a.x); o[2] = bflo(a.y); o[3] = bfhi(a.y); o[4] = bflo(a.z); o[5] = bfhi(a.z); o[6] = bflo(a.w); o[7] = bfhi(a.w); }
DI u32x4 pack8(const float* v) { u32x4 w; w.x = pk2(v[0], v[1]); w.y = pk2(v[2], v[3]); w.z = pk2(v[4], v[5]); w.w = pk2(v[6], v[7]); return w; }
DI bf16x8 pack_frag(f32x4 a, f32x4 b) { u32x4 w; w.x = pk2(a[0], a[1]); w.y = pk2(a[2], a[3]); w.z = pk2(b[0], b[1]); w.w = pk2(b[2], b[3]); return __builtin_bit_cast(bf16x8, w); }
#define MFMA16(a, b, c) __builtin_amdgcn_mfma_f32_16x16x32_bf16((a), (b), (c), 0, 0, 0)

namespace pg8 {
constexpr int BM = 256, BK = 64, HALF = 128, HTB = HALF * BK * 2, STAGE_BYTES = 8 * HTB, NXCD = 8, WGM = 8;
DI int lds_byte(int r, int c) { const int st = (r >> 4) * 2 + (c >> 5), rr = r & 15, cc = c & 31, ob = rr * 64 + cc * 2; return st * 1024 + (ob ^ (((ob >> 9) & 1) << 5)); }
DI void stage_rc(int b, int& R, int& C) { const int st = b / 1024, sb = b % 1024, swz = sb ^ (((sb >> 9) & 1) << 5); R = (st >> 1) * 16 + swz / 64; C = (st & 1) * 32 + (swz % 64) / 2; }
DI int perm32(int rho) { const int n = rho >> 4, i = rho & 15; return 8 * (i >> 2) + 4 * n + (i & 3); }
struct Unit { int pm, pn; };
struct Gemm { const bf16_t* A; const bf16_t* Bt; int M, N, K, lda, ldb, a_div, a_step; };
struct StaticOrder {
  int nM, nN, nwg, G, c;
  DI void init(int M, int N, int G_, int c_) { nM = M / BM; nN = N / BM; nwg = nM * nN; G = G_; c = c_; }
  DI bool next(int i, Unit& u) const {
    const long L = (long)i * G + c; if (L >= nwg) return false;
    int wgid = (int)L; { const int q = nwg / NXCD, r = nwg % NXCD, xcd = wgid % NXCD, off = wgid / NXCD; wgid = (xcd < r ? xcd * (q + 1) : r * (q + 1) + (xcd - r) * q) + off; }
    const int nig = WGM * nN, gid = wgid / nig, fm = gid * WGM, gsz = (nM - fm) < WGM ? (nM - fm) : WGM;
    u.pm = fm + ((wgid % nig) % gsz); u.pn = (wgid % nig) / gsz; return true;
  }
};

template <class Epi>
DI void gemm_phase(LAS unsigned char* lds, const Gemm g, const StaticOrder& S, const Epi& E) {
  const int tid = otid(), wid = __builtin_amdgcn_readfirstlane(tid >> 6), lane = tid & 63, wr = wid >> 2, wc = wid & 3, fr = lane & 15, fq = lane >> 4;
  const int K = g.K, nt = K / BK;
  unsigned voffA[2], voffB[2];
#pragma unroll
  for (int i = 0; i < 2; ++i) { int R, C; stage_rc(tid * 16 + i * 8192, R, C); const int Rb = Epi::PERM ? ((R & ~31) + perm32(R & 31)) : R;
    voffA[i] = (unsigned)(R * g.lda + C) * 2u; voffB[i] = (unsigned)(Rb * g.ldb + C) * 2u; }
  const size_t kstep = (size_t)(BK * 2);
  const size_t hstepA = (size_t)HALF * g.lda * 2, hstepB = (size_t)HALF * g.ldb * 2;
  const size_t tstepA = 2 * hstepA, tstepB = 2 * hstepB;
  const unsigned ldsw = (unsigned)wid * 1024u;
  const int aoff = lds_byte(wr * 64 + fr, fq * 8), boff = lds_byte(wc * 32 + fr, fq * 8);
#define PG8_SA(b, h) (((b) * 2 + (h)) * HTB)
#define PG8_SB(b, h) ((4 + (b) * 2 + (h)) * HTB)
#define PG8_STAGE(bufoff, gbase, voff) do { const char* _gb = (const char*)(gbase); asm volatile("" : "+s"(_gb)); _Pragma("unroll") for (int _i = 0; _i < 2; ++_i) \
    __builtin_amdgcn_global_load_lds((const unsigned*)(_gb + (voff)[_i]), (LAS unsigned*)(lds + (bufoff) + ldsw + _i * 8192), 16, 0, 0); } while (0)
#define PG8_LDA(dst, b, h) do { _Pragma("unroll") for (int m = 0; m < 4; ++m) _Pragma("unroll") for (int k = 0; k < 2; ++k) dst[m][k] = *(const LAS bf16x8*)(lds + PG8_SA(b, h) + aoff + m * 2048 + k * 1024); } while (0)
#define PG8_LDB(dst, b, h) do { _Pragma("unroll") for (int n = 0; n < 2; ++n) _Pragma("unroll") for (int k = 0; k < 2; ++k) dst[n][k] = *(const LAS bf16x8*)(lds + PG8_SB(b, h) + boff + n * 2048 + k * 1024); } while (0)
#define PG8_MMA(ai, bj, At, Bt) do { __builtin_amdgcn_s_setprio(1); _Pragma("unroll") for (int m = 0; m < 4; ++m) _Pragma("unroll") for (int n = 0; n < 2; ++n) _Pragma("unroll") for (int k = 0; k < 2; ++k) \
    acc[ai][bj][m][n] = __builtin_amdgcn_mfma_f32_16x16x32_bf16(Bt[n][k], At[m][k], acc[ai][bj][m][n], 0, 0, 0); __builtin_amdgcn_s_setprio(0); } while (0)
#define PG8_WAIT_V(n) asm volatile("s_waitcnt vmcnt(" #n ")" ::: "memory")
#define PG8_WAIT_L(n) asm volatile("s_waitcnt lgkmcnt(" #n ")" ::: "memory")
#define PG8_BAR __builtin_amdgcn_s_barrier()
#define PG8_SCHED __builtin_amdgcn_sched_barrier(0)
  Unit cur, nxt; int ui = 0;
  if (!S.next(0, cur)) return;
  f32x4 acc[2][2][4][2];
#pragma unroll
  for (int a = 0; a < 2; ++a)
#pragma unroll
    for (int b = 0; b < 2; ++b)
#pragma unroll
      for (int m = 0; m < 4; ++m)
#pragma unroll
        for (int n = 0; n < 2; ++n) acc[a][b][m][n] = (f32x4){0.f, 0.f, 0.f, 0.f};
  bf16x8 At[4][2], B0[2][2], B1[2][2];
  const char* cA = (const char*)g.A + (size_t)cur.pm * tstepA + (size_t)((cur.pn / g.a_div) * g.a_step); const char* cB = (const char*)g.Bt + (size_t)cur.pn * tstepB;
  PG8_STAGE(PG8_SB(0, 0), cB, voffB); PG8_STAGE(PG8_SA(0, 0), cA, voffA); PG8_STAGE(PG8_SB(0, 1), cB + hstepB, voffB); PG8_STAGE(PG8_SA(0, 1), cA + hstepA, voffA);
  if (wr == 1) PG8_BAR;
  PG8_WAIT_V(4); PG8_BAR;
  PG8_STAGE(PG8_SB(1, 0), cB + kstep, voffB); PG8_STAGE(PG8_SA(1, 0), cA + kstep, voffA); PG8_STAGE(PG8_SB(1, 1), cB + hstepB + kstep, voffB);
  PG8_WAIT_V(6); PG8_BAR;
  for (;;) {
    const bool has_next = S.next(ui + 1, nxt);
    const char* nA = has_next ? (const char*)g.A + (size_t)nxt.pm * tstepA + (size_t)((nxt.pn / g.a_div) * g.a_step) : cA; const char* nB = has_next ? (const char*)g.Bt + (size_t)nxt.pn * tstepB : cB;
    for (int t = 0; t < nt; t += 2) {
      const bool last = (t == nt - 2);
      const char* a1 = cA + (size_t)(t + 1) * kstep;
      const char* a2 = last ? nA : cA + (size_t)(t + 2) * kstep; const char* b2 = last ? nB : cB + (size_t)(t + 2) * kstep;
      const char* a3 = a2 + kstep; const char* b3 = b2 + kstep;
      PG8_LDB(B0, 0, 0); PG8_SCHED; PG8_LDA(At, 0, 0); PG8_STAGE(PG8_SA(1, 1), a1 + hstepA, voffA);
      PG8_WAIT_L(8); PG8_BAR; PG8_WAIT_L(0); PG8_MMA(0, 0, At, B0); PG8_BAR; PG8_SCHED;
      PG8_LDB(B1, 0, 1); PG8_STAGE(PG8_SB(0, 0), b2, voffB);
      PG8_BAR; PG8_WAIT_L(0); PG8_MMA(0, 1, At, B1); PG8_BAR;
      PG8_LDA(At, 0, 1); PG8_STAGE(PG8_SA(0, 0), a2, voffA);
      PG8_BAR; PG8_WAIT_L(0); PG8_MMA(1, 0, At, B0); PG8_BAR; PG8_SCHED;
      PG8_STAGE(PG8_SB(0, 1), b2 + hstepB, voffB);
      PG8_WAIT_V(6); PG8_BAR; PG8_MMA(1, 1, At, B1); PG8_BAR;
      PG8_LDB(B0, 1, 0); PG8_SCHED; PG8_LDA(At, 1, 0); PG8_STAGE(PG8_SA(0, 1), a2 + hstepA, voffA);
      PG8_WAIT_L(8); PG8_BAR; PG8_WAIT_L(0); PG8_MMA(0, 0, At, B0); PG8_BAR; PG8_SCHED;
      PG8_LDB(B1, 1, 1); PG8_STAGE(PG8_SB(1, 0), b3, voffB);
      PG8_BAR; PG8_WAIT_L(0); PG8_MMA(0, 1, At, B1); PG8_BAR;
      PG8_LDA(At, 1, 1); PG8_STAGE(PG8_SA(1, 0), a3, voffA);
      PG8_BAR; PG8_WAIT_L(0); PG8_MMA(1, 0, At, B0); PG8_BAR; PG8_SCHED;
      PG8_STAGE(PG8_SB(1, 1), b3 + hstepB, voffB);
      PG8_WAIT_V(6); PG8_BAR; PG8_MMA(1, 1, At, B1); PG8_BAR;
    }
    E(acc, cur, wr, wc, fr, fq);
    if (!has_next) break;
#pragma unroll
    for (int a = 0; a < 2; ++a)
#pragma unroll
      for (int b = 0; b < 2; ++b)
#pragma unroll
        for (int m = 0; m < 4; ++m)
#pragma unroll
          for (int n = 0; n < 2; ++n) acc[a][b][m][n] = (f32x4){0.f, 0.f, 0.f, 0.f};
    cur = nxt; cA = nA; cB = nB; ++ui;
  }
  PG8_WAIT_V(0);
  if (wr == 0) PG8_BAR;
  PG8_BAR;
#undef PG8_SA
#undef PG8_SB
#undef PG8_STAGE
#undef PG8_LDA
#undef PG8_LDB
#undef PG8_MMA
#undef PG8_WAIT_V
#undef PG8_WAIT_L
#undef PG8_BAR
#undef PG8_SCHED
}
}

struct EpiProj {
  static constexpr bool PERM = true;
  bf16_t* O; float* side; int ldc, nmain;
  DI void operator()(const f32x4 (&acc)[2][2][4][2], const pg8::Unit& u, int wr, int wc, int fr, int fq) const {
    const int row0 = u.pm * 256 + wr * 64 + fr;
    if (u.pn < nmain) {
      const int col0 = u.pn * 256 + wc * 32 + 8 * fq;
#pragma unroll
      for (int ai = 0; ai < 2; ++ai)
#pragma unroll
        for (int m = 0; m < 4; ++m) { bf16_t* rowp = O + (size_t)(row0 + ai * 128 + m * 16) * ldc + col0;
#pragma unroll
          for (int bj = 0; bj < 2; ++bj) { const f32x4 v0 = acc[ai][bj][m][0], v1 = acc[ai][bj][m][1];
            u32x4 w; w.x = pk2(v0[0], v0[1]); w.y = pk2(v0[2], v0[3]); w.z = pk2(v1[0], v1[1]); w.w = pk2(v1[2], v1[3]);
            *(u32x4*)(rowp + bj * 128) = w; } }
    } else if (wc == 0 && fq < 2) {
#pragma unroll
      for (int ai = 0; ai < 2; ++ai)
#pragma unroll
        for (int m = 0; m < 4; ++m) { float* sp = side + (size_t)(row0 + ai * 128 + m * 16) * 16 + 8 * fq;
          *(f32x4*)sp = acc[ai][0][m][0]; *(f32x4*)(sp + 4) = acc[ai][0][m][1]; }
    }
  }
};
struct EpiGate {
  static constexpr bool PERM = true;
  bf16_t* O; const bf16_t* proj; int br;
  DI void operator()(const f32x4 (&acc)[2][2][4][2], const pg8::Unit& u, int wr, int wc, int fr, int fq) const {
    const int row0 = u.pm * 256 + wr * 64 + fr, col0 = u.pn * 256 + wc * 32 + 8 * fq;
#pragma unroll
    for (int ai = 0; ai < 2; ++ai)
#pragma unroll
      for (int m = 0; m < 4; ++m) { const int row = row0 + ai * 128 + m * 16;
        bf16_t* rowp = O + (size_t)row * DM + col0; const bf16_t* gp = proj + (size_t)row * LDP + 12288 + br * 2048 + col0;
#pragma unroll
        for (int bj = 0; bj < 2; ++bj) { const f32x4 v0 = acc[ai][bj][m][0], v1 = acc[ai][bj][m][1];
          float gt[8], v[8]; unpack8(*(const u32x4*)(gp + bj * 128), gt);
#pragma unroll
          for (int j = 0; j < 4; ++j) { v[j] = v0[j] * sigmoidf_(gt[j]); v[4 + j] = v1[j] * sigmoidf_(gt[4 + j]); }
          if (br > 0) { float pv[8]; unpack8(*(const u32x4*)(rowp + bj * 128), pv);
#pragma unroll
            for (int j = 0; j < 8; ++j) v[j] += pv[j]; }
          *(u32x4*)(rowp + bj * 128) = pack8(v); } }
  }
};
struct EpiF32 {
  static constexpr bool PERM = false;
  float* C;
  DI void operator()(const f32x4 (&acc)[2][2][4][2], const pg8::Unit& u, int wr, int wc, int fr, int fq) const {
    const int row0 = u.pm * 256 + wr * 64 + fr, col0 = u.pn * 256 + wc * 32 + 4 * fq;
#pragma unroll
    for (int ai = 0; ai < 2; ++ai)
#pragma unroll
      for (int m = 0; m < 4; ++m) { float* rowp = C + (size_t)(row0 + ai * 128 + m * 16) * DM + col0;
#pragma unroll
        for (int bj = 0; bj < 2; ++bj)
#pragma unroll
          for (int n = 0; n < 2; ++n) *(f32x4*)(rowp + bj * 128 + n * 16) = acc[ai][bj][m][n]; }
  }
};

DI void conv_tile(float* T, const float* src, int ldsrc, int n0, int nvalid, int k0, bf16_t* dst, int K) {
  const int tid = otid();
  f32x4 v[8];
#pragma unroll
  for (int ps = 0; ps < 8; ++ps) { const int k = ps * 8 + (tid >> 6), c4 = (tid & 63) * 4;
    v[ps] = (f32x4){0.f, 0.f, 0.f, 0.f};
    if (c4 < nvalid) v[ps] = *(const f32x4*)(src + (size_t)(k0 + k) * ldsrc + n0 + c4); }
#pragma unroll
  for (int ps = 0; ps < 8; ++ps) { const int k = ps * 8 + (tid >> 6), c4 = (tid & 63) * 4;
    T[k * 257 + c4] = v[ps][0]; T[k * 257 + c4 + 1] = v[ps][1]; T[k * 257 + c4 + 2] = v[ps][2]; T[k * 257 + c4 + 3] = v[ps][3]; }
  __syncthreads();
#pragma unroll
  for (int i = 0; i < 4; ++i) { const int n = (tid >> 3) + 64 * i, kg = tid & 7; float w[8];
#pragma unroll
    for (int j = 0; j < 8; ++j) w[j] = T[(8 * kg + j) * 257 + n];
    *(u32x4*)(dst + (size_t)n * K + k0 + 8 * kg) = pack8(w); }
  __syncthreads();
}
DI void convert_weights(const Params& p, int l, float* T, int part, int first, int stride) {
  bf16_t* win = (bf16_t*)(p.ws + OFF_WIN); bf16_t* wbr = (bf16_t*)(p.ws + OFF_WBR); bf16_t* wout = (bf16_t*)(p.ws + OFF_WOUT);
  const int n_in = 73 * 32, n_br = 3 * 8 * 16, n_out = 8 * 32;
  const int t_lo = (part == 1) ? n_in + n_br : 0, t_hi = (part == 0) ? n_in + n_br : n_in + n_br + n_out;
  for (int t = t_lo + first; t < t_hi; t += stride) {
    if (t < n_in) { const int ntile = t >> 5, kt = t & 31, np0 = ntile * 256; int n0 = 0, nv = 256;
      if (np0 < 8192) n0 = np0; else if (np0 < 18432) n0 = np0 + 16; else { n0 = 8192; nv = 16; }
      conv_tile(T, p.w_in + (size_t)l * DM * NIN, NIN, n0, nv, kt * 64, win + (size_t)np0 * DM, DM);
    } else if (t < n_in + n_br) { const int u = t - n_in, br = u >> 7, r = u & 127, ntile = r >> 4, kt = r & 15;
      const float* src = (br == 0 ? p.w_ba : br == 1 ? p.w_bb : p.w_bc) + (size_t)l * 1024 * DM;
      conv_tile(T, src, DM, ntile * 256, 256, kt * 64, wbr + (size_t)br * DM * 1024 + (size_t)ntile * 256 * 1024, 1024);
    } else { const int u = t - n_in - n_br, ntile = u >> 5, kt = u & 31;
      conv_tile(T, p.w_out + (size_t)l * DM * DM, DM, ntile * 256, 256, kt * 64, wout + (size_t)ntile * 256 * DM, DM); }
  }
}

DI void prenorm_phase(const Params& p, int l) {
  bf16_t* h = (bf16_t*)(p.ws + OFF_H); const float* g = p.norm_pre + (size_t)l * DM;
  const int tid_ = otid(); const int lane = tid_ & 63, gw = oblk() * 8 + (tid_ >> 6), nw = gridDim.x * 8;
  for (int r = gw; r < MROWS; r += nw) {
    const float* xr = (r < 16384) ? p.x_prompt + (size_t)r * DM : p.x_sample + (size_t)(r - 16384) * DM;
    f32x4 v[8]; float ss = 0.f;
#pragma unroll
    for (int i = 0; i < 8; ++i) { v[i] = *(const f32x4*)(xr + i * 256 + lane * 4); ss += v[i][0] * v[i][0] + v[i][1] * v[i][1] + v[i][2] * v[i][2] + v[i][3] * v[i][3]; }
    ss = wsum(ss); const float rn = rsqrtf(ss * (1.f / DM) + 1e-6f);
#pragma unroll
    for (int i = 0; i < 8; ++i) { const f32x4 gg = *(const f32x4*)(g + i * 256 + lane * 4);
      u32x2 w; w.x = pk2(v[i][0] * rn * gg[0], v[i][1] * rn * gg[1]); w.y = pk2(v[i][2] * rn * gg[2], v[i][3] * rn * gg[3]);
      *(u32x2*)(h + (size_t)r * DM + i * 256 + lane * 4) = w; }
  }
}
DI void postnorm_phase(const Params& p, int l, int row_lo, int row_hi, int wg_first, int wg_count) {
  bf16_t* h = (bf16_t*)(p.ws + OFF_H); const float* ypre = (const float*)(p.ws + OFF_M1 + 69206016);
  const float* gpost = p.norm_post + (size_t)l * DM; const float* gpre = p.norm_pre + (size_t)(l + 1) * DM;
  const int tid_ = otid(); const int lane = tid_ & 63, gw = (oblk() - wg_first) * 8 + (tid_ >> 6), nw = wg_count * 8;
  for (int r = row_lo + gw; r < row_hi; r += nw) {
    const float* xr = (l > 0) ? p.out + (size_t)r * DM : ((r < 16384) ? p.x_prompt + (size_t)r * DM : p.x_sample + (size_t)(r - 16384) * DM);
    const float* yr = ypre + (size_t)r * DM;
    f32x4 v[8]; float ss = 0.f;
#pragma unroll
    for (int i = 0; i < 8; ++i) { v[i] = *(const f32x4*)(yr + i * 256 + lane * 4); ss += v[i][0] * v[i][0] + v[i][1] * v[i][1] + v[i][2] * v[i][2] + v[i][3] * v[i][3]; }
    ss = wsum(ss); const float rn = rsqrtf(ss * (1.f / DM) + 1e-6f); float s2 = 0.f;
#pragma unroll
    for (int i = 0; i < 8; ++i) { const f32x4 gg = *(const f32x4*)(gpost + i * 256 + lane * 4); const f32x4 xx = *(const f32x4*)(xr + i * 256 + lane * 4);
#pragma unroll
      for (int j = 0; j < 4; ++j) { v[i][j] = xx[j] + v[i][j] * rn * gg[j]; s2 += v[i][j] * v[i][j]; }
      *(f32x4*)(p.out + (size_t)r * DM + i * 256 + lane * 4) = v[i]; }
    if (l == 0) { s2 = wsum(s2); const float r2 = rsqrtf(s2 * (1.f / DM) + 1e-6f);
#pragma unroll
      for (int i = 0; i < 8; ++i) { const f32x4 gg = *(const f32x4*)(gpre + i * 256 + lane * 4);
        u32x2 w; w.x = pk2(v[i][0] * r2 * gg[0], v[i][1] * r2 * gg[1]); w.y = pk2(v[i][2] * r2 * gg[2], v[i][3] * r2 * gg[3]);
        *(u32x2*)(h + (size_t)r * DM + i * 256 + lane * 4) = w; } }
  }
}

template <class F> DI void write_T_perm(bf16_t* dst, F&& val) {
  const int t = otid(), r = t >> 2, q4 = t & 3, tb = q4 >> 1, p0 = 16 * (q4 & 1);
  float v[16];
#pragma unroll
  for (int j = 0; j < 16; ++j) v[j] = val(32 * tb + kperm(p0 + j), r);
  *(u32x4*)(dst + r * 64 + 32 * tb + p0) = pack8(v); *(u32x4*)(dst + r * 64 + 32 * tb + p0 + 8) = pack8(v + 8);
}
template <class F> DI void write_perm(bf16_t* dst, F&& val) {
  const int t = otid(), tok = t >> 3, cgp = t & 7, db = cgp >> 1, p0 = 16 * (cgp & 1);
  float v[16];
#pragma unroll
  for (int j = 0; j < 16; ++j) v[j] = val(tok, 32 * db + kperm(p0 + j));
  *(u32x4*)(dst + tok * 128 + 32 * db + p0) = pack8(v); *(u32x4*)(dst + tok * 128 + 32 * db + p0 + 8) = pack8(v + 8);
}

DI void conv16(const Params& p, const bf16_t* proj, int l, int ci, int ch0, int tok, float (&y)[16]) {
  const float* cw = p.conv_w + (size_t)l * 4 * 3072 + ch0;
#pragma unroll
  for (int c = 0; c < 16; ++c) y[c] = 0.f;
#pragma unroll
  for (int o = 0; o < 4; ++o) {
    const int t = tok - 3 + o; float xv[16];
    if (t >= 0 || (ci < 256 && (ci & 63) != 0)) {
      const bf16_t* src = proj + (size_t)(ci * 64 + t) * LDP + 4096 + ch0;
      unpack8(*(const u32x4*)src, xv); unpack8(*(const u32x4*)(src + 8), xv + 8);
    } else if (ci >= 256) {
      const float* sc = p.state_conv + ((size_t)(l * 8 + (ci - 256)) * 3 + (3 + t)) * 3072 + ch0;
#pragma unroll
      for (int q = 0; q < 4; ++q) { const f32x4 a = *(const f32x4*)(sc + 4 * q); xv[4 * q] = a[0]; xv[4 * q + 1] = a[1]; xv[4 * q + 2] = a[2]; xv[4 * q + 3] = a[3]; }
    } else {
#pragma unroll
      for (int c = 0; c < 16; ++c) xv[c] = 0.f;
    }
#pragma unroll
    for (int q = 0; q < 4; ++q) { const f32x4 w = *(const f32x4*)(cw + o * 3072 + 4 * q);
      y[4 * q] += w[0] * xv[4 * q]; y[4 * q + 1] += w[1] * xv[4 * q + 1]; y[4 * q + 2] += w[2] * xv[4 * q + 2]; y[4 * q + 3] += w[3] * xv[4 * q + 3]; }
  }
#pragma unroll
  for (int c = 0; c < 16; ++c) y[c] = siluf_(y[c]);
}

DI void conv_fetch(const Params& p, const bf16_t* proj, int l, int ci, int hh, int cgp, int tok, u32x4 (&raw)[3][4][2]) {
#pragma unroll
  for (int o = 0; o < 4; ++o) {
    const int t = tok - 3 + o;
#pragma unroll
    for (int mat = 0; mat < 3; ++mat) {
      const int ch0 = mat * 1024 + hh * 128 + 16 * cgp;
      if (t >= 0 || (ci < 256 && (ci & 63) != 0)) {
        const bf16_t* src = proj + (size_t)(ci * 64 + t) * LDP + 4096 + ch0;
        raw[mat][o][0] = *(const u32x4*)src; raw[mat][o][1] = *(const u32x4*)(src + 8);
      } else if (ci >= 256) {
        const float* sc = p.state_conv + ((size_t)(l * 8 + (ci - 256)) * 3 + (3 + t)) * 3072 + ch0; float f[16];
#pragma unroll
        for (int q = 0; q < 4; ++q) { const f32x4 a = *(const f32x4*)(sc + 4 * q); f[4 * q] = a[0]; f[4 * q + 1] = a[1]; f[4 * q + 2] = a[2]; f[4 * q + 3] = a[3]; }
        raw[mat][o][0] = pack8(f); raw[mat][o][1] = pack8(f + 8);
      } else { raw[mat][o][0] = (u32x4){0u, 0u, 0u, 0u}; raw[mat][o][1] = (u32x4){0u, 0u, 0u, 0u}; }
    }
  }
}
DI void conv_apply(const float* sCW, int mat, int cgp, const u32x4 (&raw)[3][4][2], float (&y)[16]) {
#pragma unroll
  for (int c = 0; c < 16; ++c) y[c] = 0.f;
#pragma unroll
  for (int o = 0; o < 4; ++o) { float xv[16]; unpack8(raw[mat][o][0], xv); unpack8(raw[mat][o][1], xv + 8);
#pragma unroll
    for (int q = 0; q < 4; ++q) { const f32x4 w = *(const f32x4*)(sCW + (mat * 4 + o) * 128 + 16 * cgp + 4 * q);
      y[4 * q] += w[0] * xv[4 * q]; y[4 * q + 1] += w[1] * xv[4 * q + 1]; y[4 * q + 2] += w[2] * xv[4 * q + 2]; y[4 * q + 3] += w[3] * xv[4 * q + 3]; } }
#pragma unroll
  for (int c = 0; c < 16; ++c) y[c] = siluf_(y[c]);
}

DI void delta_pre(const Params& p, int l, int it, unsigned char* smem) {
  const int ci = it >> 3, hh = it & 7, tid = otid(), wid = tid >> 6, lane = tid & 63, fr = lane & 15, fq = lane >> 4;
  bf16_t* sKB = (bf16_t*)smem; bf16_t* sQB = (bf16_t*)(smem + 17408); float* sKF = (float*)(smem + 34816); float* sVF = (float*)(smem + 68608);
  float* sA = (float*)(smem + 102400); float* sGC = (float*)(smem + 118784); float* sBT = sGC + 64; float* sEG = sGC + 128; float* sR1 = sGC + 192;
  const bf16_t* proj = (const bf16_t*)(p.ws + OFF_PROJ); const float* side = (const float*)(p.ws + OFF_SIDE);
  bf16_t* m1 = (bf16_t*)(p.ws + OFF_M1);
  bf16_t* dW = m1 + 0 * M1_BLK + (size_t)it * 8192; bf16_t* dQ = m1 + 1 * M1_BLK + (size_t)it * 8192; bf16_t* dKT = m1 + 2 * M1_BLK + (size_t)it * 8192;
  bf16_t* dUT = m1 + 3 * M1_BLK + (size_t)it * 8192; bf16_t* dIN = m1 + 8 * M1_BLK + (size_t)it * 4096;
  float g_bl = 0.f, g_al = 0.f, g_a = 0.f;
  if (wid == 0) { const int row = ci * 64 + lane;
    g_bl = side[(size_t)row * 16 + hh]; g_al = side[(size_t)row * 16 + 8 + hh] + p.dt_bias[l * 8 + hh]; g_a = p.a_log[l * 8 + hh]; }
  { const int tok = tid >> 3, cgp = tid & 7; float y[16]; const float* sCW = (const float*)(smem + 122880);
    u32x4 raw[3][4][2]; conv_fetch(p, proj, l, ci, hh, cgp, tok, raw);
    if (wid == 0) {
      const float sp = g_al > 20.f ? g_al : log1pf(__expf(g_al));
      float g = -__expf(g_a) * sp;
#pragma unroll
      for (int o = 1; o < 64; o <<= 1) { const float t = __shfl_up(g, o); if (lane >= o) g += t; }
      const float bt = sigmoidf_(g_bl), eg = __expf(g);
      sGC[lane] = g; sBT[lane] = bt; sEG[lane] = eg; sR1[lane] = bt * eg;
      if (lane == 63) ((float*)(p.ws + OFF_DG))[it] = eg;
    }
    conv_apply(sCW, 0, cgp, raw, y);
    { float ss = 0.f;
#pragma unroll
      for (int c = 0; c < 16; ++c) ss += y[c] * y[c];
      ss += __shfl_xor(ss, 1); ss += __shfl_xor(ss, 2); ss += __shfl_xor(ss, 4);
      const float rn = rsqrtf(ss + 1e-6f) * 0.08838834764831845f;
#pragma unroll
      for (int c = 0; c < 16; ++c) y[c] *= rn;
      *(u32x4*)(sQB + tok * 136 + 16 * cgp) = pack8(y); *(u32x4*)(sQB + tok * 136 + 16 * cgp + 8) = pack8(y + 8); }
    conv_apply(sCW, 1, cgp, raw, y);
    { float ss = 0.f;
#pragma unroll
      for (int c = 0; c < 16; ++c) ss += y[c] * y[c];
      ss += __shfl_xor(ss, 1); ss += __shfl_xor(ss, 2); ss += __shfl_xor(ss, 4);
      const float rn = rsqrtf(ss + 1e-6f);
#pragma unroll
      for (int c = 0; c < 16; ++c) { y[c] *= rn; sKF[tok * 132 + 16 * cgp + c] = y[c]; }
      *(u32x4*)(sKB + tok * 136 + 16 * cgp) = pack8(y); *(u32x4*)(sKB + tok * 136 + 16 * cgp + 8) = pack8(y + 8); }
    conv_apply(sCW, 2, cgp, raw, y);
#pragma unroll
    for (int c = 0; c < 16; ++c) sVF[tok * 132 + 16 * cgp + c] = y[c];
  }
  __syncthreads();
  {
    const int mt = wid & 3; const bf16_t* Asrc = (wid < 4) ? sKB : sQB;
    bf16x8 a[4];
#pragma unroll
    for (int s = 0; s < 4; ++s) a[s] = *(const bf16x8*)(Asrc + (16 * mt + fr) * 136 + 32 * s + 8 * fq);
#pragma unroll
    for (int nt = 0; nt < 4; ++nt) {
      f32x4 c = {0.f, 0.f, 0.f, 0.f};
#pragma unroll
      for (int s = 0; s < 4; ++s) { const bf16x8 b = *(const bf16x8*)(sKB + (16 * nt + fr) * 136 + 32 * s + 8 * fq); c = MFMA16(a[s], b, c); }
      const int j = 16 * nt + fr; const float gj = sGC[j];
#pragma unroll
      for (int r = 0; r < 4; ++r) { const int i = 16 * mt + 4 * fq + r; const float gi = sGC[i]; const float dec = __expf(fminf(gi - gj, 0.f));
        if (wid < 4) sA[i * 64 + j] = (i > j) ? sBT[i] * c[r] * dec : 0.f;
        else dIN[i * 64 + (j & 32) + kinv(j & 31)] = f2bf((i >= j) ? c[r] * dec : 0.f); }
    }
  }
  __syncthreads();
  if (wid < 4) {
    int zv = 0; asm volatile("" : "+v"(zv));
    const int c = tid; const float* src = (c < 128) ? sVF + c : sKF + (c - 128); const float* scl = ((c < 128) ? sBT : sR1) + zv; const float* sAz = sA + zv;
    f32x2 sp[32];
#pragma unroll
    for (int i = 0; i < 32; ++i) sp[i] = (f32x2){0.f, 0.f};
    f32x4 Bk[2][8]; float rs[2], rc[2];
    f32x2 a0 = {0.f, 0.f}, a1 = {0.f, 0.f};
    rs[0] = src[0]; rc[0] = scl[0];
#pragma unroll
    for (int t = 0; t < 95; ++t) {
      const int i = t < 33 ? t : 33 + ((t - 33) >> 1), part = t < 33 ? 0 : ((t - 33) & 1), n = (i + 3) / 4;
      const int j0 = part * 8, j1 = (part == 0) ? (n < 8 ? n : 8) : n;
      const bool last = (part == 1) || (n <= 8);
      if (t + 1 < 95) { const int t2 = t + 1, i2 = t2 < 33 ? t2 : 33 + ((t2 - 33) >> 1), p2 = t2 < 33 ? 0 : ((t2 - 33) & 1), n2 = (i2 + 3) / 4;
        const int k0 = p2 * 8, k1 = (p2 == 0) ? (n2 < 8 ? n2 : 8) : n2;
#pragma unroll
        for (int j4 = k0; j4 < k1; ++j4) Bk[t2 & 1][j4 - k0] = *(const f32x4*)(sAz + i2 * 64 + 4 * j4);
        if (p2 == 0) { rs[t2 & 1] = src[i2 * 132]; rc[t2 & 1] = scl[i2]; } }
      __builtin_amdgcn_sched_barrier(0);
      if (part == 0) { a0 = (f32x2){rs[t & 1] * rc[t & 1], 0.f}; a1 = (f32x2){0.f, 0.f}; }
#pragma unroll
      for (int j4 = j0; j4 < j1; ++j4) { const f32x4 a = Bk[t & 1][j4 - j0];
        a0 -= (f32x2){a[0], a[1]} * sp[2 * j4]; a1 -= (f32x2){a[2], a[3]} * sp[2 * j4 + 1]; }
      if (last) { const f32x2 tt = a0 + a1; sp[i >> 1][i & 1] = tt[0] + tt[1]; }
      __builtin_amdgcn_sched_barrier(0);
    }
    float sol[64];
#pragma unroll
    for (int i = 0; i < 64; ++i) sol[i] = sp[i >> 1][i & 1];
    if (c < 128) {
#pragma unroll
      for (int q = 0; q < 8; ++q) *(u32x4*)(dUT + c * 64 + 8 * q) = pack8(sol + 8 * q);
    } else { const int d = c - 128, pos = (d & ~31) + kinv(d & 31);
#pragma unroll
      for (int i = 0; i < 64; ++i) dW[i * 128 + pos] = f2bf(-sol[i]); }
  } else {
    const int t = tid - 256; const float gl = sGC[63];
    { const int tok = t >> 2, db = t & 3; const float eg = sEG[tok]; float v[32];
#pragma unroll
      for (int pp = 0; pp < 32; ++pp) v[pp] = bf2f(sQB[tok * 136 + 32 * db + kperm(pp)]) * eg;
#pragma unroll
      for (int q = 0; q < 4; ++q) *(u32x4*)(dQ + tok * 128 + 32 * db + 8 * q) = pack8(v + 8 * q); }
    { const int d = t >> 1, tb = t & 1; float v[32];
#pragma unroll
      for (int pp = 0; pp < 32; ++pp) { const int tok = 32 * tb + kperm(pp); v[pp] = sKF[tok * 132 + d] * __expf(gl - sGC[tok]); }
#pragma unroll
      for (int q = 0; q < 4; ++q) *(u32x4*)(dKT + d * 64 + 32 * tb + 8 * q) = pack8(v + 8 * q); }
  }
  __syncthreads();
}

DI void ret_pre(const Params& p, int l, int it, unsigned char* smem) {
  const int ci = it >> 3, hh = it & 7, tid = otid(), wid = tid >> 6, lane = tid & 63, fr = lane & 15, fq = lane >> 4;
  bf16_t* sQB = (bf16_t*)smem; bf16_t* sKB = (bf16_t*)(smem + 17408); float* sKZ = (float*)(smem + 34816); float* sVF = (float*)(smem + 68608);
  const bf16_t* proj = (const bf16_t*)(p.ws + OFF_PROJ);
  bf16_t* m1 = (bf16_t*)(p.ws + OFF_M1);
  bf16_t* rQ = m1 + 4 * M1_BLK + (size_t)it * 8192; bf16_t* rKT = m1 + 5 * M1_BLK + (size_t)it * 8192; bf16_t* rVT = m1 + 6 * M1_BLK + (size_t)it * 8192;
  bf16_t* rIN = m1 + 8 * M1_BLK + (size_t)NITEM * 4096 + (size_t)it * 4096;
  const float lg = __logf(1.f - exp2f(-5.f - (float)hh));
  { const int tok = tid >> 3, cgp = tid & 7; const bf16_t* rp = proj + (size_t)(ci * 64 + tok) * LDP;
    const int pos = (ci >= 256) ? 2048 + tok : (ci & 63) * 64 + tok;
    float q1[8], q2[8], k1[8], k2[8], vv[16];
    unpack8(*(const u32x4*)(rp + 8192 + hh * 128 + 8 * cgp), q1); unpack8(*(const u32x4*)(rp + 8192 + hh * 128 + 64 + 8 * cgp), q2);
    unpack8(*(const u32x4*)(rp + 9216 + hh * 128 + 8 * cgp), k1); unpack8(*(const u32x4*)(rp + 9216 + hh * 128 + 64 + 8 * cgp), k2);
    unpack8(*(const u32x4*)(rp + 10240 + hh * 128 + 16 * cgp), vv); unpack8(*(const u32x4*)(rp + 10240 + hh * 128 + 16 * cgp + 8), vv + 8);
    const float zeta = __expf(lg * (float)(63 - tok)) * 0.08838834764831845f;
    float qa[8], qb[8], ka[8], kb[8];
#pragma unroll
    for (int j = 0; j < 8; ++j) { const int i = 8 * cgp + j;
      const float inv = exp2f(-(float)i * (13.287712379549449f / 64.f)); const float ang = (float)pos * inv;
      float rv = ang * 0.15915494309189535f; rv = rv - floorf(rv);
      const float sn = __builtin_amdgcn_sinf(rv), cs = __builtin_amdgcn_cosf(rv);
      qa[j] = q1[j] * cs - q2[j] * sn; qb[j] = q1[j] * sn + q2[j] * cs;
      ka[j] = (k1[j] * cs - k2[j] * sn); kb[j] = (k1[j] * sn + k2[j] * cs);
      sKZ[tok * 132 + i] = ka[j] * zeta; sKZ[tok * 132 + 64 + i] = kb[j] * zeta;
      ka[j] *= 0.08838834764831845f; kb[j] *= 0.08838834764831845f; }
    *(u32x4*)(sQB + tok * 136 + 8 * cgp) = pack8(qa); *(u32x4*)(sQB + tok * 136 + 64 + 8 * cgp) = pack8(qb);
    *(u32x4*)(sKB + tok * 136 + 8 * cgp) = pack8(ka); *(u32x4*)(sKB + tok * 136 + 64 + 8 * cgp) = pack8(kb);
#pragma unroll
    for (int c = 0; c < 16; ++c) sVF[tok * 132 + 16 * cgp + c] = vv[c];
  }
  __syncthreads();
  { const int mt = wid >> 1;
    bf16x8 a[4];
#pragma unroll
    for (int s = 0; s < 4; ++s) a[s] = *(const bf16x8*)(sQB + (16 * mt + fr) * 136 + 32 * s + 8 * fq);
#pragma unroll
    for (int n2 = 0; n2 < 2; ++n2) { const int nt = 2 * (wid & 1) + n2;
      f32x4 c = {0.f, 0.f, 0.f, 0.f};
#pragma unroll
      for (int s = 0; s < 4; ++s) { const bf16x8 b = *(const bf16x8*)(sKB + (16 * nt + fr) * 136 + 32 * s + 8 * fq); c = MFMA16(a[s], b, c); }
      const int j = 16 * nt + fr;
#pragma unroll
      for (int r = 0; r < 4; ++r) { const int i = 16 * mt + 4 * fq + r;
        rIN[i * 64 + (j & 32) + kinv(j & 31)] = f2bf((i >= j) ? c[r] * __expf(lg * (float)(i - j)) : 0.f); }
    }
  }
  write_perm(rQ, [&](int tok, int d) { return bf2f(sQB[tok * 136 + d]) * __expf(lg * (float)(tok + 1)); });
  write_T_perm(rKT, [&](int tok, int d) { return sKZ[tok * 132 + d]; });
  write_T_perm(rVT, [&](int tok, int e) { return sVF[tok * 132 + e]; });
  __syncthreads();
}

DI void misc_item(const Params& p, int l, int it, unsigned char* smem) {
  const int ci = it >> 3, hh = it & 7, tid = otid();
  bf16_t* sVB = (bf16_t*)smem;
  const bf16_t* proj = (const bf16_t*)(p.ws + OFF_PROJ);
  bf16_t* aVT = (bf16_t*)(p.ws + OFF_M1) + 7 * M1_BLK + (size_t)it * 8192;
  { const int tok = tid >> 3, cgp = tid & 7; const bf16_t* rp = proj + (size_t)(ci * 64 + tok) * LDP;
    const u32x4 v0 = *(const u32x4*)(rp + 2048 + hh * 128 + 16 * cgp), v1 = *(const u32x4*)(rp + 2048 + hh * 128 + 16 * cgp + 8);
    *(u32x4*)(sVB + tok * 136 + 16 * cgp) = v0; *(u32x4*)(sVB + tok * 136 + 16 * cgp + 8) = v1;
    float* ok = nullptr; float* ov = nullptr;
    if (ci < 256) { const int b = ci >> 6, c = ci & 63;
      if (c >= 56) { const size_t o = ((((size_t)l * 4 + b) * 512 + (c - 56) * 64 + tok) * 8 + hh) * 128 + 16 * cgp; ok = p.out + O_PK + o; ov = p.out + O_PV + o; }
    } else { const size_t o = ((((size_t)l * 8 + (ci - 256)) * 512 + 448 + tok) * 8 + hh) * 128 + 16 * cgp; ok = p.out + O_SK + o; ov = p.out + O_SV + o; }
    if (ok) { float f[16]; unpack8(v0, f); unpack8(v1, f + 8);
#pragma unroll
      for (int q = 0; q < 4; ++q) *(f32x4*)(ov + 4 * q) = (f32x4){f[4 * q], f[4 * q + 1], f[4 * q + 2], f[4 * q + 3]};
      unpack8(*(const u32x4*)(rp + 1024 + hh * 128 + 16 * cgp), f); unpack8(*(const u32x4*)(rp + 1024 + hh * 128 + 16 * cgp + 8), f + 8);
#pragma unroll
      for (int q = 0; q < 4; ++q) *(f32x4*)(ok + 4 * q) = (f32x4){f[4 * q], f[4 * q + 1], f[4 * q + 2], f[4 * q + 3]}; }
  }
  if (ci >= 256 || (ci & 63) == 63) {
    float* oc = (ci < 256) ? p.out + O_PC + ((size_t)l * 4 + (ci >> 6)) * 3 * 3072 : p.out + O_SC + ((size_t)l * 8 + (ci - 256)) * 3 * 3072;
    for (int idx = tid; idx < 3 * 384; idx += 512) { const int rr = idx / 384, ch = hh * 384 + idx % 384;
      oc[rr * 3072 + ch] = bf2f(proj[(size_t)(ci * 64 + 61 + rr) * LDP + 4096 + ch]); }
  }
  __syncthreads();
  write_T_perm(aVT, [&](int tok, int e) { return bf2f(sVB[tok * 136 + e]); });
  __syncthreads();
}
DI void cache_item(const Params& p, int l, int cit, unsigned char* smem) {
  const int hh = cit & 7, j = (cit >> 3) & 7, sb = cit >> 6, tid = otid();
  float* sVF = (float*)smem;
  bf16_t* kc = (bf16_t*)(p.ws + OFF_KC) + (size_t)cit * 8192; bf16_t* cvt = (bf16_t*)(p.ws + OFF_CVT) + (size_t)cit * 8192;
  { const int key = tid >> 3, cgp = tid & 7;
    const size_t so = ((((size_t)l * 8 + sb) * 512 + 64 * j + key) * 8 + hh) * 128 + 16 * cgp;
    float fk[16], fv[16];
#pragma unroll
    for (int q = 0; q < 4; ++q) { const f32x4 a = *(const f32x4*)(p.cache_k + so + 4 * q); const f32x4 b = *(const f32x4*)(p.cache_v + so + 4 * q);
#pragma unroll
      for (int e = 0; e < 4; ++e) { fk[4 * q + e] = a[e]; fv[4 * q + e] = b[e]; } }
    *(u32x4*)(kc + key * 128 + 16 * cgp) = pack8(fk); *(u32x4*)(kc + key * 128 + 16 * cgp + 8) = pack8(fk + 8);
#pragma unroll
    for (int c = 0; c < 16; ++c) sVF[key * 132 + 16 * cgp + c] = fv[c];
    if (j >= 1) { const size_t oo = ((((size_t)l * 8 + sb) * 512 + 64 * (j - 1) + key) * 8 + hh) * 128 + 16 * cgp;
#pragma unroll
      for (int q = 0; q < 4; ++q) { *(f32x4*)(p.out + O_SK + oo + 4 * q) = (f32x4){fk[4 * q], fk[4 * q + 1], fk[4 * q + 2], fk[4 * q + 3]};
        *(f32x4*)(p.out + O_SV + oo + 4 * q) = (f32x4){fv[4 * q], fv[4 * q + 1], fv[4 * q + 2], fv[4 * q + 3]}; } }
  }
  __syncthreads();
  write_T_perm(cvt, [&](int tok, int e) { return sVF[tok * 132 + e]; });
  __syncthreads();
}

template <int TYPE> DI void scan_item(const Params& p, int l, int seq, int hh, int sl) {
  const int lane = otid() & 63, fr = lane & 15, fq = lane >> 4, e0 = 16 * sl;
  const int nsteps = seq < 4 ? 64 : 1, ci0 = seq < 4 ? seq * 64 : 256 + (seq - 4);
  const bf16_t* m1 = (const bf16_t*)(p.ws + OFF_M1);
  bf16_t* proj = (bf16_t*)(p.ws + OFF_PROJ);
  const float* dG = (const float*)(p.ws + OFF_DG);
  f32x4 S[8];
  if (seq < 4) {
#pragma unroll
    for (int t = 0; t < 8; ++t) S[t] = (f32x4){0.f, 0.f, 0.f, 0.f};
  } else { const float* st = (TYPE == 0 ? p.state_delta : p.state_ret) + (((size_t)l * 8 + (seq - 4)) * 8 + hh) * 16384 + e0 + fr;
#pragma unroll
    for (int t = 0; t < 8; ++t)
#pragma unroll
      for (int i = 0; i < 4; ++i) S[t][i] = st[(16 * t + 4 * fq + i) * 128]; }
  const float gret = __expf(64.f * __logf(1.f - exp2f(-5.f - (float)hh)));
  for (int n = 0; n < nsteps; ++n) {
    const int it = (ci0 + n) * 8 + hh;
    const bf16_t* W = m1 + 0 * M1_BLK + (size_t)it * 8192;
    const bf16_t* Q = m1 + (TYPE == 0 ? 1 : 4) * M1_BLK + (size_t)it * 8192;
    const bf16_t* KT = m1 + (TYPE == 0 ? 2 : 5) * M1_BLK + (size_t)it * 8192;
    const bf16_t* UT = m1 + (TYPE == 0 ? 3 : 6) * M1_BLK + (size_t)it * 8192;
    const bf16_t* IN = m1 + 8 * M1_BLK + (TYPE == 0 ? 0 : (size_t)NITEM * 4096) + (size_t)it * 4096;
    bf16x8 Sf[4];
#pragma unroll
    for (int s = 0; s < 4; ++s) Sf[s] = pack_frag(S[2 * s], S[2 * s + 1]);
    bf16x8 Vf[2];
    if (TYPE == 0) {
      f32x4 Vn[4];
#pragma unroll
      for (int mt = 0; mt < 4; ++mt) { const u32x2 u = *(const u32x2*)(UT + (e0 + fr) * 64 + 16 * mt + 4 * fq); Vn[mt] = (f32x4){bflo(u.x), bfhi(u.x), bflo(u.y), bfhi(u.y)}; }
#pragma unroll
      for (int s = 0; s < 4; ++s)
#pragma unroll
        for (int mt = 0; mt < 4; ++mt) { const bf16x8 a = *(const bf16x8*)(W + (16 * mt + fr) * 128 + 32 * s + 8 * fq); Vn[mt] = MFMA16(a, Sf[s], Vn[mt]); }
      Vf[0] = pack_frag(Vn[0], Vn[1]); Vf[1] = pack_frag(Vn[2], Vn[3]);
    } else {
      Vf[0] = *(const bf16x8*)(UT + (e0 + fr) * 64 + 8 * fq); Vf[1] = *(const bf16x8*)(UT + (e0 + fr) * 64 + 32 + 8 * fq);
    }
    f32x4 O[4];
#pragma unroll
    for (int nt = 0; nt < 4; ++nt) O[nt] = (f32x4){0.f, 0.f, 0.f, 0.f};
#pragma unroll
    for (int s = 0; s < 4; ++s)
#pragma unroll
      for (int nt = 0; nt < 4; ++nt) { const bf16x8 b = *(const bf16x8*)(Q + (16 * nt + fr) * 128 + 32 * s + 8 * fq); O[nt] = MFMA16(Sf[s], b, O[nt]); }
#pragma unroll
    for (int s2 = 0; s2 < 2; ++s2)
#pragma unroll
      for (int nt = 0; nt < 4; ++nt) { const bf16x8 b = *(const bf16x8*)(IN + (16 * nt + fr) * 64 + 32 * s2 + 8 * fq); O[nt] = MFMA16(Vf[s2], b, O[nt]); }
#pragma unroll
    for (int nt = 0; nt < 4; ++nt) { u32x2 w; w.x = pk2(O[nt][0], O[nt][1]); w.y = pk2(O[nt][2], O[nt][3]);
      *(u32x2*)(proj + (size_t)((ci0 + n) * 64 + 16 * nt + fr) * LDP + (TYPE == 0 ? C_OBRAW : C_OCRAW) + hh * 128 + e0 + 4 * fq) = w; }
    const float gb = (TYPE == 0) ? dG[it] : gret;
#pragma unroll
    for (int dt = 0; dt < 8; ++dt) { S[dt] = S[dt] * gb;
#pragma unroll
      for (int s2 = 0; s2 < 2; ++s2) { const bf16x8 a = *(const bf16x8*)(KT + (16 * dt + fr) * 64 + 32 * s2 + 8 * fq); S[dt] = MFMA16(a, Vf[s2], S[dt]); } }
  }
  { float* so = p.out + (seq < 4 ? (TYPE == 0 ? O_PD : O_PR) + (((size_t)l * 4 + seq) * 8 + hh) * 16384 : (TYPE == 0 ? O_SD : O_SR) + (((size_t)l * 8 + (seq - 4)) * 8 + hh) * 16384) + e0 + fr;
#pragma unroll
    for (int t = 0; t < 8; ++t)
#pragma unroll
      for (int i = 0; i < 4; ++i) so[(16 * t + 4 * fq + i) * 128] = S[t][i]; }
}

template <int TYPE> DI void scan_step(const unsigned char* B, f32x4 (&S)[8], const u32x4 (&uc)[2], float gb, bf16_t* orow, int fr, int fq) {
#define SW_A128(base_, row_, s_) (*(const bf16x8*)((base_) + (((row_) * 16 + ((4 * (s_) + fq) ^ fr)) * 16)))
#define SW_A64(base_, row_, s_) (*(const bf16x8*)((base_) + (((row_) * 8 + ((4 * (s_) + fq) ^ (fr >> 1))) * 16)))
  bf16x8 Sf[4];
#pragma unroll
  for (int s = 0; s < 4; ++s) Sf[s] = pack_frag(S[2 * s], S[2 * s + 1]);
  bf16x8 Vf[2];
  if (TYPE == 0) {
    f32x4 Vn[4];
#pragma unroll
    for (int mt = 0; mt < 4; ++mt) { const unsigned ux = uc[mt >> 1][(mt & 1) * 2], uy = uc[mt >> 1][(mt & 1) * 2 + 1]; Vn[mt] = (f32x4){bflo(ux), bfhi(ux), bflo(uy), bfhi(uy)}; }
#pragma unroll
    for (int s = 0; s < 4; ++s)
#pragma unroll
      for (int mt = 0; mt < 4; ++mt) Vn[mt] = MFMA16(SW_A128(B, 16 * mt + fr, s), Sf[s], Vn[mt]);
    Vf[0] = pack_frag(Vn[0], Vn[1]); Vf[1] = pack_frag(Vn[2], Vn[3]);
  } else { Vf[0] = __builtin_bit_cast(bf16x8, uc[0]); Vf[1] = __builtin_bit_cast(bf16x8, uc[1]); }
  f32x4 O[4];
#pragma unroll
  for (int nt = 0; nt < 4; ++nt) O[nt] = (f32x4){0.f, 0.f, 0.f, 0.f};
#pragma unroll
  for (int s = 0; s < 4; ++s)
#pragma unroll
    for (int nt = 0; nt < 4; ++nt) O[nt] = MFMA16(Sf[s], SW_A128(B + 16384, 16 * nt + fr, s), O[nt]);
#pragma unroll
  for (int s2 = 0; s2 < 2; ++s2)
#pragma unroll
    for (int nt = 0; nt < 4; ++nt) O[nt] = MFMA16(Vf[s2], SW_A64(B + 49152, 16 * nt + fr, s2), O[nt]);
#pragma unroll
  for (int nt = 0; nt < 4; ++nt) { u32x2 w; w.x = pk2(O[nt][0], O[nt][1]); w.y = pk2(O[nt][2], O[nt][3]); *(u32x2*)(orow + (size_t)(16 * nt) * LDP) = w; }
#pragma unroll
  for (int dt = 0; dt < 8; ++dt) { S[dt] = S[dt] * gb;
#pragma unroll
    for (int s2 = 0; s2 < 2; ++s2) S[dt] = MFMA16(SW_A64(B + 32768, 16 * dt + fr, s2), Vf[s2], S[dt]); }
#undef SW_A128
#undef SW_A64
}
template <int TYPE> DI void scan_wg(const Params& p, int l, int seq, int hh, unsigned char* smem) {
  const int tid = otid(), lane = tid & 63, wv = tid >> 6, fr = lane & 15, fq = lane >> 4, e0 = 16 * wv;
  const int ci0 = seq * 64;
  const bf16_t* m1 = (const bf16_t*)(p.ws + OFF_M1);
  bf16_t* proj = (bf16_t*)(p.ws + OFF_PROJ);
  const float* dG = (const float*)(p.ws + OFF_DG);
  const bf16_t* gW = m1 + 0 * M1_BLK; const bf16_t* gQ = m1 + (TYPE == 0 ? 1 : 4) * M1_BLK; const bf16_t* gKT = m1 + (TYPE == 0 ? 2 : 5) * M1_BLK;
  const bf16_t* gUT = m1 + (TYPE == 0 ? 3 : 6) * M1_BLK; const bf16_t* gIN = m1 + 8 * M1_BLK + (TYPE == 0 ? 0 : (size_t)NITEM * 4096);
  f32x4 S[8];
#pragma unroll
  for (int t = 0; t < 8; ++t) S[t] = (f32x4){0.f, 0.f, 0.f, 0.f};
  const float gvec = (TYPE == 0) ? dG[(ci0 + lane) * 8 + hh] : __expf(64.f * __logf(1.f - exp2f(-5.f - (float)hh)));
  int d128[2], d64[2];
#pragma unroll
  for (int k = 0; k < 2; ++k) { const int q = tid + 512 * k; { const int r = q >> 4, c = q & 15; d128[k] = (r * 16 + (c ^ (r & 15))) * 16; }
    { const int r = q >> 3, c = q & 7; d64[k] = (r * 8 + (c ^ ((r >> 1) & 7))) * 16; } }
  u32x4 st[2][7]; u32x4 uv[2][2];
#define SW_ISSUE(n_, X_) do { const size_t it_ = (size_t)((ci0 + (n_)) * 8 + hh); \
    if (TYPE == 0) { st[X_][0] = *(const u32x4*)(gW + it_ * 8192 + tid * 8); st[X_][1] = *(const u32x4*)(gW + it_ * 8192 + (tid + 512) * 8); } \
    st[X_][2] = *(const u32x4*)(gQ + it_ * 8192 + tid * 8); st[X_][3] = *(const u32x4*)(gQ + it_ * 8192 + (tid + 512) * 8); \
    st[X_][4] = *(const u32x4*)(gKT + it_ * 8192 + tid * 8); st[X_][5] = *(const u32x4*)(gKT + it_ * 8192 + (tid + 512) * 8); \
    st[X_][6] = *(const u32x4*)(gIN + it_ * 4096 + tid * 8); \
    if (TYPE == 0) { _Pragma("unroll") for (int mt = 0; mt < 4; ++mt) { const u32x2 u_ = *(const u32x2*)(gUT + it_ * 8192 + (e0 + fr) * 64 + 16 * mt + 4 * fq); uv[X_][mt >> 1][(mt & 1) * 2] = u_.x; uv[X_][mt >> 1][(mt & 1) * 2 + 1] = u_.y; } } \
    else { uv[X_][0] = *(const u32x4*)(gUT + it_ * 8192 + (e0 + fr) * 64 + 8 * fq); uv[X_][1] = *(const u32x4*)(gUT + it_ * 8192 + (e0 + fr) * 64 + 32 + 8 * fq); } } while (0)
#define SW_COMMIT(b_, X_) do { unsigned char* B_ = smem + (b_) * 57344; \
    if (TYPE == 0) { *(u32x4*)(B_ + d128[0]) = st[X_][0]; *(u32x4*)(B_ + d128[1]) = st[X_][1]; } \
    *(u32x4*)(B_ + 16384 + d128[0]) = st[X_][2]; *(u32x4*)(B_ + 16384 + d128[1]) = st[X_][3]; \
    *(u32x4*)(B_ + 32768 + d64[0]) = st[X_][4]; *(u32x4*)(B_ + 32768 + d64[1]) = st[X_][5]; *(u32x4*)(B_ + 49152 + d64[0]) = st[X_][6]; \
    ucur[0] = uv[X_][0]; ucur[1] = uv[X_][1]; } while (0)
  u32x4 ucur[2];
  bf16_t* obase = proj + (size_t)(ci0 * 64 + fr) * LDP + (TYPE == 0 ? C_OBRAW : C_OCRAW) + hh * 128 + e0 + 4 * fq;
  SW_ISSUE(0, 0);
  SW_COMMIT(0, 0);
  SW_ISSUE(1, 1);
  __syncthreads();
  for (int n = 0; n < 64; n += 2) {
    if (n + 2 < 64) SW_ISSUE(n + 2, 0);
    scan_step<TYPE>(smem, S, ucur, __shfl(gvec, n), obase + (size_t)(n * 64) * LDP, fr, fq);
    SW_COMMIT(1, 1);
    __syncthreads();
    if (n + 3 < 64) SW_ISSUE(n + 3, 1);
    scan_step<TYPE>(smem + 57344, S, ucur, __shfl(gvec, n + 1), obase + (size_t)((n + 1) * 64) * LDP, fr, fq);
    if (n + 2 < 64) SW_COMMIT(0, 0);
    __syncthreads();
  }
#undef SW_ISSUE
#undef SW_COMMIT
  { float* so = p.out + (TYPE == 0 ? O_PD : O_PR) + (((size_t)l * 4 + seq) * 8 + hh) * 16384 + e0 + fr;
#pragma unroll
    for (int t = 0; t < 8; ++t)
#pragma unroll
      for (int i = 0; i < 4; ++i) so[(16 * t + 4 * fq + i) * 128] = S[t][i]; }
}

template <int TYPE> DI void scan_step2(const unsigned char* B, f32x4 (&S)[2][8], const u32x4 (&uc)[2][2], float gb, bf16_t* orow, int fr, int fq) {
#define SW_A128(base_, row_, s_) (*(const bf16x8*)((base_) + (((row_) * 16 + ((4 * (s_) + fq) ^ fr)) * 16)))
#define SW_A64(base_, row_, s_) (*(const bf16x8*)((base_) + (((row_) * 8 + ((4 * (s_) + fq) ^ (fr >> 1))) * 16)))
  bf16x8 Sf[2][4];
#pragma unroll
  for (int c = 0; c < 2; ++c)
#pragma unroll
    for (int s = 0; s < 4; ++s) Sf[c][s] = pack_frag(S[c][2 * s], S[c][2 * s + 1]);
  bf16x8 Vf[2][2];
  if (TYPE == 0) {
    f32x4 Vn[2][4];
#pragma unroll
    for (int c = 0; c < 2; ++c)
#pragma unroll
      for (int mt = 0; mt < 4; ++mt) { const unsigned ux = uc[c][mt >> 1][(mt & 1) * 2], uy = uc[c][mt >> 1][(mt & 1) * 2 + 1]; Vn[c][mt] = (f32x4){bflo(ux), bfhi(ux), bflo(uy), bfhi(uy)}; }
#pragma unroll
    for (int s = 0; s < 4; ++s)
#pragma unroll
      for (int mt = 0; mt < 4; ++mt) { const bf16x8 a = SW_A128(B, 16 * mt + fr, s); Vn[0][mt] = MFMA16(a, Sf[0][s], Vn[0][mt]); Vn[1][mt] = MFMA16(a, Sf[1][s], Vn[1][mt]); }
#pragma unroll
    for (int c = 0; c < 2; ++c) { Vf[c][0] = pack_frag(Vn[c][0], Vn[c][1]); Vf[c][1] = pack_frag(Vn[c][2], Vn[c][3]); }
  } else {
#pragma unroll
    for (int c = 0; c < 2; ++c) { Vf[c][0] = __builtin_bit_cast(bf16x8, uc[c][0]); Vf[c][1] = __builtin_bit_cast(bf16x8, uc[c][1]); }
  }
  f32x4 O[2][4];
#pragma unroll
  for (int c = 0; c < 2; ++c)
#pragma unroll
    for (int nt = 0; nt < 4; ++nt) O[c][nt] = (f32x4){0.f, 0.f, 0.f, 0.f};
#pragma unroll
  for (int s = 0; s < 4; ++s)
#pragma unroll
    for (int nt = 0; nt < 4; ++nt) { const bf16x8 b = SW_A128(B + 16384, 16 * nt + fr, s); O[0][nt] = MFMA16(Sf[0][s], b, O[0][nt]); O[1][nt] = MFMA16(Sf[1][s], b, O[1][nt]); }
#pragma unroll
  for (int s2 = 0; s2 < 2; ++s2)
#pragma unroll
    for (int nt = 0; nt < 4; ++nt) { const bf16x8 b = SW_A64(B + 49152, 16 * nt + fr, s2); O[0][nt] = MFMA16(Vf[0][s2], b, O[0][nt]); O[1][nt] = MFMA16(Vf[1][s2], b, O[1][nt]); }
#pragma unroll
  for (int c = 0; c < 2; ++c)
#pragma unroll
    for (int nt = 0; nt < 4; ++nt) { u32x2 w; w.x = pk2(O[c][nt][0], O[c][nt][1]); w.y = pk2(O[c][nt][2], O[c][nt][3]); *(u32x2*)(orow + (size_t)(16 * nt) * LDP + 16 * c) = w; }
#pragma unroll
  for (int dt = 0; dt < 8; ++dt) { S[0][dt] = S[0][dt] * gb; S[1][dt] = S[1][dt] * gb;
#pragma unroll
    for (int s2 = 0; s2 < 2; ++s2) { const bf16x8 a = SW_A64(B + 32768, 16 * dt + fr, s2); S[0][dt] = MFMA16(a, Vf[0][s2], S[0][dt]); S[1][dt] = MFMA16(a, Vf[1][s2], S[1][dt]); } }
#undef SW_A128
#undef SW_A64
}
template <int TYPE> DI void scan_wg2(const Params& p, int l, int seq, int hh, unsigned char* smem) {
  const int tid = otid(), lane = tid & 63, wv = tid >> 6, fr = lane & 15, fq = lane >> 4;
  const int ci0 = seq * 64;
  const bf16_t* m1 = (const bf16_t*)(p.ws + OFF_M1);
  const bf16_t* gW = m1 + 0 * M1_BLK; const bf16_t* gQ = m1 + (TYPE == 0 ? 1 : 4) * M1_BLK; const bf16_t* gKT = m1 + (TYPE == 0 ? 2 : 5) * M1_BLK;
  const bf16_t* gUT = m1 + (TYPE == 0 ? 3 : 6) * M1_BLK; const bf16_t* gIN = m1 + 8 * M1_BLK + (TYPE == 0 ? 0 : (size_t)NITEM * 4096);
  if (wv >= 4) {
    const int lt = tid - 256;
    const int b128 = ((lt >> 4) * 16 + ((lt & 15) ^ ((lt >> 4) & 15))) * 16, b64 = ((lt >> 3) * 8 + ((lt & 7) ^ ((lt >> 4) & 7))) * 16;
    u32x4 st[2][14];
#define LW_ISSUE(n_, X_) do { const size_t it_ = (size_t)((ci0 + (n_)) * 8 + hh); \
      _Pragma("unroll") for (int k = 0; k < 4; ++k) { if (TYPE == 0) st[X_][k] = *(const u32x4*)(gW + it_ * 8192 + (lt + 256 * k) * 8); \
        st[X_][4 + k] = *(const u32x4*)(gQ + it_ * 8192 + (lt + 256 * k) * 8); st[X_][8 + k] = *(const u32x4*)(gKT + it_ * 8192 + (lt + 256 * k) * 8); } \
      st[X_][12] = *(const u32x4*)(gIN + it_ * 4096 + lt * 8); st[X_][13] = *(const u32x4*)(gIN + it_ * 4096 + (lt + 256) * 8); } while (0)
#define LW_COMMIT(b_, X_) do { unsigned char* B_ = smem + (b_) * 57344; \
      _Pragma("unroll") for (int k = 0; k < 4; ++k) { if (TYPE == 0) *(u32x4*)(B_ + b128 + k * 4096) = st[X_][k]; \
        *(u32x4*)(B_ + 16384 + b128 + k * 4096) = st[X_][4 + k]; *(u32x4*)(B_ + 32768 + b64 + k * 4096) = st[X_][8 + k]; } \
      *(u32x4*)(B_ + 49152 + b64) = st[X_][12]; *(u32x4*)(B_ + 49152 + b64 + 4096) = st[X_][13]; } while (0)
    LW_ISSUE(0, 0); LW_COMMIT(0, 0); LW_ISSUE(1, 1);
    __syncthreads();
    for (int n = 0; n < 64; n += 2) {
      if (n + 2 < 64) LW_ISSUE(n + 2, 0);
      LW_COMMIT(1, 1);
      __syncthreads();
      if (n + 3 < 64) LW_ISSUE(n + 3, 1);
      if (n + 2 < 64) LW_COMMIT(0, 0);
      __syncthreads();
    }
#undef LW_ISSUE
#undef LW_COMMIT
  } else {
    const int e0 = 32 * wv;
    bf16_t* proj = (bf16_t*)(p.ws + OFF_PROJ);
    const float* dG = (const float*)(p.ws + OFF_DG);
    f32x4 S[2][8];
#pragma unroll
    for (int c = 0; c < 2; ++c)
#pragma unroll
      for (int t = 0; t < 8; ++t) S[c][t] = (f32x4){0.f, 0.f, 0.f, 0.f};
    const float gvec = (TYPE == 0) ? dG[(ci0 + lane) * 8 + hh] : __expf(64.f * __logf(1.f - exp2f(-5.f - (float)hh)));
    u32x4 ucur[2][2], unext[2][2];
#define CW_ULOAD(n_, dst_) do { const size_t it_ = (size_t)((ci0 + (n_)) * 8 + hh); _Pragma("unroll") for (int c = 0; c < 2; ++c) { \
      if (TYPE == 0) { _Pragma("unroll") for (int mt = 0; mt < 4; ++mt) { const u32x2 u_ = *(const u32x2*)(gUT + it_ * 8192 + (e0 + 16 * c + fr) * 64 + 16 * mt + 4 * fq); dst_[c][mt >> 1][(mt & 1) * 2] = u_.x; dst_[c][mt >> 1][(mt & 1) * 2 + 1] = u_.y; } } \
      else { dst_[c][0] = *(const u32x4*)(gUT + it_ * 8192 + (e0 + 16 * c + fr) * 64 + 8 * fq); dst_[c][1] = *(const u32x4*)(gUT + it_ * 8192 + (e0 + 16 * c + fr) * 64 + 32 + 8 * fq); } } } while (0)
    bf16_t* obase = proj + (size_t)(ci0 * 64 + fr) * LDP + (TYPE == 0 ? C_OBRAW : C_OCRAW) + hh * 128 + e0 + 4 * fq;
    CW_ULOAD(0, ucur);
    __syncthreads();
    for (int n = 0; n < 64; ++n) {
      if (n + 1 < 64) CW_ULOAD(n + 1, unext);
      scan_step2<TYPE>(smem + (n & 1) * 57344, S, ucur, __shfl(gvec, n), obase + (size_t)(n * 64) * LDP, fr, fq);
#pragma unroll
      for (int c = 0; c < 2; ++c) { ucur[c][0] = unext[c][0]; ucur[c][1] = unext[c][1]; }
      __syncthreads();
    }
#undef CW_ULOAD
    { float* so = p.out + (TYPE == 0 ? O_PD : O_PR) + (((size_t)l * 4 + seq) * 8 + hh) * 16384 + e0 + fr;
#pragma unroll
      for (int c = 0; c < 2; ++c)
#pragma unroll
        for (int t = 0; t < 8; ++t)
#pragma unroll
          for (int i = 0; i < 4; ++i) so[(16 * t + 4 * fq + i) * 128 + 16 * c] = S[c][t][i]; }
  }
}

DI void attn_item(const Params& p, int l, int ai) {
  const int qt = ai & 3, hh = (ai >> 2) & 7, ci = ai >> 5;
  const int lane = otid() & 63, fr = lane & 15, fq = lane >> 4;
  bf16_t* proj = (bf16_t*)(p.ws + OFF_PROJ);
  const bf16_t* aVT = (const bf16_t*)(p.ws + OFF_M1) + 7 * M1_BLK;
  const bf16_t* kcb = (const bf16_t*)(p.ws + OFF_KC); const bf16_t* cvt = (const bf16_t*)(p.ws + OFF_CVT);
  const float* rb = p.rel_bias + ((size_t)l * 8 + hh) * 257;
  const int qrow = ci * 64 + 16 * qt + fr;
  bf16x8 Qf[4];
#pragma unroll
  for (int s = 0; s < 4; ++s) Qf[s] = *(const bf16x8*)(proj + (size_t)qrow * LDP + hh * 128 + 32 * s + 8 * fq);
  const int jmin = (ci < 256) ? ((ci & 63) >= 8 ? 0 : 8 - (ci & 63)) : 0;
  const float bfar = rb[256]; const int iq = 16 * qt + fr;
  float m = -1e30f, lsum = 0.f;
  f32x4 O[8];
#pragma unroll
  for (int et = 0; et < 8; ++et) O[et] = (f32x4){0.f, 0.f, 0.f, 0.f};
#pragma unroll 1
  for (int grp = 0; grp < 3; ++grp) {
    if (3 * grp + 2 < jmin) continue;
    f32x4 sc[12]; float gmx = -1e30f;
#pragma unroll
    for (int jj = 0; jj < 3; ++jj) { const int j = 3 * grp + jj;
      if (j >= jmin) {
        const bf16_t* Kp; int ks;
        if (ci < 256 || j == 8) { Kp = proj + (size_t)((ci < 256 ? ci - 8 + j : ci) * 64) * LDP + 1024 + hh * 128; ks = LDP; }
        else { Kp = kcb + (size_t)(((ci - 256) * 8 + j) * 8 + hh) * 8192; ks = 128; }
#pragma unroll
        for (int kt = 0; kt < 4; ++kt) {
          f32x4 c = {0.f, 0.f, 0.f, 0.f};
#pragma unroll
          for (int s = 0; s < 4; ++s) { const bf16x8 a = *(const bf16x8*)(Kp + (size_t)(16 * kt + fr) * ks + 32 * s + 8 * fq); c = MFMA16(a, Qf[s], c); }
#pragma unroll
          for (int i = 0; i < 4; ++i) { float bias = bfar;
            if (grp == 2) { const int r = 64 * j + 16 * kt + 4 * fq + i; int dist = 512 + iq - r; dist = dist < -128 ? -128 : (dist > 128 ? 128 : dist); bias = rb[dist + 128]; }
            c[i] = c[i] * 0.08838834764831845f + bias; gmx = fmaxf(gmx, c[i]); }
          sc[4 * jj + kt] = c;
        }
      } else {
#pragma unroll
        for (int kt = 0; kt < 4; ++kt) sc[4 * jj + kt] = (f32x4){-1e30f, -1e30f, -1e30f, -1e30f};
      }
    }
    gmx = fmaxf(gmx, __shfl_xor(gmx, 16)); gmx = fmaxf(gmx, __shfl_xor(gmx, 32));
    const float mnew = fmaxf(m, gmx), alpha = __expf(m - mnew); m = mnew;
    lsum *= alpha;
#pragma unroll
    for (int et = 0; et < 8; ++et) O[et] = O[et] * alpha;
#pragma unroll
    for (int t = 0; t < 12; ++t)
#pragma unroll
      for (int i = 0; i < 4; ++i) { const float e = __expf(sc[t][i] - m); sc[t][i] = e; lsum += e; }
#pragma unroll
    for (int jj = 0; jj < 3; ++jj) { const int j = 3 * grp + jj;
      if (j >= jmin) {
        const bf16_t* Vp;
        if (ci < 256 || j == 8) Vp = aVT + (size_t)((ci < 256 ? ci - 8 + j : ci) * 8 + hh) * 8192;
        else Vp = cvt + (size_t)(((ci - 256) * 8 + j) * 8 + hh) * 8192;
#pragma unroll
        for (int s2 = 0; s2 < 2; ++s2) { const bf16x8 pf = pack_frag(sc[4 * jj + 2 * s2], sc[4 * jj + 2 * s2 + 1]);
#pragma unroll
          for (int et = 0; et < 8; ++et) { const bf16x8 a = *(const bf16x8*)(Vp + (16 * et + fr) * 64 + 32 * s2 + 8 * fq); O[et] = MFMA16(a, pf, O[et]); } }
      }
    }
  }
  lsum += __shfl_xor(lsum, 16); lsum += __shfl_xor(lsum, 32);
  const float inv = __builtin_amdgcn_rcpf(lsum);
#pragma unroll
  for (int et = 0; et < 8; ++et) { const u32x2 z = *(const u32x2*)(proj + (size_t)qrow * LDP + 3072 + hh * 128 + 16 * et + 4 * fq);
    u32x2 w; w.x = pk2(O[et][0] * inv * siluf_(bflo(z.x)), O[et][1] * inv * siluf_(bfhi(z.x))); w.y = pk2(O[et][2] * inv * siluf_(bflo(z.y)), O[et][3] * inv * siluf_(bfhi(z.y)));
    *(u32x2*)(proj + (size_t)qrow * LDP + C_ACAT + hh * 128 + 16 * et + 4 * fq) = w; }
}

DI void attn_stage(const unsigned char* Kl, const float* sB, int j, int iq, float bfar, const bf16x8 (&Qf)[4], f32x4 (&O)[8], float& m, float& lsum, int fr, int fq) {
#define AW_A128(base_, row_, s_) (*(const bf16x8*)((base_) + (((row_) * 16 + ((4 * (s_) + fq) ^ fr)) * 16)))
#define AW_A64(base_, row_, s_) (*(const bf16x8*)((base_) + (((row_) * 8 + ((4 * (s_) + fq) ^ (fr >> 1))) * 16)))
  const unsigned char* Vl = Kl + 32768;
  f32x4 sc[4]; float gmx = -1e30f;
#pragma unroll
  for (int kt = 0; kt < 4; ++kt) {
    f32x4 c = {0.f, 0.f, 0.f, 0.f};
#pragma unroll
    for (int s = 0; s < 4; ++s) c = MFMA16(AW_A128(Kl, 16 * kt + fr, s), Qf[s], c);
#pragma unroll
    for (int i = 0; i < 4; ++i) { float bias = bfar;
      if (j >= 6) { const int r = 64 * j + 16 * kt + 4 * fq + i; int dist = 512 + iq - r; dist = dist < -128 ? -128 : (dist > 128 ? 128 : dist); bias = sB[dist + 128]; }
      c[i] = c[i] * 0.08838834764831845f + bias; gmx = fmaxf(gmx, c[i]); }
    sc[kt] = c;
  }
  gmx = fmaxf(gmx, __shfl_xor(gmx, 16)); gmx = fmaxf(gmx, __shfl_xor(gmx, 32));
  const float mnew = fmaxf(m, gmx), alpha = __expf(m - mnew); m = mnew;
  lsum *= alpha;
#pragma unroll
  for (int et = 0; et < 8; ++et) O[et] = O[et] * alpha;
#pragma unroll
  for (int kt = 0; kt < 4; ++kt)
#pragma unroll
    for (int i = 0; i < 4; ++i) { const float e = __expf(sc[kt][i] - m); sc[kt][i] = e; lsum += e; }
#pragma unroll
  for (int s2 = 0; s2 < 2; ++s2) { const bf16x8 pf = pack_frag(sc[2 * s2], sc[2 * s2 + 1]);
#pragma unroll
    for (int et = 0; et < 8; ++et) O[et] = MFMA16(AW_A64(Vl, 16 * et + fr, s2), pf, O[et]); }
#undef AW_A128
#undef AW_A64
}
DI void attn_wg(const Params& p, int l, int wi, unsigned char* smem) {
  const int tid = otid(), lane = tid & 63, wv = tid >> 6, fr = lane & 15, fq = lane >> 4;
  const int ci = wi >> 2, hp = wi & 3, hsel = wv >> 2, hh = 2 * hp + hsel, qt = wv & 3;
  bf16_t* proj = (bf16_t*)(p.ws + OFF_PROJ);
  const bf16_t* aVT = (const bf16_t*)(p.ws + OFF_M1) + 7 * M1_BLK;
  const bf16_t* kcb = (const bf16_t*)(p.ws + OFF_KC); const bf16_t* cvt = (const bf16_t*)(p.ws + OFF_CVT);
  const float* rb = p.rel_bias + ((size_t)l * 8 + 2 * hp) * 257;
  float* sBias = (float*)(smem + 131072 + 256);
  const int qrow = ci * 64 + 16 * qt + fr;
  bf16x8 Qf[4];
#pragma unroll
  for (int s = 0; s < 4; ++s) Qf[s] = *(const bf16x8*)(proj + (size_t)qrow * LDP + hh * 128 + 32 * s + 8 * fq);
  const int jmin = (ci < 256) ? ((ci & 63) >= 8 ? 0 : 8 - (ci & 63)) : 0;
  const float bfar = rb[hsel * 257 + 256]; const int iq = 16 * qt + fr;
  const int row0 = tid >> 4, kcol = tid & 15;
  const int dKb = (row0 * 16 + (kcol ^ (row0 & 15))) * 16, dVb = 32768 + ((tid >> 3) * 8 + ((tid & 7) ^ ((tid >> 4) & 7))) * 16;
  u32x4 st[2][8];
#define AW_ISSUE(j_, X_) do { const bf16_t* Kb_; const bf16_t* Vb_; int ks_; size_t khs_; \
    if (ci < 256 || (j_) == 8) { const int cj_ = (ci < 256) ? ci - 8 + (j_) : ci; Kb_ = proj + (size_t)(cj_ * 64) * LDP + 1024 + 2 * hp * 128; ks_ = LDP; khs_ = 128; Vb_ = aVT + (size_t)(cj_ * 8 + 2 * hp) * 8192; } \
    else { const size_t o_ = (size_t)(((ci - 256) * 8 + (j_)) * 8 + 2 * hp) * 8192; Kb_ = kcb + o_; ks_ = 128; khs_ = 8192; Vb_ = cvt + o_; } \
    const bf16_t* kp_ = Kb_ + (size_t)row0 * ks_ + kcol * 8; \
    _Pragma("unroll") for (int k = 0; k < 4; ++k) { st[X_][k] = *(const u32x4*)(kp_ + (k >> 1) * khs_ + (size_t)(32 * (k & 1)) * ks_); st[X_][4 + k] = *(const u32x4*)(Vb_ + (size_t)(tid + 512 * k) * 8); } } while (0)
#define AW_COMMIT(b_, X_) do { unsigned char* B_ = smem + (b_) * 65536; _Pragma("unroll") for (int k = 0; k < 4; ++k) { \
    *(u32x4*)(B_ + dKb + (k >> 1) * 16384 + (k & 1) * 8192) = st[X_][k]; *(u32x4*)(B_ + dVb + (k >> 1) * 16384 + (k & 1) * 8192) = st[X_][4 + k]; } } while (0)
  float m = -1e30f, lsum = 0.f;
  f32x4 O[8];
#pragma unroll
  for (int et = 0; et < 8; ++et) O[et] = (f32x4){0.f, 0.f, 0.f, 0.f};
  AW_ISSUE(jmin, 0);
  if (tid < 257) { sBias[tid] = rb[tid]; sBias[260 + tid] = rb[257 + tid]; }
  AW_COMMIT(0, 0);
  if (jmin + 1 < 9) AW_ISSUE(jmin + 1, 1);
  __syncthreads();
  const float* sB = sBias + hsel * 260;
  for (int j = jmin; j < 9; j += 2) {
    if (j + 2 < 9) AW_ISSUE(j + 2, 0);
    attn_stage(smem + hsel * 16384, sB, j, iq, bfar, Qf, O, m, lsum, fr, fq);
    if (j + 1 < 9) AW_COMMIT(1, 1);
    __syncthreads();
    if (j + 1 >= 9) break;
    if (j + 3 < 9) AW_ISSUE(j + 3, 1);
    attn_stage(smem + 65536 + hsel * 16384, sB, j + 1, iq, bfar, Qf, O, m, lsum, fr, fq);
    if (j + 2 < 9) AW_COMMIT(0, 0);
    __syncthreads();
  }
#undef AW_ISSUE
#undef AW_COMMIT
  lsum += __shfl_xor(lsum, 16); lsum += __shfl_xor(lsum, 32);
  const float inv = __builtin_amdgcn_rcpf(lsum);
#pragma unroll
  for (int et = 0; et < 8; ++et) { const u32x2 z = *(const u32x2*)(proj + (size_t)qrow * LDP + 3072 + hh * 128 + 16 * et + 4 * fq);
    u32x2 w; w.x = pk2(O[et][0] * inv * siluf_(bflo(z.x)), O[et][1] * inv * siluf_(bfhi(z.x))); w.y = pk2(O[et][2] * inv * siluf_(bflo(z.y)), O[et][3] * inv * siluf_(bfhi(z.y)));
    *(u32x2*)(proj + (size_t)qrow * LDP + C_ACAT + hh * 128 + 16 * et + 4 * fq) = w; }
}

DI void m2_phase(const Params& p, int l, int rep, unsigned char* smem) {
  const int tid_ = otid(); const int wv = tid_ >> 6;
  if (oblk() < 64) {
    const int chain = oblk(), ty = chain >> 5, sq = (chain & 31) >> 3, hh = chain & 7;
    for (int r3 = 0; r3 < R_SW; ++r3) { if (ty == 0) scan_wg2<0>(p, l, sq, hh, smem); else scan_wg2<1>(p, l, sq, hh, smem); }
  } else {
    for (int idx = (oblk() - 64) * 8 + wv; idx < 1024; idx += (gridDim.x - 64) * 8) {
      const int ty = idx >> 9, r = idx & 511, sq = 4 + (r >> 6), hh = (r >> 3) & 7, sl = r & 7;
      if (ty == 0) scan_item<0>(p, l, sq, hh, sl); else scan_item<1>(p, l, sq, hh, sl); }
  }
  unsigned* cnt = (unsigned*)(p.ws + OFF_CNT) + 64 * (l * 2 + rep);
  for (;;) {
    __syncthreads();
    if (tid_ == 0) *(volatile unsigned*)(smem + 131072) = atomicAdd(cnt, 1u);
    __syncthreads();
    const unsigned idx = *(volatile unsigned*)(smem + 131072);
    if (idx >= 1056u) break;
    for (int r2 = 0; r2 < R_AT; ++r2) attn_wg(p, l, (int)idx, smem);
  }
}

DI void m3_phase(const Params& p, int l) {
  bf16_t* proj = (bf16_t*)(p.ws + OFF_PROJ);
  const int tid_ = otid(); const int lane = tid_ & 63, gw = oblk() * 8 + (tid_ >> 6), nw = gridDim.x * 8;
  for (int wi = gw; wi < 2 * MROWS; wi += nw) {
    const int r = wi >> 1, br = wi & 1; bf16_t* rp = proj + (size_t)r * LDP;
    float v[16], z[16];
    unpack8(*(const u32x4*)(rp + (br ? C_OCRAW : C_OBRAW) + 16 * lane), v); unpack8(*(const u32x4*)(rp + (br ? C_OCRAW : C_OBRAW) + 16 * lane + 8), v + 8);
    unpack8(*(const u32x4*)(rp + (br ? 11264 : 7168) + 16 * lane), z); unpack8(*(const u32x4*)(rp + (br ? 11264 : 7168) + 16 * lane + 8), z + 8);
    const float* nw_ = br ? p.ret_norm + (size_t)l * 1024 + 16 * lane : p.delta_norm + (size_t)l * 128 + 16 * (lane & 7);
    float mu = 0.f;
    if (br) {
#pragma unroll
      for (int c = 0; c < 16; ++c) mu += v[c];
      mu += __shfl_xor(mu, 1); mu += __shfl_xor(mu, 2); mu += __shfl_xor(mu, 4); mu *= (1.f / 128.f); }
    float ss = 0.f;
#pragma unroll
    for (int c = 0; c < 16; ++c) { v[c] -= mu; ss += v[c] * v[c]; }
    ss += __shfl_xor(ss, 1); ss += __shfl_xor(ss, 2); ss += __shfl_xor(ss, 4);
    const float rn = rsqrtf(ss * (1.f / 128.f) + 1e-6f);
#pragma unroll
    for (int c = 0; c < 16; ++c) v[c] = v[c] * rn * nw_[c] * siluf_(z[c]);
    *(u32x4*)(rp + C_ACAT + 1024 + br * 1024 + 16 * lane) = pack8(v); *(u32x4*)(rp + C_ACAT + 1024 + br * 1024 + 16 * lane + 8) = pack8(v + 8);
  }
}

DI void merge_phase(const Params& p) {
  const bf16_t* proj = (const bf16_t*)(p.ws + OFF_PROJ); const bf16_t* P = (const bf16_t*)(p.ws + OFF_M1); bf16_t* mg = (bf16_t*)(p.ws + OFF_H);
  const int tid_ = otid(); const int lane = tid_ & 63, gw = oblk() * 8 + (tid_ >> 6), nw = gridDim.x * 8;
  for (int r = gw; r < MROWS; r += nw) {
    const bf16_t* pr = P + (size_t)r * (3 * DM); const bf16_t* gr = proj + (size_t)r * LDP + 12288;
#pragma unroll
    for (int q = 0; q < 4; ++q) { const int c = q * 512 + lane * 8; float acc[8];
#pragma unroll
      for (int j = 0; j < 8; ++j) acc[j] = 0.f;
#pragma unroll
      for (int br = 0; br < 3; ++br) { float pv[8], gv[8]; unpack8(*(const u32x4*)(pr + br * DM + c), pv); unpack8(*(const u32x4*)(gr + br * DM + c), gv);
#pragma unroll
        for (int j = 0; j < 8; ++j) acc[j] += pv[j] * sigmoidf_(gv[j]); }
      *(u32x4*)(mg + (size_t)r * DM + c) = pack8(acc); }
  }
}

#define XB_TMO      128
#define XB_XCNT(j)  (256  + 64 * (j))
#define XB_XSUB(j)  (1280 + 64 * (j))
#define XB_XGEN(j)  (2304 + 64 * (j))
#define XB_TOP      3328
#define XB_TOPGEN   3392
#define XCD_BAR_WORDS 3456
#define XB_SPIN_CAP (1u << 18)
DI unsigned xb_ld(unsigned* p) { return __hip_atomic_load(p, __ATOMIC_RELAXED, __HIP_MEMORY_SCOPE_AGENT); }
DI unsigned xb_add(unsigned* p, unsigned v) { return __hip_atomic_fetch_add(p, v, __ATOMIC_RELAXED, __HIP_MEMORY_SCOPE_AGENT); }
DI unsigned xb_xcc_id() { return (unsigned)__builtin_amdgcn_s_getreg((3 << 11) | 20) & 0xFu; }
#define XB_SPIN(cond, bar) do { unsigned _sp = 0; while (cond) { __builtin_amdgcn_s_sleep(1); \
    if ((++_sp & 255u) == 0u) { if (xb_ld(&(bar)[XB_TMO])) break; if (_sp > XB_SPIN_CAP) { atomicAdd(&(bar)[XB_TMO], 1u); break; } } } } while (0)
struct XcdBarrier { unsigned* bar; unsigned x; volatile LAS unsigned* st; };
DI XcdBarrier xcd_barrier_post(unsigned* bar, volatile LAS unsigned* st) {
  XcdBarrier b; b.bar = bar; b.x = xb_xcc_id(); b.st = st;
  if (threadIdx.x == 0) (void)xb_add(&bar[XB_XCNT(b.x)], 1u);
  return b;
}
DI void xcd_barrier_complete(unsigned* bar, unsigned x, unsigned& nloc, unsigned& nx) {
  const unsigned G = gridDim.x * gridDim.y * gridDim.z;
  unsigned sum, cnt, mine, sp = 0u;
  for (;;) {
    sum = 0u; cnt = 0u; mine = 0u;
#pragma unroll
    for (unsigned j = 0; j < 16; ++j) { const unsigned c = xb_ld(&bar[XB_XCNT(j)]); sum += c; cnt += (c > 0u) ? 1u : 0u; mine = (j == x) ? c : mine; }
    if (sum == G) break;
    __builtin_amdgcn_s_sleep(1);
    if ((++sp & 255u) == 0u) { if (xb_ld(&bar[XB_TMO])) break; if (sp > XB_SPIN_CAP) { atomicAdd(&bar[XB_TMO], 1u); break; } }
  }
  nloc = mine > 0u ? mine : 1u; nx = cnt > 0u ? cnt : 1u;
}
DI void xcd_barrier(const XcdBarrier& b) {
  asm volatile("s_waitcnt vmcnt(0)" ::: "memory");
  __syncthreads();
  if (threadIdx.x == 0) {
    unsigned* bar = b.bar;
    __builtin_amdgcn_s_waitcnt(0);
    unsigned nloc = b.st[0], nx = b.st[1];
    if (nloc == 0u) { xcd_barrier_complete(bar, b.x, nloc, nx); b.st[0] = nloc; b.st[1] = nx; }
    const unsigned old = xb_add(&bar[XB_XSUB(b.x)], 1u);
    const unsigned gen = old / nloc;
    if (old + 1u == (gen + 1u) * nloc) {
      __builtin_amdgcn_fence(__ATOMIC_RELEASE, "agent");
      asm volatile("s_waitcnt vmcnt(0)" ::: "memory");
      const unsigned og = xb_add(&bar[XB_TOP], 1u);
      const unsigned tg = og / nx;
      if (og + 1u == (tg + 1u) * nx) xb_add(&bar[XB_TOPGEN], 1u);
      else XB_SPIN(xb_ld(&bar[XB_TOPGEN]) == tg, bar);
      __builtin_amdgcn_fence(__ATOMIC_ACQUIRE, "agent");
      xb_add(&bar[XB_XGEN(b.x)], 1u);
      asm volatile("s_waitcnt vmcnt(0)" ::: "memory");
    } else {
      XB_SPIN(xb_ld(&bar[XB_XGEN(b.x)]) == gen, bar);
      __builtin_amdgcn_fence(__ATOMIC_ACQUIRE, "agent");
      asm volatile("s_waitcnt vmcnt(0)" ::: "memory");
    }
  }
  __syncthreads();
}

__global__ void __launch_bounds__(512, 2) mega(Params p) {
  extern __shared__ __attribute__((aligned(16))) unsigned char smem[];
  cg::grid_group grid = cg::this_grid();
  const int G = gridDim.x;
  if (threadIdx.x == 0) { ((volatile LAS unsigned*)(LAS unsigned char*)smem)[(131072 + 16) / 4] = 0u; ((volatile LAS unsigned*)(LAS unsigned char*)smem)[(131072 + 20) / 4] = 0u; }
  __syncthreads();
  XcdBarrier xb = xcd_barrier_post((unsigned*)(p.ws + OFF_BAR), (volatile LAS unsigned*)((LAS unsigned char*)smem + 131072 + 16));
  if (oblk() == 0 && threadIdx.x < 4) ((unsigned*)(p.ws + OFF_CNT))[64 * threadIdx.x] = 0u;
  if (T_ROW) { convert_weights(p, 0, (float*)smem, 2, oblk(), gridDim.x);
  prenorm_phase(p, 0); }
  grid.sync();
  for (int l = 0; l < 2; ++l) {
    { pg8::Gemm g{(const bf16_t*)(p.ws + OFF_H), (const bf16_t*)(p.ws + OFF_WIN), MROWS, NW1, DM, DM, DM, 1 << 20, 0};
      pg8::StaticOrder S; S.init(MROWS, NW1, G, oblk());
      EpiProj E{(bf16_t*)(p.ws + OFF_PROJ), (float*)(p.ws + OFF_SIDE), LDP, 72};
      for (int rep = 0; rep < R_G1; ++rep) pg8::gemm_phase(( LAS unsigned char*)smem, g, S, E); }
    xcd_barrier(xb);
    { float* sCW = (float*)(smem + 122880); const int hh0 = oblk() & 7;
      for (int idx = threadIdx.x; idx < 1536; idx += 512) { const int mat = idx / 512, tap = (idx >> 7) & 3, col = idx & 127;
        sCW[idx] = p.conv_w[((size_t)l * 4 + tap) * 3072 + mat * 1024 + hh0 * 128 + col]; }
      __syncthreads(); }
    for (int rep = 0; rep < R_M1; ++rep)
    for (int t = oblk(); t < 3 * NITEM + 512; t += G) {
      if (t < NITEM) { for (int r2 = 0; r2 < R_DP; ++r2) delta_pre(p, l, t, smem); }
      else if (t < 2 * NITEM) { if (T_RP) ret_pre(p, l, t - NITEM, smem); }
      else if (t < 3 * NITEM) { if (T_MI) misc_item(p, l, t - 2 * NITEM, smem); }
      else { if (T_MI) cache_item(p, l, t - 3 * NITEM, smem); }
    }
    xcd_barrier(xb);
    for (int rep = 0; rep < R_M2; ++rep) m2_phase(p, l, rep, smem);
    xcd_barrier(xb);
    for (int rep = 0; rep < R_M3; ++rep) m3_phase(p, l);
    xcd_barrier(xb);
    for (int rep = 0; rep < R_G2; ++rep) {
      pg8::Gemm g{(const bf16_t*)(p.ws + OFF_PROJ) + C_ACAT, (const bf16_t*)(p.ws + OFF_WBR), MROWS, 3 * DM, 1024, LDP, 1024, 8, 2048};
      pg8::StaticOrder S; S.init(MROWS, 3 * DM, G, oblk());
      EpiProj E{(bf16_t*)(p.ws + OFF_M1), nullptr, 3 * DM, 1 << 20};
      pg8::gemm_phase((LAS unsigned char*)smem, g, S, E); }
    xcd_barrier(xb);
    merge_phase(p);
    xcd_barrier(xb);
    if (l == 0) {
      { pg8::Gemm g{(const bf16_t*)(p.ws + OFF_H), (const bf16_t*)(p.ws + OFF_WOUT), MROWS, DM, DM, DM, DM, 1 << 20, 0};
        pg8::StaticOrder S; S.init(MROWS, DM, G, oblk());
        EpiF32 E{(float*)(p.ws + OFF_M1 + 69206016)};
        pg8::gemm_phase((LAS unsigned char*)smem, g, S, E); }
      { const int c0 = 528 - ((528 + G - 1) / G - 1) * G;
        if (c0 < G && oblk() >= c0) convert_weights(p, 1, (float*)smem, 0, oblk() - c0, G - c0);
        else if (c0 >= G) convert_weights(p, 1, (float*)smem, 0, oblk(), G); }
      xcd_barrier(xb);
      postnorm_phase(p, l, 0, MROWS, 0, G);
    } else {
      { pg8::Gemm g{(const bf16_t*)(p.ws + OFF_H), (const bf16_t*)(p.ws + OFF_WOUT), 16384, DM, DM, DM, DM, 1 << 20, 0};
        pg8::StaticOrder S; S.init(16384, DM, G, oblk());
        EpiF32 E{(float*)(p.ws + OFF_M1 + 69206016)};
        pg8::gemm_phase((LAS unsigned char*)smem, g, S, E); }
      xcd_barrier(xb);
      if (oblk() < 16 && G > 16) {
        pg8::Gemm g{(const bf16_t*)(p.ws + OFF_H) + (size_t)16384 * DM, (const bf16_t*)(p.ws + OFF_WOUT), 512, DM, DM, DM, DM, 1 << 20, 0};
        pg8::StaticOrder S; S.init(512, DM, 16, oblk());
        EpiF32 E{(float*)(p.ws + OFF_M1 + 69206016) + (size_t)16384 * DM};
        pg8::gemm_phase((LAS unsigned char*)smem, g, S, E);
      } else if (G > 16) postnorm_phase(p, l, 0, 16384, 16, G - 16);
      xcd_barrier(xb);
      postnorm_phase(p, l, 16384, MROWS, 0, G);
    }
    if (l == 0) { if (T_ROW) convert_weights(p, 1, (float*)smem, 1, oblk(), gridDim.x); xcd_barrier(xb); }
  }
}

extern "C" void kernel_launch(void* const* d_in, const int* in_sizes, int n_in, void* d_out, int out_size,
                              void* d_ws, size_t ws_size, hipStream_t stream) {
  constexpr size_t kLds = 131072 + 256 + 4096;
  static int grid_blocks = 0;
  if (!grid_blocks) {
    (void)hipFuncSetAttribute((const void*)mega, hipFuncAttributeMaxDynamicSharedMemorySize, (int)kLds);
    int dev = 0, cus = 0, per_cu = 0;
    (void)hipGetDevice(&dev);
    (void)hipDeviceGetAttribute(&cus, hipDeviceAttributeMultiprocessorCount, dev);
    (void)hipOccupancyMaxActiveBlocksPerMultiprocessor(&per_cu, mega, 512, kLds);
    if (per_cu > 1) per_cu = 1;
    grid_blocks = cus * per_cu;
    if (grid_blocks > 256) grid_blocks = 256;
  }
  if (ws_size < WS_NEED) { fprintf(stderr, "workspace too small: %zu < %zu\n", ws_size, (size_t)WS_NEED); return; }
  (void)hipMemsetAsync((unsigned char*)d_ws + OFF_BAR, 0, 16384, stream);
  Params p{};
  const float** pp = (const float**)&p;
  for (int i = 0; i < 20; ++i) pp[i] = (const float*)d_in[i];
  p.out = (float*)d_out; p.ws = (unsigned char*)d_ws;
  void* args[] = {&p};
  hipError_t e = hipLaunchCooperativeKernel((void*)mega, dim3(grid_blocks), dim3(512), args, kLds, stream);
  if (e != hipSuccess) fprintf(stderr, "cooperative launch failed: %s (grid %d)\n", hipGetErrorString(e), grid_blocks);
}
```
